# Optimizing an MI355X kernel written in HIP

```python
import jax, jax.numpy as jnp
from jax import lax
import numpy as np

D_MODEL = 1024
BATCH = 8
SEQ = 2048
DEPTH = 1

N_META = 16
CONV_WIDTH = 512
CONV_K = 31
N_HEADS = 8
HEAD_DIM = 64
ATTN_WIDTH = N_HEADS * HEAD_DIM
Q_BLOCK = 128
N_GROUPS = 8
EXPERTS_PER_GROUP = 8
N_EXPERTS = N_GROUPS * EXPERTS_PER_GROUP
TOP_K = 2
D_EXPERT = 256
ROW_BLOCK = 256
RMS_EPS = 1e-6
LN_EPS = 1e-5

IN_SPLITS = (2 * CONV_WIDTH, ATTN_WIDTH, ATTN_WIDTH, ATTN_WIDTH, N_HEADS, D_MODEL, D_MODEL)
IN_COLS = sum(IN_SPLITS)

kernel_name = "hybrid_conformer_fox_hmoe_block"


def rmsnorm(x, g):
    xf = x.astype(jnp.float32)
    y = xf * lax.rsqrt(jnp.mean(xf * xf, axis=-1, keepdims=True) + RMS_EPS)
    return (y * g.astype(jnp.float32)).astype(x.dtype)


def layernorm(x, g, b):
    xf = x.astype(jnp.float32)
    mu = jnp.mean(xf, axis=-1, keepdims=True)
    var = jnp.mean(jnp.square(xf - mu), axis=-1, keepdims=True)
    y = (xf - mu) * lax.rsqrt(var + LN_EPS)
    return (y * g.astype(jnp.float32) + b.astype(jnp.float32)).astype(x.dtype)


def conformer_conv(u, dw_w, dw_b, ln_g, ln_b, w_pw, b_pw):
    a = u[..., :CONV_WIDTH] * jax.nn.sigmoid(u[..., CONV_WIDTH:])
    a = lax.conv_general_dilated(a, dw_w[:, None, :], window_strides=(1,),
                                 padding=[(CONV_K - 1, 0)],
                                 dimension_numbers=('NWC', 'WIO', 'NWC'),
                                 feature_group_count=CONV_WIDTH) + dw_b
    a = jax.nn.silu(layernorm(a, ln_g, ln_b))
    return a @ w_pw + b_pw


def forgetting_attention(q, k, v, logf):
    L = q.shape[1]
    c = jnp.cumsum(logf, axis=1).transpose(0, 2, 1)
    scale = HEAD_DIM ** -0.5

    def block(q0, q1):
        t = jnp.arange(q0, q1)
        s = jnp.arange(q1)
        logits = jnp.einsum('bqhd,bkhd->bhqk', q[:, q0:q1], k[:, :q1]).astype(jnp.float32) * scale
        logits = logits + c[:, :, q0:q1, None] - c[:, :, None, :q1]
        logits = jnp.where(s[None, :] <= t[:, None], logits, -jnp.inf)
        p = jax.nn.softmax(logits, axis=-1)
        return jnp.einsum('bhqk,bkhd->bqhd', p.astype(v.dtype), v[:, :q1])

    n_blocks = (L - N_META) // Q_BLOCK
    bounds = [(0, N_META)] + [(N_META + i * Q_BLOCK, N_META + (i + 1) * Q_BLOCK) for i in range(n_blocks)]
    return jnp.concatenate([block(q0, q1) for (q0, q1) in bounds], axis=1)


def hierarchical_moe(xt, w_group, b_group, w_router, b_router, w_gate, w_up, w_down):
    N = xt.shape[0]
    g_logits = (xt @ w_group).astype(jnp.float32) + b_group.astype(jnp.float32)
    g_prob = jax.nn.softmax(g_logits, axis=-1)
    g_idx = jnp.argmax(g_logits, axis=-1).astype(jnp.int32)
    g_w = jnp.take_along_axis(g_prob, g_idx[:, None], axis=1)
    e_logits = ((xt @ w_router).astype(jnp.float32) + b_router.astype(jnp.float32)).reshape(N, N_GROUPS, EXPERTS_PER_GROUP)
    e_logits = jnp.take_along_axis(e_logits, g_idx[:, None, None], axis=1)[:, 0]
    top_l, top_i = lax.top_k(e_logits, TOP_K)
    w = jax.nn.softmax(top_l, axis=-1) * g_w

    A = N * TOP_K
    e_id = (g_idx[:, None] * EXPERTS_PER_GROUP + top_i.astype(jnp.int32)).reshape(A)
    tok = jnp.repeat(jnp.arange(N, dtype=jnp.int32), TOP_K)
    wa = w.reshape(A)

    order = jnp.argsort(e_id)
    se, stok, sw = e_id[order], tok[order], wa[order]
    counts = jnp.zeros((N_EXPERTS,), jnp.int32).at[e_id].add(1)
    start = jnp.cumsum(counts) - counts
    padded = (counts + ROW_BLOCK - 1) // ROW_BLOCK * ROW_BLOCK
    pend = jnp.cumsum(padded)
    pstart = pend - padded
    dest = pstart[se] + jnp.arange(A, dtype=jnp.int32) - start[se]

    n_blocks = -(-A // ROW_BLOCK) + N_EXPERTS
    P = n_blocks * ROW_BLOCK
    buf_tok = jnp.full((P,), N, jnp.int32).at[dest].set(stok)
    buf_w = jnp.zeros((P,), jnp.float32).at[dest].set(sw)
    blk_e = jnp.minimum(jnp.searchsorted(pend, jnp.arange(n_blocks, dtype=jnp.int32) * ROW_BLOCK, side='right'),
                        N_EXPERTS - 1).astype(jnp.int32)

    x_pad = jnp.concatenate([xt, jnp.zeros((1, xt.shape[1]), xt.dtype)], axis=0)
    xin = x_pad[buf_tok].reshape(n_blocks, ROW_BLOCK, xt.shape[1])

    def expert_block(args):
        xb, e = args
        hb = jax.nn.silu(xb @ w_gate[e]) * (xb @ w_up[e])
        return hb @ w_down[e]

    yb = lax.map(expert_block, (xin, blk_e)).reshape(P, xt.shape[1])
    y = yb.astype(jnp.float32) * buf_w[:, None]
    out = jax.ops.segment_sum(y, buf_tok, num_segments=N + 1)[:N]
    return out.astype(xt.dtype)


def setup_inputs(seed: int = 0) -> dict:
    key = jax.random.key(seed)
    ks = jax.random.split(key, 24)
    f32 = jnp.float32
    nrm = lambda k, shape, scale: jax.random.normal(k, shape, f32) * scale
    return {
        "x": nrm(ks[0], (BATCH, SEQ, D_MODEL), 1.0),
        "meta": nrm(ks[1], (N_META, D_MODEL), 1.0),
        "norm1_g": 1.0 + nrm(ks[2], (DEPTH, D_MODEL), 0.02),
        "w_in": nrm(ks[3], (DEPTH, D_MODEL, IN_COLS), D_MODEL ** -0.5),
        "b_in": nrm(ks[4], (DEPTH, IN_COLS), 0.02),
        "dw_w": nrm(ks[5], (DEPTH, CONV_K, CONV_WIDTH), CONV_K ** -0.5),
        "dw_b": nrm(ks[6], (DEPTH, CONV_WIDTH), 0.02),
        "conv_ln_g": 1.0 + nrm(ks[7], (DEPTH, CONV_WIDTH), 0.02),
        "conv_ln_b": nrm(ks[8], (DEPTH, CONV_WIDTH), 0.02),
        "w_conv_out": nrm(ks[9], (DEPTH, CONV_WIDTH, D_MODEL), CONV_WIDTH ** -0.5),
        "b_conv_out": nrm(ks[10], (DEPTH, D_MODEL), 0.02),
        "q_norm_g": 1.0 + nrm(ks[11], (DEPTH, HEAD_DIM), 0.02),
        "k_norm_g": 1.0 + nrm(ks[12], (DEPTH, HEAD_DIM), 0.02),
        "b_forget": jax.random.uniform(ks[13], (DEPTH, N_HEADS), f32, 1.0, 3.0),
        "w_attn_out": nrm(ks[14], (DEPTH, ATTN_WIDTH, D_MODEL), ATTN_WIDTH ** -0.5),
        "w_out": nrm(ks[15], (DEPTH, D_MODEL, D_MODEL), D_MODEL ** -0.5),
        "norm2_g": 1.0 + nrm(ks[16], (DEPTH, D_MODEL), 0.02),
        "w_group": nrm(ks[17], (DEPTH, D_MODEL, N_GROUPS), D_MODEL ** -0.5),
        "b_group": nrm(ks[18], (DEPTH, N_GROUPS), 0.01),
        "w_router": nrm(ks[19], (DEPTH, D_MODEL, N_EXPERTS), D_MODEL ** -0.5),
        "b_router": nrm(ks[20], (DEPTH, N_EXPERTS), 0.01),
        "w_gate": nrm(ks[21], (DEPTH, N_EXPERTS, D_MODEL, D_EXPERT), D_MODEL ** -0.5),
        "w_up": nrm(ks[22], (DEPTH, N_EXPERTS, D_MODEL, D_EXPERT), D_MODEL ** -0.5),
        "w_down": nrm(ks[23], (DEPTH, N_EXPERTS, D_EXPERT, D_MODEL), D_EXPERT ** -0.5),
    }


def reference(x, meta, norm1_g, w_in, b_in, dw_w, dw_b, conv_ln_g, conv_ln_b, w_conv_out, b_conv_out,
              q_norm_g, k_norm_g, b_forget, w_attn_out, w_out, norm2_g, w_group, b_group, w_router,
              b_router, w_gate, w_up, w_down):
    B = x.shape[0]
    h = jnp.concatenate([jnp.broadcast_to(meta[None].astype(x.dtype), (B, N_META, D_MODEL)), x], axis=1)
    L = h.shape[1]
    split_pts = list(np.cumsum(IN_SPLITS)[:-1])
    for l in range(DEPTH):
        xn = rmsnorm(h, norm1_g[l])
        proj = xn @ w_in[l] + b_in[l]
        u_conv, q, k, v, f_logit, gate_c, gate_a = jnp.split(proj, split_pts, axis=-1)

        y_conv = conformer_conv(u_conv, dw_w[l], dw_b[l], conv_ln_g[l], conv_ln_b[l],
                                w_conv_out[l], b_conv_out[l])

        q = rmsnorm(q.reshape(B, L, N_HEADS, HEAD_DIM), q_norm_g[l])
        k = rmsnorm(k.reshape(B, L, N_HEADS, HEAD_DIM), k_norm_g[l])
        v = v.reshape(B, L, N_HEADS, HEAD_DIM)
        logf = jax.nn.log_sigmoid(f_logit.astype(jnp.float32) + b_forget[l].astype(jnp.float32))
        o = forgetting_attention(q, k, v, logf).reshape(B, L, ATTN_WIDTH)
        y_attn = o @ w_attn_out[l]

        merged = jax.nn.sigmoid(gate_c) * y_conv + jax.nn.sigmoid(gate_a) * y_attn
        h = h + merged @ w_out[l]

        hn = rmsnorm(h, norm2_g[l]).reshape(B * L, D_MODEL)
        y_moe = hierarchical_moe(hn, w_group[l], b_group[l], w_router[l], b_router[l],
                                 w_gate[l], w_up[l], w_down[l])
        h = h + y_moe.reshape(B, L, D_MODEL)
    return h[:, N_META:]
```

```cpp
#include <hip/hip_runtime.h>
#include <hip/hip_bf16.h>
#include <cstdio>
#include <cstdint>
#include <cmath>

#define GAS __attribute__((address_space(1)))
#define LAS __attribute__((address_space(3)))
typedef unsigned short bf16_t;
typedef short bf16x8 __attribute__((ext_vector_type(8)));
typedef float f32x4 __attribute__((ext_vector_type(4)));
typedef float f32x2 __attribute__((ext_vector_type(2)));
typedef unsigned u32x4 __attribute__((ext_vector_type(4)));
typedef unsigned u32x2 __attribute__((ext_vector_type(2)));

__device__ __forceinline__ unsigned cvt_pk_bf16(float lo, float hi) { unsigned r; asm volatile("v_cvt_pk_bf16_f32 %0, %1, %2" : "=v"(r) : "v"(lo), "v"(hi)); return r; }
__device__ __forceinline__ float bf_lo(unsigned w) { return __uint_as_float(w << 16); }
__device__ __forceinline__ float bf_hi(unsigned w) { return __uint_as_float(w & 0xffff0000u); }
__device__ __forceinline__ float bf2f(bf16_t b) { return __uint_as_float((unsigned)b << 16); }
__device__ __forceinline__ float sigmoidf_(float x) { return __builtin_amdgcn_rcpf(1.0f + __builtin_amdgcn_exp2f(-1.4426950408889634f * x)); }

namespace pg8 {
constexpr int BM = 256, BK = 64, HALF = 128, HTB = HALF * BK * 2  , STAGE_BYTES = 8 * HTB;

__host__ __device__ __forceinline__ int lds_byte(int r, int c) { const int st = (r >> 4) * 2 + (c >> 5), rr = r & 15, cc = c & 31, ob = rr * 64 + cc * 2; return st * 1024 + (ob ^ (((ob >> 9) & 1) << 5)); }
__host__ __device__ __forceinline__ void stage_rc(int b, int& R, int& C) { const int st = b / 1024, sb = b % 1024, swz = sb ^ (((sb >> 9) & 1) << 5); R = (st >> 1) * 16 + swz / 64; C = (st & 1) * 32 + (swz % 64) / 2; }
__host__ __device__ __forceinline__ int perm32(int rho) { const int n = rho >> 4, i = rho & 15; return 8 * (i >> 2) + 4 * n + (i & 3); }

struct Unit { int pm, pn, e; };

template <class Epi, class Sched, bool ALIGN_EPI, bool GATHER = false, bool PARTIAL = false>
__device__ __forceinline__ void gemm_phase(LAS unsigned char* lds, const int K, const Sched& S, Epi& E) {
    int tid = threadIdx.x; asm volatile("" : "+v"(tid));
    const int wid = __builtin_amdgcn_readfirstlane(tid >> 6), lane = tid & 63, wr = wid >> 2, wc = wid & 3, fr = lane & 15, fq = lane >> 4;
    const int nt = K / BK;
    int Rr[2], Cc[2]; unsigned voffB[2], voffA[2];
#pragma unroll
    for (int i = 0; i < 2; ++i) { stage_rc(tid * 16 + i * 8192, Rr[i], Cc[i]); const int Rb = Epi::PERM ? ((Rr[i] & ~31) + perm32(Rr[i] & 31)) : Rr[i]; voffB[i] = (unsigned)(Rb * K + Cc[i]) * 2u; voffA[i] = (unsigned)(Rr[i] * K + Cc[i]) * 2u; }
    const size_t kstep = (size_t)(BK * 2);
    const size_t hstep = (size_t)HALF * K * 2;
    const unsigned ldsw = (unsigned)wid * 1024u;
    const int aoff = lds_byte(wr * 64 + fr, fq * 8), boff = lds_byte(wc * 32 + fr, fq * 8);
#define PG8_SA(b, h) (((b) * 2 + (h)) * HTB)
#define PG8_SB(b, h) ((4 + (b) * 2 + (h)) * HTB)
#define PG8_STAGE(bufoff, gbase, voff) do { _Pragma("unroll") for (int _i = 0; _i < 2; ++_i) \
        __builtin_amdgcn_global_load_lds((const unsigned*)((const char*)(gbase) + (voff)[_i]), (LAS unsigned*)(lds + (bufoff) + ldsw + _i * 8192), 16, 0, 0); } while (0)
#define PG8_STAGE_A(bufoff, gbase, h, OFFS) do { _Pragma("unroll") for (int _i = 0; _i < 2; ++_i) { \
        const char* _src; if constexpr (GATHER) _src = (const char*)(gbase) + (OFFS)[h][_i]; else _src = (const char*)(gbase) + (size_t)(h) * hstep + voffA[_i]; \
        __builtin_amdgcn_global_load_lds((const unsigned*)_src, (LAS unsigned*)(lds + (bufoff) + ldsw + _i * 8192), 16, 0, 0); } } while (0)
#define PG8_LDA(dst, b, h) do { _Pragma("unroll") for (int m = 0; m < 4; ++m) _Pragma("unroll") for (int k = 0; k < 2; ++k) dst[m][k] = *(const LAS bf16x8*)(lds + PG8_SA(b, h) + aoff + m * 2048 + k * 1024); } while (0)
#define PG8_LDB(dst, b, h) do { _Pragma("unroll") for (int n = 0; n < 2; ++n) _Pragma("unroll") for (int k = 0; k < 2; ++k) dst[n][k] = *(const LAS bf16x8*)(lds + PG8_SB(b, h) + boff + n * 2048 + k * 1024); } while (0)
#define PG8_MMA(ai, bj, At, Bt) do { __builtin_amdgcn_s_setprio(1); _Pragma("unroll") for (int m = 0; m < 4; ++m) _Pragma("unroll") for (int n = 0; n < 2; ++n) _Pragma("unroll") for (int k = 0; k < 2; ++k) \
        acc[ai][bj][m][n] = __builtin_amdgcn_mfma_f32_16x16x32_bf16(Bt[n][k], At[m][k], acc[ai][bj][m][n], 0, 0, 0); __builtin_amdgcn_s_setprio(0); } while (0)
#define PG8_WAIT_V(n) asm volatile("s_waitcnt vmcnt(" #n ")" ::: "memory")
#define PG8_WAIT_L(n) asm volatile("s_waitcnt lgkmcnt(" #n ")" ::: "memory")
#define PG8_BAR __builtin_amdgcn_s_barrier()
#define PG8_SCHED __builtin_amdgcn_sched_barrier(0)
    Unit cur, nxt; int ui = 0;
    if (!S.next(0, cur)) return;
    f32x4 acc[2][2][4][2];
#pragma unroll
    for (int a = 0; a < 2; ++a)
#pragma unroll
        for (int b = 0; b < 2; ++b)
#pragma unroll
            for (int m = 0; m < 4; ++m)
#pragma unroll
                for (int n = 0; n < 2; ++n) acc[a][b][m][n] = (f32x4){0.f, 0.f, 0.f, 0.f};
    bf16x8 At[4][2], B0[2][2], B1[2][2];
    unsigned ao[2][2], nao[2][2];
    if constexpr (GATHER) S.a_offs(cur, Rr, Cc, ao);
    const char* cA = S.a_base(cur); const char* cB = S.b_base(cur);
    PG8_STAGE(PG8_SB(0, 0), cB, voffB); PG8_STAGE(PG8_SB(0, 1), cB + hstep, voffB); PG8_STAGE_A(PG8_SA(0, 0), cA, 0, ao); PG8_STAGE_A(PG8_SA(0, 1), cA, 1, ao);
    if (wr == 1) PG8_BAR;
    PG8_WAIT_V(2); PG8_BAR;
    PG8_STAGE(PG8_SB(1, 0), cB + kstep, voffB); PG8_STAGE_A(PG8_SA(1, 0), cA + kstep, 0, ao); PG8_STAGE(PG8_SB(1, 1), cB + hstep + kstep, voffB);
    PG8_WAIT_V(6); PG8_BAR;
    for (;;) {
        const bool has_next = S.next(ui + 1, nxt);
        const char* nA = cA; const char* nB = cB;
        if (has_next) { if constexpr (GATHER) S.a_offs(nxt, Rr, Cc, nao); nA = S.a_base(nxt); nB = S.b_base(nxt); }
        else if constexpr (GATHER) {
#pragma unroll
            for (int h = 0; h < 2; ++h)
#pragma unroll
                for (int i = 0; i < 2; ++i) nao[h][i] = ao[h][i];
        }
        for (int t = 0; t < nt; t += 2) {
            const bool last = (t == nt - 2);
            const char* a1 = cA + (size_t)(t + 1) * kstep;
            const char* a2 = last ? nA : cA + (size_t)(t + 2) * kstep; const char* b2 = last ? nB : cB + (size_t)(t + 2) * kstep;
            const char* a3 = a2 + kstep; const char* b3 = b2 + kstep;
            unsigned xo[2][2];
            if constexpr (GATHER) {
#pragma unroll
                for (int h = 0; h < 2; ++h)
#pragma unroll
                    for (int i = 0; i < 2; ++i) xo[h][i] = last ? nao[h][i] : ao[h][i];
            }
            PG8_LDB(B0, 0, 0); PG8_LDB(B1, 0, 1); PG8_SCHED; PG8_LDA(At, 0, 0); PG8_STAGE_A(PG8_SA(1, 1), a1, 1, ao);
            PG8_WAIT_V(8); PG8_WAIT_L(0); PG8_BAR; PG8_MMA(0, 0, At, B0); PG8_MMA(0, 1, At, B1); PG8_BAR; PG8_SCHED;
            PG8_LDA(At, 0, 1); PG8_STAGE(PG8_SB(0, 0), b2, voffB); PG8_STAGE(PG8_SB(0, 1), b2 + hstep, voffB); PG8_STAGE_A(PG8_SA(0, 0), a2, 0, xo);
            PG8_WAIT_V(8); PG8_WAIT_L(0); PG8_BAR; PG8_MMA(1, 0, At, B0); PG8_MMA(1, 1, At, B1); PG8_BAR; PG8_SCHED;
            PG8_LDB(B0, 1, 0); PG8_LDB(B1, 1, 1); PG8_SCHED; PG8_LDA(At, 1, 0); PG8_STAGE_A(PG8_SA(0, 1), a2, 1, xo);
            PG8_WAIT_V(8); PG8_WAIT_L(0); PG8_BAR; PG8_MMA(0, 0, At, B0); PG8_MMA(0, 1, At, B1); PG8_BAR; PG8_SCHED;
            PG8_LDA(At, 1, 1); PG8_STAGE(PG8_SB(1, 0), b3, voffB); PG8_STAGE(PG8_SB(1, 1), b3 + hstep, voffB); PG8_STAGE_A(PG8_SA(1, 0), a3, 0, xo);
            PG8_WAIT_V(8); PG8_WAIT_L(0); PG8_BAR; PG8_MMA(1, 0, At, B0); PG8_MMA(1, 1, At, B1); PG8_BAR; PG8_SCHED;
        }
        if constexpr (ALIGN_EPI) { if (wr == 0) PG8_BAR; }
        const bool keep = E(acc, cur, wr, wc, fr, fq);
        if (!has_next) break;
        if (!keep) {
#pragma unroll
            for (int a = 0; a < 2; ++a)
#pragma unroll
                for (int b = 0; b < 2; ++b)
#pragma unroll
                    for (int m = 0; m < 4; ++m)
#pragma unroll
                        for (int n = 0; n < 2; ++n) acc[a][b][m][n] = (f32x4){0.f, 0.f, 0.f, 0.f};
        }
        cur = nxt; cA = nA; cB = nB; ++ui;
        if constexpr (GATHER) {
#pragma unroll
            for (int h = 0; h < 2; ++h)
#pragma unroll
                for (int i = 0; i < 2; ++i) ao[h][i] = nao[h][i];
        }
        if constexpr (ALIGN_EPI) { if (wr == 1) PG8_BAR; }
    }
    PG8_WAIT_V(0);
    if constexpr (!ALIGN_EPI) { if (wr == 0) PG8_BAR; }
    PG8_BAR;
#undef PG8_SA
#undef PG8_SB
#undef PG8_STAGE
#undef PG8_STAGE_A
#undef PG8_LDA
#undef PG8_LDB
#undef PG8_MMA
#undef PG8_WAIT_V
#undef PG8_WAIT_L
#undef PG8_BAR
#undef PG8_SCHED
}
}
namespace attn_body {
using bf16=__hip_bfloat16;
using bf16x8=__attribute__((ext_vector_type(8)))short;
using s16x4=__attribute__((ext_vector_type(4)))short;
using f32x16=__attribute__((ext_vector_type(16)))float;
using u32x4=__attribute__((ext_vector_type(4)))unsigned;
constexpr int BATCH=8,NHEAD=8,SEQ=2048,KVROWS=2112,D=64,DM=NHEAD*D;
constexpr int NW=8,QBLK=32,QB=QBLK*NW,KVBLK=64,NQB=SEQ/QB;
constexpr int ATTN_PITCH=DM, ATTN_UNIT_ROWS=QB;
__device__ __forceinline__ int crow(int r,int hi){return (r&3)+8*(r>>2)+4*hi;}
#define SBAR() __builtin_amdgcn_sched_barrier(0)
__device__ __forceinline__ void cmask(f32x16&p0,f32x16&p1,int jb,int qrel,int hi){
  asm volatile("":"+v"(hi),"+v"(qrel));
  const float NEG=-INFINITY; int kb=64*jb+4*hi;
  #pragma unroll
  for(int r=0;r<16;++r){int kv=kb+(r&3)+8*(r>>2); if(kv>qrel)p0[r]=NEG; if(kv+32>qrel)p1[r]=NEG;}
}

constexpr int NSLOT=3, SLOTB=8192;
constexpr int LDS_K=0, LDS_V=NSLOT*SLOTB, LDS_WS=2*NSLOT*SLOTB, LDS_OST=LDS_WS+NW*64*4, LDS_CBT=LDS_OST+NW*4096, LDS_BYTES=LDS_CBT+KVROWS*4;
constexpr float C2=0.125f*1.4426950408889634f;
__device__ __forceinline__ void glds16(const void*gsrc,unsigned lds_dst){unsigned keep;
  asm volatile("s_mov_b32 %0, m0\n\ts_mov_b32 m0, %2\n\ts_nop 0\n\tglobal_load_lds_dwordx4 %1, off\n\ts_mov_b32 m0, %0":"=&s"(keep):"v"(gsrc),"s"(lds_dst):"memory");}
__device__ __forceinline__ float max3f(float a,float b,float c){float r;asm("v_max3_f32 %0, %1, %2, %3":"=v"(r):"v"(a),"v"(b),"v"(c));return r;}
__device__ __forceinline__ float max2f(float a,float b){float r;asm("v_max_f32_e32 %0, %1, %2":"=v"(r):"v"(a),"v"(b));return r;}
__device__ __forceinline__ float fadd_s(float a,float b){float r;asm("v_add_f32_e32 %0, %1, %2":"=v"(r):"v"(a),"v"(b));return r;}
__device__ __forceinline__ float fsub_s(float a,float b){float r;asm("v_sub_f32_e32 %0, %1, %2":"=v"(r):"v"(a),"v"(b));return r;}
typedef float f32x2_t __attribute__((ext_vector_type(2))); typedef float f32x4_t __attribute__((ext_vector_type(4))); typedef __bf16 bf16x2_t __attribute__((ext_vector_type(2)));
__device__ __forceinline__ unsigned cvtpk_s(float lo,float hi){f32x2_t v={lo,hi};bf16x2_t b=__builtin_convertvector(v,bf16x2_t);return __builtin_bit_cast(unsigned,b);}
#define WAIT_BAR(N) asm volatile("s_waitcnt vmcnt(" #N ") lgkmcnt(0)\n\ts_barrier":::"memory")

__device__ __forceinline__ void qkt(f32x16&p0,f32x16&p1,const char*Kslot,const bf16x8*qr,const f32x16&negm,int r32,int hi){
  const char*kb=Kslot+hi*1024+r32*16;
  #pragma unroll
  for(int d0=0;d0<4;++d0){
    const bf16x8 b0=*reinterpret_cast<const bf16x8*>(kb+d0*2048);
    const bf16x8 b1=*reinterpret_cast<const bf16x8*>(kb+d0*2048+512);
    if(d0==0){p0=__builtin_amdgcn_mfma_f32_32x32x16_bf16(b0,qr[0],negm,0,0,0);p1=__builtin_amdgcn_mfma_f32_32x32x16_bf16(b1,qr[0],negm,0,0,0);}
    else{p0=__builtin_amdgcn_mfma_f32_32x32x16_bf16(b0,qr[d0],p0,0,0,0);p1=__builtin_amdgcn_mfma_f32_32x32x16_bf16(b1,qr[d0],p1,0,0,0);}}
}
typedef __attribute__((address_space(3))) const char* lds_cptr;
typedef short v4i16_t __attribute__((ext_vector_type(4)));
__device__ __forceinline__ void kload8(bf16x8*kf,lds_cptr kp){
  kf[0]=*(const __attribute__((address_space(3))) bf16x8*)(kp);      kf[1]=*(const __attribute__((address_space(3))) bf16x8*)(kp+512);
  kf[2]=*(const __attribute__((address_space(3))) bf16x8*)(kp+2048); kf[3]=*(const __attribute__((address_space(3))) bf16x8*)(kp+2560);
  kf[4]=*(const __attribute__((address_space(3))) bf16x8*)(kp+4096); kf[5]=*(const __attribute__((address_space(3))) bf16x8*)(kp+4608);
  kf[6]=*(const __attribute__((address_space(3))) bf16x8*)(kp+6144); kf[7]=*(const __attribute__((address_space(3))) bf16x8*)(kp+6656);
}
__device__ __forceinline__ void kload2(bf16x8*kf,lds_cptr kp,int j){ kf[2*j]=*(const __attribute__((address_space(3))) bf16x8*)(kp+j*2048); kf[2*j+1]=*(const __attribute__((address_space(3))) bf16x8*)(kp+j*2048+512); }
__device__ __forceinline__ s16x4 vtr(lds_cptr p){ return __builtin_bit_cast(s16x4,__builtin_amdgcn_ds_read_tr16_b64_v4i16((__attribute__((address_space(3))) v4i16_t*)p)); }
__device__ __forceinline__ float rowmax(const f32x16&p0,const f32x16&p1){
  float a=max3f(p0[0],p0[1],p1[0]),b=max3f(p0[2],p0[3],p1[1]);a=max3f(a,p1[2],p1[3]);
  #pragma unroll
  for(int r=4;r<16;r+=4){a=max3f(a,p0[r],p0[r+1]);b=max3f(b,p0[r+2],p0[r+3]);a=max3f(a,p1[r],p1[r+1]);b=max3f(b,p1[r+2],p1[r+3]);}
  const float m=max2f(a,b);
  auto rr=__builtin_amdgcn_permlane32_swap(__float_as_uint(m),__float_as_uint(m),false,false);
  return max2f(__uint_as_float(rr[0]),__uint_as_float(rr[1]));
}
__device__ __forceinline__ void pv(f32x16*o,int vb,bf16x8 pa0,bf16x8 pa1,bf16x8 pa2,bf16x8 pa3){
  #pragma unroll
  for(int d0=0;d0<2;++d0){s16x4 lo[4],hi[4];
    #pragma unroll
    for(int ks=0;ks<4;++ks){
      asm volatile("ds_read_b64_tr_b16 %0,%1 offset:%c2":"=&v"(lo[ks]):"v"(vb),"i"(d0*4096+ks*1024):"memory");
      asm volatile("ds_read_b64_tr_b16 %0,%1 offset:%c2":"=&v"(hi[ks]):"v"(vb),"i"(d0*4096+ks*1024+512):"memory");}
    asm volatile("s_waitcnt lgkmcnt(0)":::"memory");SBAR();
    #define PK(k) (bf16x8){lo[k][0],lo[k][1],lo[k][2],lo[k][3],hi[k][0],hi[k][1],hi[k][2],hi[k][3]}
    o[d0]=__builtin_amdgcn_mfma_f32_32x32x16_bf16(pa0,PK(0),o[d0],0,0,0);
    o[d0]=__builtin_amdgcn_mfma_f32_32x32x16_bf16(pa1,PK(1),o[d0],0,0,0);
    o[d0]=__builtin_amdgcn_mfma_f32_32x32x16_bf16(pa2,PK(2),o[d0],0,0,0);
    o[d0]=__builtin_amdgcn_mfma_f32_32x32x16_bf16(pa3,PK(3),o[d0],0,0,0);
    #undef PK
  }
}

#ifndef ATTN_STORE16
#define ATTN_STORE16(p,v) (*(u32x4*)(p)=(v))
#endif
template<int THRL> __device__ __forceinline__ void attn_unit(int b,int h,int qb,const bf16*Q,const bf16*__restrict__ K,const bf16*__restrict__ V,bf16*O,const float*__restrict__ CB,char*shm){
  const int tid=threadIdx.x,lane=tid&63,r32=lane&31,hi=lane>>5; const int wid=__builtin_amdgcn_readfirstlane(tid>>6);
  const long rowbase=(long)b*SEQ, kvbase=(long)b*KVROWS; const int q0=qb*QB;
  const bf16*Qw=Q+(rowbase+q0+wid*QBLK)*DM+h*D;
  const bf16*Kh=K+kvbase*DM+h*D,*Vh=V+kvbase*DM+h*D;
  const unsigned lds0=(unsigned)(uintptr_t)shm;
  float*wsf=(float*)(shm+LDS_WS)+wid*64;
  const bf16*ksrc=Kh+(long)lane*DM+wid*8;
  const bf16*vsrc=Vh+(long)(16*(wid&3)+(lane>>2))*DM+(wid>>2)*32+(lane&3)*8;
  const unsigned kdst=lds0+LDS_K+wid*1024, vdst=lds0+LDS_V+wid*1024;
  #define DMA_K(t,slot) glds16(ksrc+(long)(t)*KVBLK*DM,(unsigned)__builtin_amdgcn_readfirstlane(kdst+(slot)))
  #define DMA_V(t,slot) glds16(vsrc+(long)(t)*KVBLK*DM,(unsigned)__builtin_amdgcn_readfirstlane(vdst+(slot)))
  const int vb0=(int)(lds0+LDS_V)+((lane>>4)&1)*32+(lane&3)*8+(4*hi+((lane&15)>>2))*64;
  const char*Kbase=shm+LDS_K; bf16x8 kf[8];
  const lds_cptr shm3=(lds_cptr)shm; const lds_cptr kp0=shm3+LDS_K+hi*1024+r32*16; const lds_cptr vp0=shm3+LDS_V+((lane>>4)&1)*32+(lane&3)*8+(4*hi+((lane&15)>>2))*64;
  const int NT=(q0+QB)/KVBLK+1;
  typedef __attribute__((address_space(3))) float* lds_fptr; const lds_fptr cbt=(lds_fptr)(shm+LDS_CBT);
  { const float*cbg=CB+(long)(b*NHEAD+h)*KVROWS; const float ref=cbg[64+q0]; for(int i=tid;i<NT*KVBLK;i+=NW*64)cbt[i]=cbg[i]-ref; }
  DMA_K(0,0);DMA_V(0,0);DMA_K(1,SLOTB);
  bf16x8 qr[4];
  #pragma unroll
  for(int d0=0;d0<4;++d0)qr[d0]=*reinterpret_cast<const bf16x8*>(&Qw[(long)r32*DM+d0*16+hi*8]);
  float mhat=0.f,l_reg=0.f;f32x16 o[2];o[0]=f32x16{};o[1]=f32x16{};const f32x16 zero16=f32x16{}; f32x16 negm=f32x16{};
  const int qrel=wid*QBLK+r32;
  #define CMASK(P0,P1,t) do{int jb_=(t)-(NT-4); if(jb_>=0)cmask(P0,P1,jb_,qrel,hi);}while(0)
  typedef __attribute__((address_space(3))) const f32x4_t* lds_f4ptr;
  #define BIAS(P0,P1,t) do{ const lds_f4ptr bp_=(lds_f4ptr)(cbt+64*(t)+4*hi); \
    _Pragma("unroll") for(int g_=0;g_<4;++g_){ const f32x4_t b0_=bp_[2*g_], b1_=bp_[8+2*g_]; \
      _Pragma("unroll") for(int j_=0;j_<4;++j_){ P0[4*g_+j_]+=b0_[j_]; P1[4*g_+j_]+=b1_[j_]; } } }while(0)
  bool resc=false;
  #define START(P0,P1) do{ const float rm=rowmax(P0,P1); resc=false; \
    { const float dl=__builtin_fmaxf(rm,0.f); mhat=fadd_s(mhat,dl); _Pragma("unroll") for(int r=0;r<16;++r)negm[r]=-mhat; asm volatile("":"+v"(negm)); \
      _Pragma("unroll") for(int r=0;r<16;++r){P0[r]=fsub_s(P0[r],dl);P1[r]=fsub_s(P1[r],dl);} \
      } \
    _Pragma("unroll") for(int r=0;r<16;++r)P0[r]=__builtin_amdgcn_exp2f(P0[r]); }while(0)
  #define RESC() do{ if(resc){ asm volatile("s_waitcnt lgkmcnt(0)":::"memory"); \
      _Pragma("unroll") for(int d_=0;d_<2;++d_) _Pragma("unroll") for(int r=0;r<16;++r)o[d_][r]*=wsf[crow(r,hi)]; } }while(0)
  f32x16 pA0,pA1,pB0,pB1;
  int sl_prev=0,sl_cur=0,sl_next=SLOTB;
  #define ROT() do{sl_prev=sl_cur;sl_cur=sl_next;sl_next=(sl_next==(NSLOT-1)*SLOTB)?0:sl_next+SLOTB;}while(0)
  DMA_K(2,2*SLOTB);
  WAIT_BAR(3);
  mhat=cbt[64+q0+qrel]+14.0f; _Pragma("unroll") for(int r=0;r<16;++r)negm[r]=-mhat; asm volatile("":"+v"(negm));
  qkt(pA0,pA1,Kbase,qr,negm,r32,hi);asm volatile("s_nop 15\n\ts_nop 7":"+v"(pA0),"+v"(pA1));BIAS(pA0,pA1,0);CMASK(pA0,pA1,0);
  START(pA0,pA1);
  _Pragma("unroll") for(int r=0;r<16;++r)pA1[r]=__builtin_amdgcn_exp2f(pA1[r]);
  WAIT_BAR(0);
  DMA_K(3,0);DMA_V(1,SLOTB);
  ROT();
  kload8(kf,kp0+sl_cur);
  WAIT_BAR(2);
  s16x4 vlo[8],vhi[8]; u32x4 pw0,pw1,pw2,pw3;
  #define PKW(P,B) cvtpk_s(P[B],P[B+1])
  #define PAF(k) __builtin_bit_cast(bf16x8,pw##k)
  #define VFR(i) (bf16x8){vlo[i][0],vlo[i][1],vlo[i][2],vlo[i][3],vhi[i][0],vhi[i][1],vhi[i][2],vhi[i][3]}
  #define PIN(x) asm volatile("":"+v"(x))
  #define MX3(a,b,c) __builtin_fmaxf(__builtin_fmaxf((a),(b)),(c))
  #define GAPA(MF,A0,A1,A2,A3,W0,W1,PW) do{ MF; sacc+=A0; sacc+=A1; sacc+=A2; sacc+=A3; PIN(sacc); W0; W1; PIN(PW); SBAR(); }while(0)
  #define EX(v) __builtin_amdgcn_exp2f(v)
  #define GAPB(MF,X,B) do{ MF; X[B]=EX(X[B]); X[B+1]=EX(X[B+1]); X[B+2]=EX(X[B+2]); X[B+3]=EX(X[B+3]); PIN(X); SBAR(); }while(0)
  #define VRD(i) do{ vlo[i]=vtr(vp_+(((i)>>2)*4096+((i)&3)*1024)); vhi[i]=vtr(vp_+(((i)>>2)*4096+((i)&3)*1024+512)); }while(0)
  #define KRD(G,j) do{ if(G){ kload2(kf,kp0+sl_next,j); SBAR(); } }while(0)
  #define STEP(C0,C1,P0,P1,t,GK,GV,GL) do{ SBAR(); \
    const lds_cptr vp_=vp0+sl_prev; \
    VRD(0); SBAR(); float sacc=(P0[0]+P0[1]); \
    GAPA(C0=__builtin_amdgcn_mfma_f32_32x32x16_bf16(kf[0],qr[0],negm,0,0,0), P0[2],P0[3],P0[4],P0[5],     pw0[0]=PKW(P0,0), pw0[1]=PKW(P0,2), pw0); \
    VRD(4); SBAR(); GAPA(C1=__builtin_amdgcn_mfma_f32_32x32x16_bf16(kf[1],qr[0],negm,0,0,0), P0[6],P0[7],P0[8],P0[9],     pw0[2]=PKW(P0,4), pw0[3]=PKW(P0,6), pw0); \
    VRD(1); SBAR(); GAPA(C0=__builtin_amdgcn_mfma_f32_32x32x16_bf16(kf[2],qr[1],C0,0,0,0),   P0[10],P0[11],P0[12],P0[13], pw1[0]=PKW(P0,8), pw1[1]=PKW(P0,10), pw1); \
    VRD(5); SBAR(); GAPA(C1=__builtin_amdgcn_mfma_f32_32x32x16_bf16(kf[3],qr[1],C1,0,0,0),   P0[14],P0[15],P1[0],P1[1],   pw1[2]=PKW(P0,12),pw1[3]=PKW(P0,14), pw1); \
    VRD(2); SBAR(); GAPA(C0=__builtin_amdgcn_mfma_f32_32x32x16_bf16(kf[4],qr[2],C0,0,0,0),   P1[2],P1[3],P1[4],P1[5],     pw2[0]=PKW(P1,0), pw2[1]=PKW(P1,2), pw2); \
    VRD(6); SBAR(); GAPA(C1=__builtin_amdgcn_mfma_f32_32x32x16_bf16(kf[5],qr[2],C1,0,0,0),   P1[6],P1[7],P1[8],P1[9],     pw2[2]=PKW(P1,4), pw2[3]=PKW(P1,6), pw2); \
    VRD(3); SBAR(); GAPA(C0=__builtin_amdgcn_mfma_f32_32x32x16_bf16(kf[6],qr[3],C0,0,0,0),   P1[10],P1[11],P1[12],P1[13], pw3[0]=PKW(P1,8), pw3[1]=PKW(P1,10), pw3); \
    VRD(7); SBAR(); GAPA(C1=__builtin_amdgcn_mfma_f32_32x32x16_bf16(kf[7],qr[3],C1,0,0,0),   P1[14],P1[15],0.f,0.f,       pw3[2]=PKW(P1,12),pw3[3]=PKW(P1,14), pw3); \
    l_reg+=sacc; \
    if(GK){DMA_K((t)+3,sl_cur);} if(GV){DMA_V((t)+1,sl_next);} \
    BIAS(C0,C1,t); CMASK(C0,C1,t); \
    { float rm=__builtin_fmaxf(__builtin_fmaxf(C0[0],C0[15]),__builtin_fmaxf(C1[0],C1[15]));   \
      resc=false; \
      if(__builtin_expect(__any(rm>(float)THRL),0)){ const float dl=__builtin_fmaxf(rm,0.f); mhat+=dl; _Pragma("unroll") for(int r=0;r<16;++r)negm[r]=-mhat; asm volatile("":"+v"(negm)); \
        _Pragma("unroll") for(int r=0;r<16;++r){C0[r]-=dl;C1[r]-=dl;} \
        const float f=__builtin_amdgcn_exp2f(-dl); l_reg*=f; if(hi==0)wsf[r32]=f; resc=true; } } \
    SBAR(); \
    GAPB(o[0]=__builtin_amdgcn_mfma_f32_32x32x16_bf16(PAF(0),VFR(0),o[0],0,0,0), C0,0); \
    GAPB(o[1]=__builtin_amdgcn_mfma_f32_32x32x16_bf16(PAF(0),VFR(4),o[1],0,0,0), C0,4); \
    KRD(GL,0); GAPB(o[0]=__builtin_amdgcn_mfma_f32_32x32x16_bf16(PAF(1),VFR(1),o[0],0,0,0), C0,8); \
    KRD(GL,1); GAPB(o[1]=__builtin_amdgcn_mfma_f32_32x32x16_bf16(PAF(1),VFR(5),o[1],0,0,0), C0,12); \
    KRD(GL,2); GAPB(o[0]=__builtin_amdgcn_mfma_f32_32x32x16_bf16(PAF(2),VFR(2),o[0],0,0,0), C1,0); \
    KRD(GL,3); GAPB(o[1]=__builtin_amdgcn_mfma_f32_32x32x16_bf16(PAF(2),VFR(6),o[1],0,0,0), C1,4); \
    GAPB(o[0]=__builtin_amdgcn_mfma_f32_32x32x16_bf16(PAF(3),VFR(3),o[0],0,0,0), C1,8); \
    GAPB(o[1]=__builtin_amdgcn_mfma_f32_32x32x16_bf16(PAF(3),VFR(7),o[1],0,0,0), C1,12); \
    }while(0)
  int t=1;
  #undef CMASK
  #define CMASK(P0,P1,t) do{}while(0)
  for(;t+5<NT;t+=2){
    STEP(pB0,pB1,pA0,pA1,t,true,true,true);     WAIT_BAR(2); RESC(); ROT();
    STEP(pA0,pA1,pB0,pB1,t+1,true,true,true);   WAIT_BAR(2); RESC(); ROT();
  }
  #undef CMASK
  #define CMASK(P0,P1,t) do{int jb_=(t)-(NT-4); if(jb_>=0)cmask(P0,P1,jb_,qrel,hi);}while(0)
  #define ENDW(tt) do{ if((tt)+3<NT){WAIT_BAR(2);} else if((tt)+2<NT){WAIT_BAR(1);} else {WAIT_BAR(0);} }while(0)
  for(;t+2<NT;t+=2){
    STEP(pB0,pB1,pA0,pA1,t,(t+3<NT),(t+1<NT),(t+1<NT));       ENDW(t);   RESC(); ROT();
    STEP(pA0,pA1,pB0,pB1,t+1,(t+4<NT),(t+2<NT),(t+2<NT));     ENDW(t+1); RESC(); ROT();
  }
  STEP(pB0,pB1,pA0,pA1,NT-2,false,true,true); ENDW(NT-2); RESC(); ROT();
  STEP(pA0,pA1,pB0,pB1,NT-1,false,false,false); RESC();
  { float sacc=pA0[0]+pA0[1]; _Pragma("unroll") for(int r=2;r<16;++r)sacc+=pA0[r]; _Pragma("unroll") for(int r=0;r<16;++r)sacc+=pA1[r]; l_reg+=sacc;
    pw0=(u32x4){PKW(pA0,0),PKW(pA0,2),PKW(pA0,4),PKW(pA0,6)};pw1=(u32x4){PKW(pA0,8),PKW(pA0,10),PKW(pA0,12),PKW(pA0,14)};pw2=(u32x4){PKW(pA1,0),PKW(pA1,2),PKW(pA1,4),PKW(pA1,6)};pw3=(u32x4){PKW(pA1,8),PKW(pA1,10),PKW(pA1,12),PKW(pA1,14)};
    SBAR(); pv(o,vb0+sl_cur,PAF(0),PAF(1),PAF(2),PAF(3)); }
  #undef PKW
  #undef PAF
  #undef VFR
  #undef PIN
  #undef MX3
  #undef GAPA
  #undef GAPB
  #undef EX
  #undef VRD
  #undef KRD
  #undef STEP
  #undef ENDW
  {auto rr=__builtin_amdgcn_permlane32_swap(__float_as_uint(l_reg),__float_as_uint(l_reg),false,false);l_reg=__uint_as_float(rr[0])+__uint_as_float(rr[1]);}
  if(hi==0)wsf[32+r32]=l_reg;asm volatile("s_waitcnt lgkmcnt(0)":::"memory");
  float rli[16];
  #pragma unroll
  for(int r=0;r<16;++r)rli[r]=__builtin_amdgcn_rcpf(wsf[32+crow(r,hi)]);
  bf16*Ow=O+(rowbase+q0+wid*QBLK)*DM+h*D;
  { bf16*stg=(bf16*)(shm+LDS_OST)+wid*2048;
    #pragma unroll
    for(int r=0;r<16;++r){const int orow=crow(r,hi);
      #pragma unroll
      for(int d0=0;d0<2;++d0)stg[orow*64+d0*32+r32]=__float2bfloat16(o[d0][r]*rli[r]);}
    asm volatile("s_waitcnt lgkmcnt(0)":::"memory");
    #pragma unroll
    for(int i=0;i<4;++i){const int row=i*8+(lane>>3),ch=lane&7; const u32x4 v=*(const u32x4*)(stg+row*64+ch*8); ATTN_STORE16(Ow+(long)row*DM+ch*8,v);} }
  asm volatile("s_waitcnt lgkmcnt(0)\n\ts_barrier":::"memory");
  #undef DMA_K
  #undef DMA_V
  #undef CMASK
  #undef BIAS
  #undef START
  #undef RESC
  #undef ROT
}
constexpr int ATTN_LDS_BYTES=LDS_BYTES;
#undef SBAR
#undef WAIT_BAR
}

constexpr int NWAVES = 8;
#ifndef MK_N_LAUNCHES
#define MK_N_LAUNCHES 1
#endif
constexpr int N_PHASES = 9;
constexpr int DM = 1024, NB = 8, SEQ = 2048, NMETA = 16, NR = NB * SEQ, NRX = NR + 256;
constexpr int CWID = 512, CK = 31, NH = 8, HD = 64;
constexpr int INCOLS = 4616, N1 = 4608, FCOL = 2560, GCOL = 2568;
constexpr int NE = 64, DE = 256, MOE_CAP = NR, MAXT = 192;
constexpr int AROWS = 2080, KROWS = 2112;
constexpr float RMS_EPS = 1e-6f, LN_EPS = 1e-5f;
constexpr float LOG2E = 1.4426950408889634f;
constexpr float C2 = 0.125f * LOG2E;
constexpr float NEGBIG = -1e30f;

constexpr size_t MiB = 1u << 20;
constexpr size_t WS_CTL = 0, CTL_ZERO_BYTES = 1 * MiB;
constexpr size_t WS_BIAS1 = 1 * MiB, WS_WR = 1 * MiB + 32 * 1024, WS_RS = 1 * MiB + 512 * 1024;
constexpr size_t WS_W1T = 2 * MiB, WS_WCT = 11 * MiB, WS_WAT = 12 * MiB, WS_WOT = 13 * MiB, WS_WGU = 15 * MiB, WS_WD = 79 * MiB;
constexpr size_t WS_XN = 111 * MiB;
constexpr size_t WS_ABUF = 144 * MiB, WS_CACT = 161 * MiB;
constexpr size_t WS_QO = 177 * MiB, WS_KX = 193 * MiB, WS_VX = 210 * MiB;
constexpr size_t WS_CB = 227 * MiB, WS_LOGF = 228 * MiB, WS_TOK = 229 * MiB, WS_WL = 233 * MiB, WS_O = 237 * MiB, WS_END = 269 * MiB;
constexpr int CW_TMO = 0, CW_CODE = 1, CW_BAR = 4096, CW_CNT = 8192;

constexpr int RING_BYTES = 131072, LDSCTL_OFF = RING_BYTES, MISC_OFF = LDSCTL_OFF + 320, TAB_OFF = RING_BYTES + 1024;
constexpr int LDS_BYTES = 147456;

typedef GAS unsigned gu32;
#define RLX_AGENT __ATOMIC_RELAXED, __HIP_MEMORY_SCOPE_AGENT
#define LDS_WAIT() asm volatile("s_waitcnt lgkmcnt(0)" ::: "memory")
#define VM_WAIT() asm volatile("s_waitcnt vmcnt(0)" ::: "memory")
#define XB_TMO      128
#define XB_XCNT(j)  (256  + 64 * (j))
#define XB_XSUB(j)  (1280 + 64 * (j))
#define XB_XGEN(j)  (2304 + 64 * (j))
#define XB_TOP      3328
#define XB_TOPGEN   3392
#define XCD_BAR_WORDS 3456
#define XB_SPIN_CAP (1u << 18)

__device__ __forceinline__ unsigned xb_ld(unsigned* p)              { return __hip_atomic_load(p, __ATOMIC_RELAXED, __HIP_MEMORY_SCOPE_AGENT); }
__device__ __forceinline__ unsigned xb_add(unsigned* p, unsigned v) { return __hip_atomic_fetch_add(p, v, __ATOMIC_RELAXED, __HIP_MEMORY_SCOPE_AGENT); }
__device__ __forceinline__ unsigned xb_xcc_id() { return (unsigned)__builtin_amdgcn_s_getreg((3 << 11) | 20) & 0xFu; }
#define XB_SPIN(cond, bar) do { unsigned _sp = 0; while (cond) { __builtin_amdgcn_s_sleep(1); \
    if ((++_sp & 255u) == 0u) { if (xb_ld(&(bar)[XB_TMO])) break; if (_sp > XB_SPIN_CAP) { atomicAdd(&(bar)[XB_TMO], 1u); break; } } } } while (0)

struct XcdBarrier {
    unsigned* bar; unsigned x;
    volatile LAS unsigned* st;
};

__device__ __forceinline__ XcdBarrier xcd_barrier_post(unsigned* bar, volatile LAS unsigned* st) {
    XcdBarrier b; b.bar = bar; b.x = xb_xcc_id(); b.st = st;
    if (threadIdx.x == 0) (void)xb_add(&bar[XB_XCNT(b.x)], 1u);
    return b;
}
__device__ __forceinline__ void xcd_barrier_complete(unsigned* bar, unsigned x, unsigned& nloc, unsigned& nx) {
    const unsigned G = gridDim.x * gridDim.y * gridDim.z;
    unsigned sum, cnt, mine, sp = 0u;
    for (;;) {
        sum = 0u; cnt = 0u; mine = 0u;
#pragma unroll
        for (unsigned j = 0; j < 16; ++j) { const unsigned c = xb_ld(&bar[XB_XCNT(j)]); sum += c; cnt += (c > 0u) ? 1u : 0u; mine = (j == x) ? c : mine; }
        if (sum == G) break;
        __builtin_amdgcn_s_sleep(1);
        if ((++sp & 255u) == 0u) { if (xb_ld(&bar[XB_TMO])) break; if (sp > XB_SPIN_CAP) { atomicAdd(&bar[XB_TMO], 1u); break; } }
    }
    nloc = mine > 0u ? mine : 1u; nx = cnt > 0u ? cnt : 1u;
}

__device__ __forceinline__ void xcd_barrier(const XcdBarrier& b) {
    asm volatile("s_waitcnt vmcnt(0)" ::: "memory");
    __syncthreads();
    if (threadIdx.x == 0) {
        unsigned* bar = b.bar;
        __builtin_amdgcn_s_waitcnt(0);
        unsigned nloc = b.st[0], nx = b.st[1];
        if (nloc == 0u) { xcd_barrier_complete(bar, b.x, nloc, nx); b.st[0] = nloc; b.st[1] = nx; }
        const unsigned old = xb_add(&bar[XB_XSUB(b.x)], 1u);
        const unsigned gen = old / nloc;
        if (old + 1u == (gen + 1u) * nloc) {
            __builtin_amdgcn_fence(__ATOMIC_RELEASE, "agent");
            asm volatile("s_waitcnt vmcnt(0)" ::: "memory");
            const unsigned og = xb_add(&bar[XB_TOP], 1u);
            const unsigned tg = og / nx;
            if (og + 1u == (tg + 1u) * nx) xb_add(&bar[XB_TOPGEN], 1u);
            else XB_SPIN(xb_ld(&bar[XB_TOPGEN]) == tg, bar);
            __builtin_amdgcn_fence(__ATOMIC_ACQUIRE, "agent");
            xb_add(&bar[XB_XGEN(b.x)], 1u);
            asm volatile("s_waitcnt vmcnt(0)" ::: "memory");
        } else {
            XB_SPIN(xb_ld(&bar[XB_XGEN(b.x)]) == gen, bar);
            __builtin_amdgcn_fence(__ATOMIC_ACQUIRE, "agent");
            asm volatile("s_waitcnt vmcnt(0)" ::: "memory");
        }
    }
    __syncthreads();
}

struct Frame {
    LAS unsigned char* lds;
    volatile LAS unsigned* MISC;
    unsigned* ctl;
    int tid, lane, wave, vcu, G;
    const float *x, *meta, *norm1_g, *w_in, *b_in, *dw_w, *dw_b, *ln_g, *ln_b, *w_conv_out, *b_conv_out, *q_norm_g, *k_norm_g, *b_forget,
                *w_attn_out, *w_out, *norm2_g, *w_group, *b_group, *w_router, *b_router, *w_gate, *w_up, *w_down;
    float* out;
    float *BIAS1, *RS, *CB, *LOGF, *WL; bf16_t *WRH, *WRL;
    int* TOK;
    bf16_t *W1T, *WCT, *WAT, *WOT, *WGU, *WD, *XN, *MERGED, *ABUF, *CACT, *HN, *QO, *KX, *VX, *HB, *SG, *YB, *OB;
};

__device__ __forceinline__ float wave_sum(float v) {
#pragma unroll
    for (int o = 1; o < 64; o <<= 1) v += __shfl_xor(v, o);
    return v;
}

__device__ __forceinline__ int col1(int p) {
    const int pn = p >> 8, q = p & 255, bj = q >> 7, y = q & 127;
    if (pn < 4) return 128 * pn + y + 512 * bj;
    if (pn < 8) { const int wc = y >> 5, xx = y & 31, head = 4 * (pn & 1) + wc, dim = 32 * bj + xx; return (pn < 6 ? 1024 : 1536) + 64 * head + dim; }
    if (pn < 10) return 2048 + 256 * (pn - 8) + q;
    return GCOL + 256 * (pn - 10) + q;
}

__device__ __forceinline__ void tr_item(const float* W, int ldw, int k0, int n0, bf16_t* WT, int ldk, int row0, LAS float* scr, int lane) {
    { f32x4 v[8];
#pragma unroll
      for (int i = 0; i < 8; ++i) v[i] = *(const f32x4*)(W + (size_t)(k0 + 8 * i + (lane >> 3)) * ldw + n0 + 4 * (lane & 7));
#pragma unroll
      for (int i = 0; i < 8; ++i) { LAS float* d = scr + (8 * i + (lane >> 3)) * 33 + 4 * (lane & 7); d[0] = v[i][0]; d[1] = v[i][1]; d[2] = v[i][2]; d[3] = v[i][3]; } }
    LDS_WAIT(); asm volatile("" ::: "memory");
    const int c = lane & 7;
#pragma unroll
    for (int j = 0; j < 4; ++j) { const int n = (lane >> 3) + 8 * j; const LAS float* s = scr + (8 * c) * 33 + n;
        u32x4 o; o.x = cvt_pk_bf16(s[0 * 33], s[1 * 33]); o.y = cvt_pk_bf16(s[2 * 33], s[3 * 33]); o.z = cvt_pk_bf16(s[4 * 33], s[5 * 33]); o.w = cvt_pk_bf16(s[6 * 33], s[7 * 33]);
        *(u32x4*)(WT + (size_t)(row0 + n) * ldk + k0 + 8 * c) = o; }
    LDS_WAIT(); asm volatile("" ::: "memory");
}

__device__ __forceinline__ float log_sigmoid_(float z) { return z >= 0.f ? -log1pf(expf(-z)) : z - log1pf(expf(z)); }

__device__ __forceinline__ void p0_prologue(Frame& F) {
    LAS float* scr = (LAS float*)(F.lds + F.wave * 16384);
    const int gw = F.vcu * NWAVES + F.wave, NGW = F.G * NWAVES;
    constexpr int I_IN = 16 * 144, I_C = 8 * 32, I_O = 16 * 32;
    constexpr int NITEMS = I_IN + 2 * I_C + I_O;
    for (int it = gw; it < NITEMS; it += NGW) {
        int r = it;
        if (r < I_IN) { const int kb = r / 144, pb = r % 144; tr_item(F.w_in, INCOLS, 64 * kb, col1(32 * pb), F.W1T, 1024, 32 * pb, scr, F.lane); continue; } r -= I_IN;
        if (r < I_C) { tr_item(F.w_conv_out, 1024, 64 * (r / 32), 32 * (r % 32), F.WCT, 512, 32 * (r % 32), scr, F.lane); continue; } r -= I_C;
        if (r < I_C) { tr_item(F.w_attn_out, 1024, 64 * (r / 32), 32 * (r % 32), F.WAT, 512, 32 * (r % 32), scr, F.lane); continue; } r -= I_C;
        { tr_item(F.w_out, 1024, 64 * (r / 32), 32 * (r % 32), F.WOT, 1024, 32 * (r % 32), scr, F.lane); }
    }
    const int gt = F.vcu * (NWAVES * 64) + F.tid, NGT = F.G * NWAVES * 64;
    for (int p = gt; p < N1; p += NGT) F.BIAS1[p] = F.b_in[col1(p)];
    for (int i = gt; i < 1024 * 80; i += NGT) { const int c = i >> 10, k = i & 1023; float w = 0.f;
        if (c < 8) w = F.w_group[k * 8 + c]; else if (c < 72) w = F.w_router[k * 64 + (c - 8)];
        w *= F.norm2_g[k];
        const unsigned hi = cvt_pk_bf16(w, 0.f) & 0xffffu; const float rem = w - __uint_as_float(hi << 16);
        F.WRH[i] = (bf16_t)hi; F.WRL[i] = (bf16_t)(cvt_pk_bf16(rem, 0.f) & 0xffffu); }
    const u32x4 z4 = (u32x4){0u, 0u, 0u, 0u};
    for (int i = gt; i < NB * 16 * 64; i += NGT) { const int b = i / (16 * 64), r = (i / 64) % 16, c = i % 64; *(u32x4*)(F.ABUF + ((size_t)(b * AROWS + r)) * 512 + 8 * c) = z4; }
    for (int i = gt; i < NB * 48 * 64; i += NGT) { const int b = i / (48 * 64), r = (i / 64) % 48, c = i % 64;
        *(u32x4*)(F.KX + ((size_t)(b * KROWS + r)) * 512 + 8 * c) = z4; *(u32x4*)(F.VX + ((size_t)(b * KROWS + r)) * 512 + 8 * c) = z4; }
    __syncthreads();
    { LAS f32x4* wl = (LAS f32x4*)F.lds;
      for (int r = F.tid; r < 1024; r += NWAVES * 64) { const float* wp = F.w_in + (size_t)r * INCOLS + FCOL; wl[2 * r] = *(const f32x4*)wp; wl[2 * r + 1] = *(const f32x4*)(wp + 4); } }
    __syncthreads();
    if (gw < NR + NMETA) {
        f32x4 wf[4][4][2];
#pragma unroll
        for (int j = 0; j < 4; ++j)
#pragma unroll
            for (int jj = 0; jj < 4; ++jj) { const LAS f32x4* wp = (const LAS f32x4*)F.lds + 2 * (4 * F.lane + 256 * j + jj); wf[j][jj][0] = wp[0]; wf[j][jj][1] = wp[1]; }
        f32x4 g1[4];
#pragma unroll
        for (int j = 0; j < 4; ++j) g1[j] = *(const f32x4*)(F.norm1_g + 4 * F.lane + 256 * j);
        for (int m0 = gw; m0 < NR + NMETA; m0 += 2 * NGW) {
            f32x4 v[2][4]; float s[2], d[2][8]; bool ok[2];
#pragma unroll
            for (int u = 0; u < 2; ++u) { const int m = m0 + u * NGW; ok[u] = m < NR + NMETA; const int mm = ok[u] ? m : m0;
                const float* xrow = mm < NR ? F.x + (size_t)mm * DM : F.meta + (size_t)(mm - NR) * DM;
#pragma unroll
                for (int j = 0; j < 4; ++j) v[u][j] = *(const f32x4*)(xrow + 4 * F.lane + 256 * j); }
#pragma unroll
            for (int u = 0; u < 2; ++u) { s[u] = 0.f;
#pragma unroll
                for (int h = 0; h < 8; ++h) d[u][h] = 0.f;
#pragma unroll
                for (int j = 0; j < 4; ++j) { s[u] += (v[u][j].x * v[u][j].x + v[u][j].y * v[u][j].y) + (v[u][j].z * v[u][j].z + v[u][j].w * v[u][j].w);
                    v[u][j] = v[u][j] * g1[j];
#pragma unroll
                    for (int jj = 0; jj < 4; ++jj) { const float xv = v[u][j][jj];
#pragma unroll
                        for (int h = 0; h < 4; ++h) { d[u][h] += xv * wf[j][jj][0][h]; d[u][4 + h] += xv * wf[j][jj][1][h]; } } } }
            float rs[2], g[2];
            const bool u32_ = (F.lane & 32) != 0, u16_ = (F.lane & 16) != 0, u8_ = (F.lane & 8) != 0;
#pragma unroll
            for (int u = 0; u < 2; ++u) { rs[u] = 1.0f / sqrtf(wave_sum(s[u]) * (1.f / DM) + RMS_EPS);
                float e[4], f[2];
#pragma unroll
                for (int i = 0; i < 4; ++i) { const float snd = u32_ ? d[u][i] : d[u][4 + i], kp = u32_ ? d[u][4 + i] : d[u][i]; e[i] = kp + __shfl_xor(snd, 32); }
#pragma unroll
                for (int i = 0; i < 2; ++i) { const float snd = u16_ ? e[i] : e[2 + i], kp = u16_ ? e[2 + i] : e[i]; f[i] = kp + __shfl_xor(snd, 16); }
                float gg = (u8_ ? f[1] : f[0]) + __shfl_xor(u8_ ? f[0] : f[1], 8);
                gg += __shfl_xor(gg, 4); gg += __shfl_xor(gg, 2); gg += __shfl_xor(gg, 1); g[u] = gg; }
#pragma unroll
            for (int u = 0; u < 2; ++u) if (ok[u]) { const int m = m0 + u * NGW;
                bf16_t* orow = F.XN + (size_t)m * DM;
#pragma unroll
                for (int j = 0; j < 4; ++j) { const f32x4 y = v[u][j] * rs[u]; u32x2 o; o.x = cvt_pk_bf16(y.x, y.y); o.y = cvt_pk_bf16(y.z, y.w); *(u32x2*)(orow + 4 * F.lane + 256 * j) = o; }
                if ((F.lane & 7) == 0) { const int h = F.lane >> 3;
                    const float z = g[u] * rs[u] + F.b_in[FCOL + h] + F.b_forget[h];
                    F.LOGF[(size_t)m * 8 + h] = log_sigmoid_(z); } }
        }
    }
}

__device__ __forceinline__ void scan_bh(Frame& F, int bh) {
    const int b = bh >> 3, h = bh & 7, lane = F.lane;
    float loc[33]; float tot = 0.f;
#pragma unroll
    for (int i = 0; i < 33; ++i) { const int p = 33 * lane + i; float v = 0.f;
        if (p < NMETA) v = F.LOGF[(size_t)(NR + p) * 8 + h]; else if (p < SEQ + NMETA) v = F.LOGF[((size_t)b * SEQ + (p - NMETA)) * 8 + h];
        tot += v; loc[i] = tot; }
    float inc = tot;
#pragma unroll
    for (int o = 1; o < 64; o <<= 1) { const float n = __shfl_up(inc, o); if (lane >= o) inc += n; }
    const float excl = inc - tot;
    float* cb = F.CB + (size_t)bh * KROWS;
#pragma unroll
    for (int i = 0; i < 33; ++i) { const int p = 33 * lane + i; if (p < SEQ + NMETA) cb[48 + p] = -(excl + loc[i]) * LOG2E; }
    if (lane < 48) cb[lane] = NEGBIG;
}

struct StaticOrder {
    int nM, nN, nwg, G, c;
    __device__ __forceinline__ void init(int nM_, int nN_, int G_, int c_) { nM = nM_; nN = nN_; nwg = nM * nN; G = G_; c = c_; }
    __device__ __forceinline__ bool tile(int i, int& pm, int& pn) const {
        const long L = (long)i * G + c; if (L >= nwg) return false;
        int wgid = (int)L; { const int q = nwg / 8, r = nwg % 8, xcd = wgid % 8, off = wgid / 8; wgid = (xcd < r ? xcd * (q + 1) : r * (q + 1) + (xcd - r) * q) + off; }
        const int nig = 8 * nN, gid = wgid / nig, fm = gid * 8, gsz = (nM - fm) < 8 ? (nM - fm) : 8;
        pm = fm + ((wgid % nig) % gsz); pn = (wgid % nig) / gsz; return true;
    }
};
struct SchedPlain {
    StaticOrder so; const char* A; const char* B; int K;
    __device__ __forceinline__ bool next(int i, pg8::Unit& u) const { u.e = 0; return so.tile(i, u.pm, u.pn); }
    __device__ __forceinline__ const char* a_base(const pg8::Unit& u) const { return A + (size_t)u.pm * 256 * K * 2; }
    __device__ __forceinline__ const char* b_base(const pg8::Unit& u) const { return B + (size_t)u.pn * 256 * K * 2; }
    __device__ __forceinline__ void a_offs(const pg8::Unit&, const int (&)[2], const int (&)[2], unsigned (&)[2][2]) const {}
};
struct SchedDual {
    StaticOrder so; const char *A0, *B0, *A1, *B1; int K;
    __device__ __forceinline__ bool next(int i, pg8::Unit& u) const { u.e = i & 1; return so.tile(i >> 1, u.pm, u.pn); }
    __device__ __forceinline__ const char* a_base(const pg8::Unit& u) const { return (u.e ? A1 : A0) + (size_t)u.pm * 256 * K * 2; }
    __device__ __forceinline__ const char* b_base(const pg8::Unit& u) const { return (u.e ? B1 : B0) + (size_t)u.pn * 256 * K * 2; }
    __device__ __forceinline__ void a_offs(const pg8::Unit&, const int (&)[2], const int (&)[2], unsigned (&)[2][2]) const {}
};
struct SchedMoe {
    int first, last, stride, c, sh; const LAS int* tab; const LAS int* cnt; const char* A; const char* B; const int* TOK; int K, brows; bool gather;
    __device__ __forceinline__ bool next(int i, pg8::Unit& u) const { const int idx = first + i * stride + c; if (idx >= last) return false; u.pm = idx >> sh; u.pn = idx & ((1 << sh) - 1); u.e = tab[u.pm]; return true; }
    __device__ __forceinline__ int rows(const pg8::Unit& u) const { return cnt[u.e & 255] - 256 * (u.e >> 8); }
    __device__ __forceinline__ const char* a_base(const pg8::Unit& u) const { return gather ? A : A + (size_t)u.pm * 256 * K * 2; }
    __device__ __forceinline__ const char* b_base(const pg8::Unit& u) const { return B + ((size_t)(u.e & 255) * brows + (size_t)u.pn * 256) * K * 2; }
    __device__ __forceinline__ void a_offs(const pg8::Unit& u, const int (&R)[2], const int (&C)[2], unsigned (&ao)[2][2]) const {
        if (gather) {
            const int e = u.e & 255, rt = u.e >> 8, n = cnt[e];
#pragma unroll
            for (int h = 0; h < 2; ++h)
#pragma unroll
                for (int i = 0; i < 2; ++i) { const int pos = rt * 256 + 128 * h + R[i]; const int tok = TOK[(size_t)e * MOE_CAP + (pos < n ? pos : 0)] >> 1; ao[h][i] = (unsigned)(tok * K + C[i]) * 2u; }
            asm volatile("s_waitcnt vmcnt(0)" : "+v"(ao[0][0]), "+v"(ao[0][1]), "+v"(ao[1][0]), "+v"(ao[1][1]) :: "memory");
        }
    }
};

__device__ __forceinline__ u32x4 pack8(const f32x4& a, const f32x4& b) { u32x4 w; w.x = cvt_pk_bf16(a[0], a[1]); w.y = cvt_pk_bf16(a[2], a[3]); w.z = cvt_pk_bf16(b[0], b[1]); w.w = cvt_pk_bf16(b[2], b[3]); return w; }
__device__ __forceinline__ void unpack8(const u32x4& w, f32x4& a, f32x4& b) { a = (f32x4){bf_lo(w.x), bf_hi(w.x), bf_lo(w.y), bf_hi(w.y)}; b = (f32x4){bf_lo(w.z), bf_hi(w.z), bf_lo(w.w), bf_hi(w.w)}; }

struct Epi1 {
    static constexpr bool PERM = true;
    const float *bias1, *gq, *gk; bf16_t *ABUF, *Q, *KX, *VX, *SG;
    __device__ __forceinline__ bool operator()(f32x4 (&acc)[2][2][4][2], const pg8::Unit& u, int wr, int wc, int fr, int fq) {
        asm volatile("" : "+v"(fr), "+v"(fq));
        const int pn = u.pn; const bool meta = (u.pm == 64); const int cpos = 32 * wc + 8 * fq;
        if (meta && (pn == 4 || pn == 5 || pn >= 10)) return false;
        const float* bp = bias1 + pn * 256 + cpos;
        const f32x4 b00 = *(const f32x4*)(bp), b01 = *(const f32x4*)(bp + 4), b10 = *(const f32x4*)(bp + 128), b11 = *(const f32x4*)(bp + 132);
        const int row_w = u.pm * 256 + 64 * wr + fr;
        if (pn < 4) {
            const int col = 128 * pn + cpos;
#pragma unroll
            for (int ai = 0; ai < 2; ++ai)
#pragma unroll
                for (int m = 0; m < 4; ++m) {
                    const f32x4 x00 = acc[ai][0][m][0] + b00, x01 = acc[ai][0][m][1] + b01, x10 = acc[ai][1][m][0] + b10, x11 = acc[ai][1][m][1] + b11;
                    f32x4 o0, o1;
#pragma unroll
                    for (int j = 0; j < 4; ++j) { o0[j] = x00[j] * sigmoidf_(x10[j]); o1[j] = x01[j] * sigmoidf_(x11[j]); }
                    const u32x4 w = pack8(o0, o1);
                    const int Rg = row_w + 128 * ai + 16 * m;
                    if (!meta) { const int b = Rg >> 11, t = Rg & 2047; *(u32x4*)(ABUF + ((size_t)(b * AROWS + 32 + t)) * 512 + col) = w; }
                    else if (ai == 0 && m == 0 && wr == 0) { for (int bb = 0; bb < NB; ++bb) *(u32x4*)(ABUF + ((size_t)(bb * AROWS + 16 + fr)) * 512 + col) = w; }
                }
        } else if (pn < 8) {
            const bool isq = pn < 6; const float* g = isq ? gq : gk; const float sc = isq ? C2 : 1.0f;
            const f32x4 g00 = *(const f32x4*)(g + 8 * fq) * sc, g01 = *(const f32x4*)(g + 8 * fq + 4) * sc, g10 = *(const f32x4*)(g + 32 + 8 * fq) * sc, g11 = *(const f32x4*)(g + 36 + 8 * fq) * sc;
            const int col = 64 * (4 * (pn & 1) + wc) + 8 * fq;
#pragma unroll
            for (int ai = 0; ai < 2; ++ai)
#pragma unroll
                for (int m = 0; m < 4; ++m) {
                    const f32x4 x00 = acc[ai][0][m][0] + b00, x01 = acc[ai][0][m][1] + b01, x10 = acc[ai][1][m][0] + b10, x11 = acc[ai][1][m][1] + b11;
                    const f32x4 sq = x00 * x00 + x01 * x01 + x10 * x10 + x11 * x11;
                    float ss = (sq[0] + sq[1]) + (sq[2] + sq[3]);
                    ss += __shfl_xor(ss, 16); ss += __shfl_xor(ss, 32);
                    const float rs = 1.0f / sqrtf(ss * (1.f / 64.f) + RMS_EPS);
                    const u32x4 w0 = pack8(x00 * rs * g00, x01 * rs * g01), w1 = pack8(x10 * rs * g10, x11 * rs * g11);
                    const int Rg = row_w + 128 * ai + 16 * m; const int b = Rg >> 11, t = Rg & 2047;
                    if (isq) { bf16_t* o = Q + (size_t)Rg * 512 + col; *(u32x4*)o = w0; *(u32x4*)(o + 32) = w1; }
                    else if (!meta) { bf16_t* o = KX + ((size_t)(b * KROWS + 64 + t)) * 512 + col; *(u32x4*)o = w0; *(u32x4*)(o + 32) = w1; }
                    else if (ai == 0 && m == 0 && wr == 0) { for (int bb = 0; bb < NB; ++bb) { bf16_t* o = KX + ((size_t)(bb * KROWS + 48 + fr)) * 512 + col; *(u32x4*)o = w0; *(u32x4*)(o + 32) = w1; } }
                }
        } else if (pn < 10) {
            const int col = 256 * (pn - 8) + cpos;
#pragma unroll
            for (int ai = 0; ai < 2; ++ai)
#pragma unroll
                for (int m = 0; m < 4; ++m) {
                    const u32x4 w0 = pack8(acc[ai][0][m][0] + b00, acc[ai][0][m][1] + b01), w1 = pack8(acc[ai][1][m][0] + b10, acc[ai][1][m][1] + b11);
                    const int Rg = row_w + 128 * ai + 16 * m; const int b = Rg >> 11, t = Rg & 2047;
                    if (!meta) { bf16_t* o = VX + ((size_t)(b * KROWS + 64 + t)) * 512 + col; *(u32x4*)o = w0; *(u32x4*)(o + 128) = w1; }
                    else if (ai == 0 && m == 0 && wr == 0) { for (int bb = 0; bb < NB; ++bb) { bf16_t* o = VX + ((size_t)(bb * KROWS + 48 + fr)) * 512 + col; *(u32x4*)o = w0; *(u32x4*)(o + 128) = w1; } }
                }
        } else {
            const int col = 256 * (pn - 10) + cpos;
#pragma unroll
            for (int ai = 0; ai < 2; ++ai)
#pragma unroll
                for (int m = 0; m < 4; ++m) {
                    const f32x4 x00 = acc[ai][0][m][0] + b00, x01 = acc[ai][0][m][1] + b01, x10 = acc[ai][1][m][0] + b10, x11 = acc[ai][1][m][1] + b11;
                    f32x4 o00, o01, o10, o11;
#pragma unroll
                    for (int j = 0; j < 4; ++j) { o00[j] = sigmoidf_(x00[j]); o01[j] = sigmoidf_(x01[j]); o10[j] = sigmoidf_(x10[j]); o11[j] = sigmoidf_(x11[j]); }
                    bf16_t* o = SG + (size_t)(row_w + 128 * ai + 16 * m) * 2048 + col;
                    *(u32x4*)o = pack8(o00, o01); *(u32x4*)(o + 128) = pack8(o10, o11);
                }
        }
        return false;
    }
};

struct Epi3 {
    static constexpr bool PERM = true;
    const float* bc; const bf16_t* SG; bf16_t* MERGED;
    __device__ __forceinline__ bool operator()(f32x4 (&acc)[2][2][4][2], const pg8::Unit& u, int wr, int wc, int fr, int fq) {
        asm volatile("" : "+v"(fr), "+v"(fq));
        const int col0 = u.pn * 256 + 32 * wc + 8 * fq;
        const bf16_t* sgrow = SG + ((size_t)u.pm * 256 + 64 * wr + fr) * 2048 + col0;
        if (u.e == 0) {
            const f32x4 b00 = *(const f32x4*)(bc + col0), b01 = *(const f32x4*)(bc + col0 + 4), b10 = *(const f32x4*)(bc + col0 + 128), b11 = *(const f32x4*)(bc + col0 + 132);
#pragma unroll
            for (int ai = 0; ai < 2; ++ai)
#pragma unroll
                for (int m = 0; m < 4; ++m) {
                    const bf16_t* sp = sgrow + (size_t)(128 * ai + 16 * m) * 2048;
                    const u32x4 wc0 = *(const u32x4*)(sp), wc1 = *(const u32x4*)(sp + 128), wa0 = *(const u32x4*)(sp + 1024), wa1 = *(const u32x4*)(sp + 1152);
                    f32x4 c00, c01, c10, c11, a00, a01, a10, a11;
                    unpack8(wc0, c00, c01); unpack8(wc1, c10, c11); unpack8(wa0, a00, a01); unpack8(wa1, a10, a11);
#pragma unroll
                    for (int j = 0; j < 4; ++j) {
                        acc[ai][0][m][0][j] = (acc[ai][0][m][0][j] + b00[j]) * c00[j] * __builtin_amdgcn_rcpf(fmaxf(a00[j], 1e-20f));
                        acc[ai][0][m][1][j] = (acc[ai][0][m][1][j] + b01[j]) * c01[j] * __builtin_amdgcn_rcpf(fmaxf(a01[j], 1e-20f));
                        acc[ai][1][m][0][j] = (acc[ai][1][m][0][j] + b10[j]) * c10[j] * __builtin_amdgcn_rcpf(fmaxf(a10[j], 1e-20f));
                        acc[ai][1][m][1][j] = (acc[ai][1][m][1][j] + b11[j]) * c11[j] * __builtin_amdgcn_rcpf(fmaxf(a11[j], 1e-20f)); }
                }
            return true;
        }
        bf16_t* mrow = MERGED + ((size_t)u.pm * 256 + 64 * wr + fr) * 1024 + col0;
#pragma unroll
        for (int ai = 0; ai < 2; ++ai)
#pragma unroll
            for (int m = 0; m < 4; ++m) {
                const bf16_t* sp = sgrow + (size_t)(128 * ai + 16 * m) * 2048;
                const u32x4 wa0 = *(const u32x4*)(sp + 1024), wa1 = *(const u32x4*)(sp + 1152);
                f32x4 a00, a01, a10, a11; unpack8(wa0, a00, a01); unpack8(wa1, a10, a11);
                bf16_t* op = mrow + (size_t)(128 * ai + 16 * m) * 1024;
                *(u32x4*)op = pack8(acc[ai][0][m][0] * a00, acc[ai][0][m][1] * a01); *(u32x4*)(op + 128) = pack8(acc[ai][1][m][0] * a10, acc[ai][1][m][1] * a11);
            }
        return false;
    }
};

struct Epi4 {
    static constexpr bool PERM = false;
    const float* x; float* out;
    __device__ __forceinline__ bool operator()(f32x4 (&acc)[2][2][4][2], const pg8::Unit& u, int wr, int wc, int fr, int fq) {
        asm volatile("" : "+v"(fr), "+v"(fq));
        const size_t off0 = ((size_t)u.pm * 256 + 64 * wr + fr) * 1024 + u.pn * 256 + 32 * wc + 4 * fq;
#pragma unroll
        for (int ai = 0; ai < 2; ++ai) {
            f32x4 r[4][2][2];
#pragma unroll
            for (int m = 0; m < 4; ++m)
#pragma unroll
                for (int bj = 0; bj < 2; ++bj)
#pragma unroll
                    for (int n = 0; n < 2; ++n) r[m][bj][n] = *(const f32x4*)(x + off0 + (size_t)(128 * ai + 16 * m) * 1024 + 128 * bj + 16 * n);
#pragma unroll
            for (int m = 0; m < 4; ++m)
#pragma unroll
                for (int bj = 0; bj < 2; ++bj)
#pragma unroll
                    for (int n = 0; n < 2; ++n) *(f32x4*)(out + off0 + (size_t)(128 * ai + 16 * m) * 1024 + 128 * bj + 16 * n) = r[m][bj][n] + acc[ai][bj][m][n];
        }
        return false;
    }
};

struct Epi6 {
    static constexpr bool PERM = true;
    const LAS int* cnt; const int* TOK; const float* RS; bf16_t* HB;
    __device__ __forceinline__ bool operator()(f32x4 (&acc)[2][2][4][2], const pg8::Unit& u, int wr, int wc, int fr, int fq) {
        asm volatile("" : "+v"(fr), "+v"(fq));
        const int e = u.e & 255, rt = u.e >> 8, n = cnt[e];
        float rsv[2][4];
        { int tk[2][4];
#pragma unroll
          for (int ai = 0; ai < 2; ++ai)
#pragma unroll
              for (int m = 0; m < 4; ++m) { const int pos = rt * 256 + 128 * ai + 64 * wr + 16 * m + fr; tk[ai][m] = TOK[(size_t)e * MOE_CAP + (pos < n ? pos : 0)] >> 1; }
#pragma unroll
          for (int ai = 0; ai < 2; ++ai)
#pragma unroll
              for (int m = 0; m < 4; ++m) rsv[ai][m] = RS[tk[ai][m]]; }
#pragma unroll
        for (int ai = 0; ai < 2; ++ai)
#pragma unroll
            for (int m = 0; m < 4; ++m) {
                const int rl = 128 * ai + 64 * wr + 16 * m + fr;
                const float rs = rsv[ai][m];
                f32x4 o0, o1;
#pragma unroll
                for (int j = 0; j < 4; ++j) { const float g0 = acc[ai][0][m][0][j] * rs, g1 = acc[ai][0][m][1][j] * rs;
                    o0[j] = g0 * sigmoidf_(g0) * (acc[ai][1][m][0][j] * rs); o1[j] = g1 * sigmoidf_(g1) * (acc[ai][1][m][1][j] * rs); }
                *(u32x4*)(HB + ((size_t)u.pm * 256 + rl) * 256 + 128 * u.pn + 32 * wc + 8 * fq) = pack8(o0, o1);
            }
        return false;
    }
};

struct Epi7 {
    static constexpr bool PERM = true;
    const LAS int* cnt; const int* TOK; const float* WL; bf16_t* YB;
    __device__ __forceinline__ bool operator()(f32x4 (&acc)[2][2][4][2], const pg8::Unit& u, int wr, int wc, int fr, int fq) {
        asm volatile("" : "+v"(fr), "+v"(fq));
        const int e = u.e & 255, rt = u.e >> 8, n = cnt[e];
        const int col = u.pn * 256 + 32 * wc + 8 * fq;
#pragma unroll
        for (int ai = 0; ai < 2; ++ai) {
            int ent[4]; float wv[4];
#pragma unroll
            for (int m = 0; m < 4; ++m) { const int pos = rt * 256 + 128 * ai + 64 * wr + 16 * m + fr; const size_t li = (size_t)e * MOE_CAP + (pos < n ? pos : 0);
                ent[m] = TOK[li]; wv[m] = WL[li]; if (pos >= n) ent[m] = -1; }
#pragma unroll
            for (int m = 0; m < 4; ++m) if (ent[m] >= 0) {
                const float w = wv[m]; bf16_t* op = YB + (size_t)ent[m] * 1024 + col;
                *(u32x4*)op = pack8(acc[ai][0][m][0] * w, acc[ai][0][m][1] * w); *(u32x4*)(op + 128) = pack8(acc[ai][1][m][0] * w, acc[ai][1][m][1] * w); }
            asm volatile("" ::: "memory");
        }
        return false;
    }
};

__device__ __forceinline__ void conv_unit(Frame& F, int b, int chunk) {
    const int c = F.tid, t0 = chunk * 32;
    float w[CK];
#pragma unroll
    for (int j = 0; j < CK; ++j) w[j] = F.dw_w[j * CWID + c];
    float v[62];
    const bf16_t* base = F.ABUF + ((size_t)(b * AROWS + 32 + t0 - 30)) * 512 + c;
#pragma unroll
    for (int i = 0; i < 62; ++i) v[i] = bf2f(base[(size_t)i * 512]);
    float ov[32]; const float bias = F.dw_b[c];
#pragma unroll
    for (int i = 0; i < 32; ++i) { float s = bias;
#pragma unroll
        for (int j = 0; j < CK; ++j) s += w[j] * v[i + j];
        ov[i] = s; }
    LAS float* red = (LAS float*)F.lds; LAS float* st = red + 32 * 512;
    __syncthreads();
#pragma unroll
    for (int i = 0; i < 32; ++i) red[i * 512 + c] = ov[i];
    __syncthreads();
    { const int row = F.tid >> 4, seg = F.tid & 15; float s = 0.f;
#pragma unroll
      for (int qq = 0; qq < 32; ++qq) s += red[row * 512 + seg + 16 * qq];
      s += __shfl_xor(s, 1); s += __shfl_xor(s, 2); s += __shfl_xor(s, 4); s += __shfl_xor(s, 8);
      const float mean = s * (1.f / 512.f); float q2 = 0.f;
#pragma unroll
      for (int qq = 0; qq < 32; ++qq) { const float dlt = red[row * 512 + seg + 16 * qq] - mean; q2 += dlt * dlt; }
      q2 += __shfl_xor(q2, 1); q2 += __shfl_xor(q2, 2); q2 += __shfl_xor(q2, 4); q2 += __shfl_xor(q2, 8);
      if (seg == 0) { st[2 * row] = mean; st[2 * row + 1] = 1.0f / sqrtf(q2 * (1.f / 512.f) + LN_EPS); } }
    __syncthreads();
    const float g = F.ln_g[c], bb = F.ln_b[c];
    bf16_t* op = F.CACT + ((size_t)(b * SEQ + t0)) * 512 + c;
#pragma unroll
    for (int i = 0; i < 32; ++i) { const float y = (ov[i] - st[2 * i]) * st[2 * i + 1] * g + bb; const float z = y * sigmoidf_(y);
        op[(size_t)i * 512] = (bf16_t)(cvt_pk_bf16(z, 0.f) & 0xffffu); }
}

constexpr int CVT_GU = 64 * 16 * 16, CVT_D = 64 * 4 * 32, CVT_EARLY = 6400;
struct CvtItem { const float* W; int ldw, k0, n0; bf16_t* WT; int ldk, row0; const float* gk; };
__device__ __forceinline__ CvtItem cvt_decode(Frame& F, int r) {
    CvtItem it;
    if (r < CVT_GU) { const int e = r >> 8, r2 = r & 255, kb = r2 >> 4, pb = r2 & 15, p0 = 32 * pb, pn = p0 >> 8, bj = (p0 & 255) >> 7, y = p0 & 127;
        it.W = (bj ? F.w_up : F.w_gate) + (size_t)e * 1024 * 256; it.ldw = 256; it.k0 = 64 * kb; it.n0 = 128 * pn + y; it.WT = F.WGU + (size_t)e * 512 * 1024; it.ldk = 1024; it.row0 = p0; it.gk = F.norm2_g; }
    else { r -= CVT_GU; const int e = r >> 7, r2 = r & 127, kb = r2 >> 5, nb = r2 & 31;
        it.W = F.w_down + (size_t)e * 256 * 1024; it.ldw = 1024; it.k0 = 64 * kb; it.n0 = 32 * nb; it.WT = F.WD + (size_t)e * 1024 * 256; it.ldk = 256; it.row0 = 32 * nb; it.gk = nullptr; }
    return it;
}
__device__ __forceinline__ void cvt_load(const CvtItem& it, f32x4 (&v)[8], int lane) {
#pragma unroll
    for (int i = 0; i < 8; ++i) v[i] = *(const f32x4*)(it.W + (size_t)(it.k0 + 8 * i + (lane >> 3)) * it.ldw + it.n0 + 4 * (lane & 7));
}
__device__ __forceinline__ void cvt_store(const CvtItem& it, const f32x4 (&v)[8], LAS float* scr, int lane) {
    float gk[8];
#pragma unroll
    for (int i = 0; i < 8; ++i) gk[i] = it.gk ? it.gk[it.k0 + 8 * i + (lane >> 3)] : 1.0f;
#pragma unroll
    for (int i = 0; i < 8; ++i) { LAS float* d = scr + (8 * i + (lane >> 3)) * 33 + 4 * (lane & 7); d[0] = v[i][0] * gk[i]; d[1] = v[i][1] * gk[i]; d[2] = v[i][2] * gk[i]; d[3] = v[i][3] * gk[i]; }
    LDS_WAIT(); asm volatile("" ::: "memory");
    const int c = lane & 7;
#pragma unroll
    for (int j = 0; j < 4; ++j) { const int n = (lane >> 3) + 8 * j; const LAS float* s = scr + (8 * c) * 33 + n;
        u32x4 o; o.x = cvt_pk_bf16(s[0 * 33], s[1 * 33]); o.y = cvt_pk_bf16(s[2 * 33], s[3 * 33]); o.z = cvt_pk_bf16(s[4 * 33], s[5 * 33]); o.w = cvt_pk_bf16(s[6 * 33], s[7 * 33]);
        *(u32x4*)(it.WT + (size_t)(it.row0 + n) * it.ldk + it.k0 + 8 * c) = o; }
    LDS_WAIT(); asm volatile("" ::: "memory");
}
__device__ __forceinline__ void convert_experts(Frame& F, int first, int last, int w, int nw) {
    LAS float* scr = (LAS float*)(F.lds + F.wave * 16384);
    int r = first + w;
    if (r >= last) return;
    CvtItem cur = cvt_decode(F, r); f32x4 va[8], vb[8];
    cvt_load(cur, va, F.lane);
    for (;;) {
        const int rn = r + nw; const bool more = rn < last;
        CvtItem nxt = cur; if (more) { nxt = cvt_decode(F, rn); cvt_load(nxt, vb, F.lane); }
        cvt_store(cur, va, scr, F.lane);
        if (!more) break;
        const int rn2 = rn + nw; const bool more2 = rn2 < last;
        CvtItem nx2 = nxt; if (more2) { nx2 = cvt_decode(F, rn2); cvt_load(nx2, va, F.lane); }
        cvt_store(nxt, vb, scr, F.lane);
        if (!more2) break;
        cur = nx2; r = rn2;
    }
}

constexpr int RT_NRT = 2, RT_WAVES = 2;
__device__ __forceinline__ void p5_router(Frame& F) {
    const int lane = F.lane, row = lane & 15, q = lane >> 4;
    LAS float* Lw = (LAS float*)(F.lds + F.wave * 16384);
    unsigned* cnt = F.ctl + CW_CNT;
    constexpr int NTASK = NR / (16 * RT_NRT);
    if (F.wave < RT_WAVES) for (int task = F.wave * F.G + F.vcu; task < NTASK; task += RT_WAVES * F.G) {
        const int row0 = task * 16 * RT_NRT;
        const float* __restrict__ hp = F.out + (size_t)(row0 + row) * DM + 8 * q;
        bf16_t* __restrict__ hn = F.HN + (size_t)(row0 + row) * DM + 8 * q;
        const bf16_t* __restrict__ bh = F.WRH + (size_t)row * 1024 + 8 * q; const bf16_t* __restrict__ bl = F.WRL + (size_t)row * 1024 + 8 * q;
        f32x4 acc[RT_NRT][5];
#pragma unroll
        for (int rt = 0; rt < RT_NRT; ++rt)
#pragma unroll
            for (int tl = 0; tl < 5; ++tl) acc[rt][tl] = (f32x4){0.f, 0.f, 0.f, 0.f};
        float ss[RT_NRT];
#pragma unroll
        for (int rt = 0; rt < RT_NRT; ++rt) ss[rt] = 0.f;
        constexpr int HD_ = 2;
        f32x4 hq0[HD_][RT_NRT], hq1[HD_][RT_NRT]; bf16x8 Bc[10];
#pragma unroll
        for (int d = 0; d < HD_; ++d)
#pragma unroll
            for (int rt = 0; rt < RT_NRT; ++rt) { hq0[d][rt] = *(const f32x4*)(hp + (size_t)rt * 16 * DM + 32 * d); hq1[d][rt] = *(const f32x4*)(hp + (size_t)rt * 16 * DM + 32 * d + 4); }
#pragma unroll
        for (int tl = 0; tl < 5; ++tl) { Bc[2 * tl] = *(const bf16x8*)(bh + (size_t)tl * 16 * 1024); Bc[2 * tl + 1] = *(const bf16x8*)(bl + (size_t)tl * 16 * 1024); }
        constexpr int NS_ = 32;
        for (int s2 = 0; s2 < NS_; s2 += HD_) {
#pragma unroll
            for (int d = 0; d < HD_; ++d) {
                const int s = s2 + d, sn = s + 1 < NS_ ? s + 1 : s;
                bf16x8 Bn[10];
#pragma unroll
                for (int tl = 0; tl < 5; ++tl) { Bn[2 * tl] = *(const bf16x8*)(bh + (size_t)tl * 16 * 1024 + 32 * sn); Bn[2 * tl + 1] = *(const bf16x8*)(bl + (size_t)tl * 16 * 1024 + 32 * sn); }
                f32x4 h0[RT_NRT], h1[RT_NRT];
#pragma unroll
                for (int rt = 0; rt < RT_NRT; ++rt) { h0[rt] = hq0[d][rt]; h1[rt] = hq1[d][rt]; }
                if (s2 + HD_ < NS_) {
#pragma unroll
                    for (int rt = 0; rt < RT_NRT; ++rt) { hq0[d][rt] = *(const f32x4*)(hp + (size_t)rt * 16 * DM + 32 * (s + HD_)); hq1[d][rt] = *(const f32x4*)(hp + (size_t)rt * 16 * DM + 32 * (s + HD_) + 4); } }
#pragma unroll
                for (int rt = 0; rt < RT_NRT; ++rt) {
                    const f32x4 sq = h0[rt] * h0[rt] + h1[rt] * h1[rt]; ss[rt] += (sq[0] + sq[1]) + (sq[2] + sq[3]);
                    const u32x4 ahi = pack8(h0[rt], h1[rt]); f32x4 r0, r1; unpack8(ahi, r0, r1);
                    *(u32x4*)(hn + (size_t)rt * 16 * DM + 32 * s) = ahi;
                    const u32x4 alo = pack8(h0[rt] - r0, h1[rt] - r1);
                    const bf16x8 Ahi = __builtin_bit_cast(bf16x8, ahi), Alo = __builtin_bit_cast(bf16x8, alo);
#pragma unroll
                    for (int tl = 0; tl < 5; ++tl) {
                        acc[rt][tl] = __builtin_amdgcn_mfma_f32_16x16x32_bf16(Ahi, Bc[2 * tl], acc[rt][tl], 0, 0, 0);
                        acc[rt][tl] = __builtin_amdgcn_mfma_f32_16x16x32_bf16(Ahi, Bc[2 * tl + 1], acc[rt][tl], 0, 0, 0);
                        acc[rt][tl] = __builtin_amdgcn_mfma_f32_16x16x32_bf16(Alo, Bc[2 * tl], acc[rt][tl], 0, 0, 0); }
                }
#pragma unroll
                for (int i = 0; i < 10; ++i) Bc[i] = Bn[i];
            }
        }
        float rsv[RT_NRT];
#pragma unroll
        for (int rt = 0; rt < RT_NRT; ++rt) { float s_ = ss[rt]; s_ += __shfl_xor(s_, 16); s_ += __shfl_xor(s_, 32); rsv[rt] = 1.0f / sqrtf(s_ * (1.f / DM) + RMS_EPS);
#pragma unroll
            for (int tl = 0; tl < 5; ++tl)
#pragma unroll
                for (int r = 0; r < 4; ++r) Lw[(rt * 16 + 4 * q + r) * 80 + 16 * tl + row] = acc[rt][tl][r]; }
        LDS_WAIT(); asm volatile("" ::: "memory");
        if (lane < 16 * RT_NRT) {
            const float rs = (lane >> 4) == 0 ? rsv[0] : rsv[RT_NRT - 1];
            float lg[72];
#pragma unroll
            for (int c = 0; c < 72; ++c) lg[c] = Lw[lane * 80 + c] * rs + (c < 8 ? F.b_group[c] : F.b_router[c - 8]);
            int gi = 0; float gm = lg[0];
#pragma unroll
            for (int c = 1; c < 8; ++c) if (lg[c] > gm) { gm = lg[c]; gi = c; }
            float gs = 0.f;
#pragma unroll
            for (int c = 0; c < 8; ++c) gs += expf(lg[c] - gm);
            const float gwt = 1.0f / gs;
            float el[8];
#pragma unroll
            for (int i = 0; i < 8; ++i) el[i] = lg[8 + i];
#pragma unroll
            for (int g = 1; g < 8; ++g) if (gi == g) {
#pragma unroll
                for (int i = 0; i < 8; ++i) el[i] = lg[8 + 8 * g + i]; }
            int i1 = 0; float l1 = el[0];
#pragma unroll
            for (int i = 1; i < 8; ++i) if (el[i] > l1) { l1 = el[i]; i1 = i; }
            int i2 = -1; float l2 = -3e38f;
#pragma unroll
            for (int i = 0; i < 8; ++i) if (i != i1 && el[i] > l2) { l2 = el[i]; i2 = i; }
            const float ex = expf(l2 - l1), w1 = gwt / (1.0f + ex), w2 = gwt * ex / (1.0f + ex);
            const int e1 = gi * 8 + i1, e2 = gi * 8 + i2, tok = row0 + lane;
            {
            const unsigned p1 = atomicAdd(cnt + 64 * e1, 1u), p2 = atomicAdd(cnt + 64 * e2, 1u);
            F.TOK[(size_t)e1 * MOE_CAP + p1] = 2 * tok; F.WL[(size_t)e1 * MOE_CAP + p1] = w1;
            F.TOK[(size_t)e2 * MOE_CAP + p2] = 2 * tok + 1; F.WL[(size_t)e2 * MOE_CAP + p2] = w2;
            F.RS[tok] = rs; }
        }
        LDS_WAIT(); asm volatile("" ::: "memory");
    }
}

__device__ __forceinline__ int moe_table(Frame& F) {
    LAS int* cntl = (LAS int*)(F.lds + TAB_OFF); LAS int* tab = cntl + 64; LAS int* ntl = tab + MAXT;
    __syncthreads();
    if (F.tid < 64) cntl[F.tid] = (int)__hip_atomic_load(F.ctl + CW_CNT + 64 * F.tid, RLX_AGENT);
    __syncthreads();
    if (F.tid == 0) { int t = 0; for (int e = 0; e < NE; ++e) { const int nt = (cntl[e] + 255) >> 8; for (int r = 0; r < nt && t < MAXT; ++r) tab[t++] = e | (r << 8); } ntl[0] = t; }
    __syncthreads();
    return ntl[0];
}

__device__ __forceinline__ void p8_combine(Frame& F) {
    const int gw = F.vcu * NWAVES + F.wave, NGW = F.G * NWAVES;
    for (int t = gw; t < NR; t += NGW) {
        float* op = F.out + (size_t)t * DM + 4 * F.lane; const bf16_t* y0 = F.YB + (size_t)(2 * t) * DM + 4 * F.lane; const bf16_t* y1 = y0 + DM;
        f32x4 h[4]; u32x2 a[4], b[4];
#pragma unroll
        for (int j = 0; j < 4; ++j) { h[j] = *(const f32x4*)(op + 256 * j); a[j] = *(const u32x2*)(y0 + 256 * j); b[j] = *(const u32x2*)(y1 + 256 * j); }
#pragma unroll
        for (int j = 0; j < 4; ++j) { h[j][0] += bf_lo(a[j].x) + bf_lo(b[j].x); h[j][1] += bf_hi(a[j].x) + bf_hi(b[j].x); h[j][2] += bf_lo(a[j].y) + bf_lo(b[j].y); h[j][3] += bf_hi(a[j].y) + bf_hi(b[j].y);
            *(f32x4*)(op + 256 * j) = h[j]; }
    }
}

struct Args { const float* in[24]; float* out; unsigned char* ws; int ph_lo, ph_hi; };
static_assert(sizeof(Args) == 24 * 8 + 8 + 8 + 8, "Args has no padding");

__global__ void __launch_bounds__(NWAVES * 64, 2) fwd_kernel(Args args) {
    extern __shared__ __attribute__((aligned(16))) unsigned char lds[];
    Frame F;
    F.lds = (LAS unsigned char*)lds;
    F.MISC = (volatile LAS unsigned*)(F.lds + MISC_OFF);
    F.tid = threadIdx.x; F.lane = F.tid & 63; F.wave = __builtin_amdgcn_readfirstlane(F.tid >> 6);
    F.G = gridDim.x; { const int bx = blockIdx.x; F.vcu = (F.G % 8 == 0) ? (bx % 8) * (F.G / 8) + bx / 8 : bx; }
    unsigned char* ws = args.ws;
    F.ctl = (unsigned*)(ws + WS_CTL);
    F.x = args.in[0]; F.meta = args.in[1]; F.norm1_g = args.in[2]; F.w_in = args.in[3]; F.b_in = args.in[4]; F.dw_w = args.in[5]; F.dw_b = args.in[6];
    F.ln_g = args.in[7]; F.ln_b = args.in[8]; F.w_conv_out = args.in[9]; F.b_conv_out = args.in[10]; F.q_norm_g = args.in[11]; F.k_norm_g = args.in[12];
    F.b_forget = args.in[13]; F.w_attn_out = args.in[14]; F.w_out = args.in[15]; F.norm2_g = args.in[16]; F.w_group = args.in[17]; F.b_group = args.in[18];
    F.w_router = args.in[19]; F.b_router = args.in[20]; F.w_gate = args.in[21]; F.w_up = args.in[22]; F.w_down = args.in[23];
    F.out = args.out;
    F.BIAS1 = (float*)(ws + WS_BIAS1); F.WRH = (bf16_t*)(ws + WS_WR); F.WRL = (bf16_t*)(ws + WS_WR + 160 * 1024); F.RS = (float*)(ws + WS_RS); F.CB = (float*)(ws + WS_CB); F.LOGF = (float*)(ws + WS_LOGF);
    F.WL = (float*)(ws + WS_WL); F.TOK = (int*)(ws + WS_TOK);
    F.W1T = (bf16_t*)(ws + WS_W1T); F.WCT = (bf16_t*)(ws + WS_WCT); F.WAT = (bf16_t*)(ws + WS_WAT); F.WOT = (bf16_t*)(ws + WS_WOT); F.WGU = (bf16_t*)(ws + WS_WGU); F.WD = (bf16_t*)(ws + WS_WD);
    F.XN = (bf16_t*)(ws + WS_XN); F.MERGED = (bf16_t*)(ws + WS_XN); F.ABUF = (bf16_t*)(ws + WS_ABUF); F.CACT = (bf16_t*)(ws + WS_CACT); F.HN = (bf16_t*)(ws + WS_O);
    F.QO = (bf16_t*)(ws + WS_QO); F.KX = (bf16_t*)(ws + WS_KX); F.VX = (bf16_t*)(ws + WS_VX); F.HB = (bf16_t*)(ws + WS_QO); F.SG = (bf16_t*)args.out; F.YB = (bf16_t*)(ws + WS_XN); F.OB = (bf16_t*)(ws + WS_O);
    for (int u = F.tid; u < (LDS_BYTES - LDSCTL_OFF) / 4; u += NWAVES * 64) ((LAS unsigned*)(F.lds + LDSCTL_OFF))[u] = 0u;
    __syncthreads();
    XcdBarrier bar; bar.bar = F.ctl + CW_BAR; bar.x = 0; bar.st = nullptr;
    if (MK_N_LAUNCHES == 1) bar = xcd_barrier_post(F.ctl + CW_BAR, F.MISC + 8);
#define GRID_BAR() do { if (MK_N_LAUNCHES == 1) xcd_barrier(bar); } while (0)
    const int lo = args.ph_lo, hi = args.ph_hi;
#ifndef P1_ALIGN
#define P1_ALIGN true
#endif
#ifndef PHASE_MASK
#define PHASE_MASK 0x1ff
#endif
#define IN(k) (((PHASE_MASK >> (k)) & 1) && lo <= (k) && (k) < hi)
#define BOTH(k) (IN(k) && IN((k) + 1))
    if (IN(0)) { p0_prologue(F); if (BOTH(0)) GRID_BAR();
    }

    if (IN(1)) {
        if (F.wave == 0) for (int bh = F.G - 1 - (int)blockIdx.x; bh < 64; bh += F.G) scan_bh(F, bh);
        SchedPlain S; S.so.init(NRX / 256, N1 / 256, F.G, (int)blockIdx.x); S.A = (const char*)F.XN; S.B = (const char*)F.W1T; S.K = 1024;
        Epi1 E{F.BIAS1, F.q_norm_g, F.k_norm_g, F.ABUF, F.QO, F.KX, F.VX, F.SG};
        pg8::gemm_phase<Epi1, SchedPlain, P1_ALIGN>(F.lds, 1024, S, E);
#ifndef CVT_EARLY_N
#define CVT_EARLY_N 11000
#endif
        { const int nfull = (NRX / 256) * (N1 / 256) - 4 * F.G;
          if (F.G == 256 && (int)blockIdx.x >= nfull) convert_experts(F, 0, CVT_EARLY_N, ((int)blockIdx.x - nfull) * NWAVES + F.wave, (F.G - nfull) * NWAVES); }
        if (BOTH(1)) GRID_BAR();
    }

    if (IN(2)) {
        for (int v = F.vcu; v < 256; v += F.G) { const int bh = v >> 2, s = v & 3;
            attn_body::attn_unit<8>(bh >> 3, bh & 7, s, (const attn_body::bf16*)F.QO, (const attn_body::bf16*)F.KX, (const attn_body::bf16*)F.VX, (attn_body::bf16*)F.OB, F.CB, (char*)lds);
            attn_body::attn_unit<8>(bh >> 3, bh & 7, 7 - s, (const attn_body::bf16*)F.QO, (const attn_body::bf16*)F.KX, (const attn_body::bf16*)F.VX, (attn_body::bf16*)F.OB, F.CB, (char*)lds); }
        __syncthreads();
        for (int u = (int)blockIdx.x; u < NB * 64; u += F.G) conv_unit(F, u >> 6, u & 63);
        __syncthreads();
        if (BOTH(2)) GRID_BAR();
    }

    if (IN(3)) {
        SchedDual S; S.so.init(NR / 256, 4, F.G, (int)blockIdx.x); S.A0 = (const char*)F.CACT; S.B0 = (const char*)F.WCT; S.A1 = (const char*)F.OB; S.B1 = (const char*)F.WAT; S.K = 512;
        Epi3 E{F.b_conv_out, F.SG, F.MERGED};
        pg8::gemm_phase<Epi3, SchedDual, true>(F.lds, 512, S, E);
        if (BOTH(3)) GRID_BAR();
    }

    if (IN(4)) {
        SchedPlain S; S.so.init(NR / 256, 4, F.G, (int)blockIdx.x); S.A = (const char*)F.MERGED; S.B = (const char*)F.WOT; S.K = 1024;
        Epi4 E{F.x, F.out};
        pg8::gemm_phase<Epi4, SchedPlain, true>(F.lds, 1024, S, E);
        if (BOTH(4)) GRID_BAR();
    }

    if (IN(5)) {
        if (F.wave >= RT_WAVES) convert_experts(F, F.G == 256 ? CVT_EARLY_N : 0, CVT_GU + CVT_D, F.vcu * (NWAVES - RT_WAVES) + (F.wave - RT_WAVES), F.G * (NWAVES - RT_WAVES)); else p5_router(F);
        if (BOTH(5)) GRID_BAR(); }

    if (IN(6)) {
        const int nt = moe_table(F);
        const LAS int* cntl = (const LAS int*)(F.lds + TAB_OFF);
        const int U6 = 2 * nt, G = F.G, c = F.vcu;
        const bool overlap = U6 > G && U6 <= 2 * G && (G & 1) == 0;
        int K7 = 256; asm volatile("" : "+s"(K7));
        Epi6 E6{cntl, F.TOK, F.RS, F.HB}; Epi7 E7{cntl, F.TOK, F.WL, F.YB};
        { SchedMoe S{0, overlap ? G : U6, G, c, 1, cntl + 64, cntl, (const char*)F.HN, (const char*)F.WGU, F.TOK, 1024, 512, true};
          pg8::gemm_phase<Epi6, SchedMoe, true, true>(F.lds, 1024, S, E6);
        }
        GRID_BAR();
        if (overlap) {
            if (c < U6 - G) { SchedMoe S{G, U6, G, c, 1, cntl + 64, cntl, (const char*)F.HN, (const char*)F.WGU, F.TOK, 1024, 512, true};
                pg8::gemm_phase<Epi6, SchedMoe, true, true>(F.lds, 1024, S, E6); }
            else { SchedMoe S{0, 2 * G, 2 * G - U6, c - (U6 - G), 2, cntl + 64, cntl, (const char*)F.HB, (const char*)F.WD, F.TOK, K7, 1024, false};
                pg8::gemm_phase<Epi7, SchedMoe, true>(F.lds, K7, S, E7); }
            GRID_BAR();
        }
        { SchedMoe S{overlap ? 2 * G : 0, 4 * nt, G, c, 2, cntl + 64, cntl, (const char*)F.HB, (const char*)F.WD, F.TOK, K7, 1024, false};
          pg8::gemm_phase<Epi7, SchedMoe, true>(F.lds, K7, S, E7);
        }
        GRID_BAR();
    }
    if (IN(8)) {
        p8_combine(F); }
#undef IN
#undef BOTH
}


extern "C" void kernel_launch(void* const* d_in, const int* in_sizes, int n_in, void* d_out, int out_size, void* d_ws, size_t ws_size, hipStream_t stream) {
    static int grid = 0;
    if (grid == 0) {
        if (n_in != 24 || in_sizes[0] != NR * DM || out_size != NR * DM || ws_size < WS_END) {
            fprintf(stderr, "kernel_launch: unexpected shapes (n_in %d, in0 %d, out %d, ws %zu); nothing launched\n", n_in, n_in > 0 ? in_sizes[0] : -1, out_size, ws_size); grid = -1; return; }
        int dev = 0, cus = 0, per_cu = 0;
        if (hipGetDevice(&dev) != hipSuccess || hipDeviceGetAttribute(&cus, hipDeviceAttributeMultiprocessorCount, dev) != hipSuccess) { grid = -1; return; }
        if (hipFuncSetAttribute((const void*)fwd_kernel, hipFuncAttributeMaxDynamicSharedMemorySize, LDS_BYTES) != hipSuccess) { fprintf(stderr, "kernel_launch: hipFuncSetAttribute failed\n"); grid = -1; return; }
        if (hipOccupancyMaxActiveBlocksPerMultiprocessor(&per_cu, (const void*)fwd_kernel, NWAVES * 64, LDS_BYTES) != hipSuccess || per_cu < 1) { fprintf(stderr, "kernel_launch: occupancy query reports %d blocks per CU\n", per_cu); (void)hipGetLastError(); grid = -1; return; }
        grid = cus;
    }
    if (grid < 0) return;
    if (hipMemsetAsync((char*)d_ws + WS_CTL, 0, CTL_ZERO_BYTES, stream) != hipSuccess) return;
    Args a{};
    for (int i = 0; i < 24; ++i) a.in[i] = (const float*)d_in[i];
    a.out = (float*)d_out; a.ws = (unsigned char*)d_ws;
    if (MK_N_LAUNCHES == 1) { a.ph_lo = 0; a.ph_hi = N_PHASES; hipLaunchKernelGGL(fwd_kernel, dim3(grid), dim3(NWAVES * 64), LDS_BYTES, stream, a); }
    else for (int p = 0; p < N_PHASES; ++p) { a.ph_lo = p; a.ph_hi = p + 1; hipLaunchKernelGGL(fwd_kernel, dim3(grid), dim3(NWAVES * 64), LDS_BYTES, stream, a); }
}
```

```cpp
#include <hip/hip_runtime.h>
#include <hip/hip_bf16.h>
#include <cstdio>
#include <cstdint>
#include <cmath>

#define GAS __attribute__((address_space(1)))
#define LAS __attribute__((address_space(3)))
typedef unsigned short bf16_t;
typedef short bf16x8 __attribute__((ext_vector_type(8)));
typedef float f32x4 __attribute__((ext_vector_type(4)));
typedef float f32x2 __attribute__((ext_vector_type(2)));
typedef unsigned u32x4 __attribute__((ext_vector_type(4)));
typedef unsigned u32x2 __attribute__((ext_vector_type(2)));

__device__ __forceinline__ unsigned cvt_pk_bf16(float lo, float hi) { unsigned r; asm volatile("v_cvt_pk_bf16_f32 %0, %1, %2" : "=v"(r) : "v"(lo), "v"(hi)); return r; }
__device__ __forceinline__ float bf_lo(unsigned w) { return __uint_as_float(w << 16); }
__device__ __forceinline__ float bf_hi(unsigned w) { return __uint_as_float(w & 0xffff0000u); }
__device__ __forceinline__ float bf2f(bf16_t b) { return __uint_as_float((unsigned)b << 16); }
__device__ __forceinline__ float sigmoidf_(float x) { return __builtin_amdgcn_rcpf(1.0f + __builtin_amdgcn_exp2f(-1.4426950408889634f * x)); }

namespace pg8 {
constexpr int BM = 256, BK = 64, HALF = 128, HTB = HALF * BK * 2  , STAGE_BYTES = 8 * HTB;

__host__ __device__ __forceinline__ int lds_byte(int r, int c) { const int st = (r >> 4) * 2 + (c >> 5), rr = r & 15, cc = c & 31, ob = rr * 64 + cc * 2; return st * 1024 + (ob ^ (((ob >> 9) & 1) << 5)); }
__host__ __device__ __forceinline__ void stage_rc(int b, int& R, int& C) { const int st = b / 1024, sb = b % 1024, swz = sb ^ (((sb >> 9) & 1) << 5); R = (st >> 1) * 16 + swz / 64; C = (st & 1) * 32 + (swz % 64) / 2; }
__host__ __device__ __forceinline__ int perm32(int rho) { const int n = rho >> 4, i = rho & 15; return 8 * (i >> 2) + 4 * n + (i & 3); }

struct Unit { int pm, pn, e; };

template <class Epi, class Sched, bool ALIGN_EPI, bool GATHER = false, bool PARTIAL = false>
__device__ __forceinline__ void gemm_phase(LAS unsigned char* lds, const int K, const Sched& S, Epi& E) {
    int tid = threadIdx.x; asm volatile("" : "+v"(tid));
    const int wid = __builtin_amdgcn_readfirstlane(tid >> 6), lane = tid & 63, wr = wid >> 2, wc = wid & 3, fr = lane & 15, fq = lane >> 4;
    const int nt = K / BK;
    int Rr[2], Cc[2]; unsigned voffB[2], voffA[2];
#pragma unroll
    for (int i = 0; i < 2; ++i) { stage_rc(tid * 16 + i * 8192, Rr[i], Cc[i]); const int Rb = Epi::PERM ? ((Rr[i] & ~31) + perm32(Rr[i] & 31)) : Rr[i]; voffB[i] = (unsigned)(Rb * K + Cc[i]) * 2u; voffA[i] = (unsigned)(Rr[i] * K + Cc[i]) * 2u; }
    const size_t kstep = (size_t)(BK * 2);
    const size_t hstep = (size_t)HALF * K * 2;
    const unsigned ldsw = (unsigned)wid * 1024u;
    const int aoff = lds_byte(wr * 64 + fr, fq * 8), boff = lds_byte(wc * 32 + fr, fq * 8);
#define PG8_SA(b, h) (((b) * 2 + (h)) * HTB)
#define PG8_SB(b, h) ((4 + (b) * 2 + (h)) * HTB)
#define PG8_STAGE(bufoff, gbase, voff) do { _Pragma("unroll") for (int _i = 0; _i < 2; ++_i) \
        __builtin_amdgcn_global_load_lds((const unsigned*)((const char*)(gbase) + (voff)[_i]), (LAS unsigned*)(lds + (bufoff) + ldsw + _i * 8192), 16, 0, 0); } while (0)
#define PG8_STAGE_A(bufoff, gbase, h, OFFS) do { _Pragma("unroll") for (int _i = 0; _i < 2; ++_i) { \
        const char* _src; if constexpr (GATHER) _src = (const char*)(gbase) + (OFFS)[h][_i]; else _src = (const char*)(gbase) + (size_t)(h) * hstep + voffA[_i]; \
        __builtin_amdgcn_global_load_lds((const unsigned*)_src, (LAS unsigned*)(lds + (bufoff) + ldsw + _i * 8192), 16, 0, 0); } } while (0)
#define PG8_LDA(dst, b, h) do { _Pragma("unroll") for (int m = 0; m < 4; ++m) _Pragma("unroll") for (int k = 0; k < 2; ++k) dst[m][k] = *(const LAS bf16x8*)(lds + PG8_SA(b, h) + aoff + m * 2048 + k * 1024); } while (0)
#define PG8_LDB(dst, b, h) do { _Pragma("unroll") for (int n = 0; n < 2; ++n) _Pragma("unroll") for (int k = 0; k < 2; ++k) dst[n][k] = *(const LAS bf16x8*)(lds + PG8_SB(b, h) + boff + n * 2048 + k * 1024); } while (0)
#define PG8_MMA(ai, bj, At, Bt) do { __builtin_amdgcn_s_setprio(1); _Pragma("unroll") for (int m = 0; m < 4; ++m) _Pragma("unroll") for (int n = 0; n < 2; ++n) _Pragma("unroll") for (int k = 0; k < 2; ++k) \
        acc[ai][bj][m][n] = __builtin_amdgcn_mfma_f32_16x16x32_bf16(Bt[n][k], At[m][k], acc[ai][bj][m][n], 0, 0, 0); __builtin_amdgcn_s_setprio(0); } while (0)
#define PG8_WAIT_V(n) asm volatile("s_waitcnt vmcnt(" #n ")" ::: "memory")
#define PG8_WAIT_L(n) asm volatile("s_waitcnt lgkmcnt(" #n ")" ::: "memory")
#define PG8_BAR __builtin_amdgcn_s_barrier()
#define PG8_SCHED __builtin_amdgcn_sched_barrier(0)
    Unit cur, nxt; int ui = 0;
    if (!S.next(0, cur)) return;
    f32x4 acc[2][2][4][2];
#pragma unroll
    for (int a = 0; a < 2; ++a)
#pragma unroll
        for (int b = 0; b < 2; ++b)
#pragma unroll
            for (int m = 0; m < 4; ++m)
#pragma unroll
                for (int n = 0; n < 2; ++n) acc[a][b][m][n] = (f32x4){0.f, 0.f, 0.f, 0.f};
    bf16x8 At[4][2], B0[2][2], B1[2][2];
    unsigned ao[2][2], nao[2][2];
    if constexpr (GATHER) S.a_offs(cur, Rr, Cc, ao);
    const char* cA = S.a_base(cur); const char* cB = S.b_base(cur);
    PG8_STAGE(PG8_SB(0, 0), cB, voffB); PG8_STAGE(PG8_SB(0, 1), cB + hstep, voffB); PG8_STAGE_A(PG8_SA(0, 0), cA, 0, ao); PG8_STAGE_A(PG8_SA(0, 1), cA, 1, ao);
    if (wr == 1) PG8_BAR;
    PG8_WAIT_V(2); PG8_BAR;
    PG8_STAGE(PG8_SB(1, 0), cB + kstep, voffB); PG8_STAGE_A(PG8_SA(1, 0), cA + kstep, 0, ao); PG8_STAGE(PG8_SB(1, 1), cB + hstep + kstep, voffB);
    PG8_WAIT_V(6); PG8_BAR;
    for (;;) {
        const bool has_next = S.next(ui + 1, nxt);
        const char* nA = cA; const char* nB = cB;
        if (has_next) { if constexpr (GATHER) S.a_offs(nxt, Rr, Cc, nao); nA = S.a_base(nxt); nB = S.b_base(nxt); }
        else if constexpr (GATHER) {
#pragma unroll
            for (int h = 0; h < 2; ++h)
#pragma unroll
                for (int i = 0; i < 2; ++i) nao[h][i] = ao[h][i];
        }
        for (int t = 0; t < nt; t += 2) {
            const bool last = (t == nt - 2);
            const char* a1 = cA + (size_t)(t + 1) * kstep;
            const char* a2 = last ? nA : cA + (size_t)(t + 2) * kstep; const char* b2 = last ? nB : cB + (size_t)(t + 2) * kstep;
            const char* a3 = a2 + kstep; const char* b3 = b2 + kstep;
            unsigned xo[2][2];
            if constexpr (GATHER) {
#pragma unroll
                for (int h = 0; h < 2; ++h)
#pragma unroll
                    for (int i = 0; i < 2; ++i) xo[h][i] = last ? nao[h][i] : ao[h][i];
            }
            PG8_LDB(B0, 0, 0); PG8_LDB(B1, 0, 1); PG8_SCHED; PG8_LDA(At, 0, 0); PG8_STAGE_A(PG8_SA(1, 1), a1, 1, ao);
            PG8_WAIT_V(8); PG8_WAIT_L(0); PG8_BAR; PG8_MMA(0, 0, At, B0); PG8_MMA(0, 1, At, B1); PG8_BAR; PG8_SCHED;
            PG8_LDA(At, 0, 1); PG8_STAGE(PG8_SB(0, 0), b2, voffB); PG8_STAGE(PG8_SB(0, 1), b2 + hstep, voffB); PG8_STAGE_A(PG8_SA(0, 0), a2, 0, xo);
            PG8_WAIT_V(8); PG8_WAIT_L(0); PG8_BAR; PG8_MMA(1, 0, At, B0); PG8_MMA(1, 1, At, B1); PG8_BAR; PG8_SCHED;
            PG8_LDB(B0, 1, 0); PG8_LDB(B1, 1, 1); PG8_SCHED; PG8_LDA(At, 1, 0); PG8_STAGE_A(PG8_SA(0, 1), a2, 1, xo);
            PG8_WAIT_V(8); PG8_WAIT_L(0); PG8_BAR; PG8_MMA(0, 0, At, B0); PG8_MMA(0, 1, At, B1); PG8_BAR; PG8_SCHED;
            PG8_LDA(At, 1, 1); PG8_STAGE(PG8_SB(1, 0), b3, voffB); PG8_STAGE(PG8_SB(1, 1), b3 + hstep, voffB); PG8_STAGE_A(PG8_SA(1, 0), a3, 0, xo);
            PG8_WAIT_V(8); PG8_WAIT_L(0); PG8_BAR; PG8_MMA(1, 0, At, B0); PG8_MMA(1, 1, At, B1); PG8_BAR; PG8_SCHED;
        }
        if constexpr (ALIGN_EPI) { if (wr == 0) PG8_BAR; }
        const bool keep = E(acc, cur, wr, wc, fr, fq);
        if (!has_next) break;
        if (!keep) {
#pragma unroll
            for (int a = 0; a < 2; ++a)
#pragma unroll
                for (int b = 0; b < 2; ++b)
#pragma unroll
                    for (int m = 0; m < 4; ++m)
#pragma unroll
                        for (int n = 0; n < 2; ++n) acc[a][b][m][n] = (f32x4){0.f, 0.f, 0.f, 0.f};
        }
        cur = nxt; cA = nA; cB = nB; ++ui;
        if constexpr (GATHER) {
#pragma unroll
            for (int h = 0; h < 2; ++h)
#pragma unroll
                for (int i = 0; i < 2; ++i) ao[h][i] = nao[h][i];
        }
        if constexpr (ALIGN_EPI) { if (wr == 1) PG8_BAR; }
    }
    PG8_WAIT_V(0);
    if constexpr (!ALIGN_EPI) { if (wr == 0) PG8_BAR; }
    PG8_BAR;
#undef PG8_SA
#undef PG8_SB
#undef PG8_STAGE
#undef PG8_STAGE_A
#undef PG8_LDA
#undef PG8_LDB
#undef PG8_MMA
#undef PG8_WAIT_V
#undef PG8_WAIT_L
#undef PG8_BAR
#undef PG8_SCHED
}
}
namespace attn_body {
using bf16=__hip_bfloat16;
using bf16x8=__attribute__((ext_vector_type(8)))short;
using s16x4=__attribute__((ext_vector_type(4)))short;
using f32x16=__attribute__((ext_vector_type(16)))float;
using u32x4=__attribute__((ext_vector_type(4)))unsigned;
constexpr int BATCH=8,NHEAD=8,SEQ=2048,KVROWS=2112,D=64,DM=NHEAD*D;
constexpr int NW=8,QBLK=32,QB=QBLK*NW,KVBLK=64,NQB=SEQ/QB;
constexpr int ATTN_PITCH=DM, ATTN_UNIT_ROWS=QB;
__device__ __forceinline__ int crow(int r,int hi){return (r&3)+8*(r>>2)+4*hi;}
#define SBAR() __builtin_amdgcn_sched_barrier(0)
__device__ __forceinline__ void cmask(f32x16&p0,f32x16&p1,int jb,int qrel,int hi){
  asm volatile("":"+v"(hi),"+v"(qrel));
  const float NEG=-INFINITY; int kb=64*jb+4*hi;
  #pragma unroll
  for(int r=0;r<16;++r){int kv=kb+(r&3)+8*(r>>2); if(kv>qrel)p0[r]=NEG; if(kv+32>qrel)p1[r]=NEG;}
}

constexpr int NSLOT=3, SLOTB=8192;
constexpr int LDS_K=0, LDS_V=NSLOT*SLOTB, LDS_WS=2*NSLOT*SLOTB, LDS_OST=LDS_WS+NW*64*4, LDS_CBT=LDS_OST+NW*4096, LDS_BYTES=LDS_CBT+KVROWS*4;
constexpr float C2=0.125f*1.4426950408889634f;
__device__ __forceinline__ void glds16(const void*gsrc,unsigned lds_dst){unsigned keep;
  asm volatile("s_mov_b32 %0, m0\n\ts_mov_b32 m0, %2\n\ts_nop 0\n\tglobal_load_lds_dwordx4 %1, off\n\ts_mov_b32 m0, %0":"=&s"(keep):"v"(gsrc),"s"(lds_dst):"memory");}
__device__ __forceinline__ float max3f(float a,float b,float c){float r;asm("v_max3_f32 %0, %1, %2, %3":"=v"(r):"v"(a),"v"(b),"v"(c));return r;}
__device__ __forceinline__ float max2f(float a,float b){float r;asm("v_max_f32_e32 %0, %1, %2":"=v"(r):"v"(a),"v"(b));return r;}
__device__ __forceinline__ float fadd_s(float a,float b){float r;asm("v_add_f32_e32 %0, %1, %2":"=v"(r):"v"(a),"v"(b));return r;}
__device__ __forceinline__ float fsub_s(float a,float b){float r;asm("v_sub_f32_e32 %0, %1, %2":"=v"(r):"v"(a),"v"(b));return r;}
typedef float f32x2_t __attribute__((ext_vector_type(2))); typedef float f32x4_t __attribute__((ext_vector_type(4))); typedef __bf16 bf16x2_t __attribute__((ext_vector_type(2)));
__device__ __forceinline__ unsigned cvtpk_s(float lo,float hi){f32x2_t v={lo,hi};bf16x2_t b=__builtin_convertvector(v,bf16x2_t);return __builtin_bit_cast(unsigned,b);}
#define WAIT_BAR(N) asm volatile("s_waitcnt vmcnt(" #N ") lgkmcnt(0)\n\ts_barrier":::"memory")

__device__ __forceinline__ void qkt(f32x16&p0,f32x16&p1,const char*Kslot,const bf16x8*qr,const f32x16&negm,int r32,int hi){
  const char*kb=Kslot+hi*1024+r32*16;
  #pragma unroll
  for(int d0=0;d0<4;++d0){
    const bf16x8 b0=*reinterpret_cast<const bf16x8*>(kb+d0*2048);
    const bf16x8 b1=*reinterpret_cast<const bf16x8*>(kb+d0*2048+512);
    if(d0==0){p0=__builtin_amdgcn_mfma_f32_32x32x16_bf16(b0,qr[0],negm,0,0,0);p1=__builtin_amdgcn_mfma_f32_32x32x16_bf16(b1,qr[0],negm,0,0,0);}
    else{p0=__builtin_amdgcn_mfma_f32_32x32x16_bf16(b0,qr[d0],p0,0,0,0);p1=__builtin_amdgcn_mfma_f32_32x32x16_bf16(b1,qr[d0],p1,0,0,0);}}
}
typedef __attribute__((address_space(3))) const char* lds_cptr;
typedef short v4i16_t __attribute__((ext_vector_type(4)));
__device__ __forceinline__ void kload8(bf16x8*kf,lds_cptr kp){
  kf[0]=*(const __attribute__((address_space(3))) bf16x8*)(kp);      kf[1]=*(const __attribute__((address_space(3))) bf16x8*)(kp+512);
  kf[2]=*(const __attribute__((address_space(3))) bf16x8*)(kp+2048); kf[3]=*(const __attribute__((address_space(3))) bf16x8*)(kp+2560);
  kf[4]=*(const __attribute__((address_space(3))) bf16x8*)(kp+4096); kf[5]=*(const __attribute__((address_space(3))) bf16x8*)(kp+4608);
  kf[6]=*(const __attribute__((address_space(3))) bf16x8*)(kp+6144); kf[7]=*(const __attribute__((address_space(3))) bf16x8*)(kp+6656);
}
__device__ __forceinline__ void kload2(bf16x8*kf,lds_cptr kp,int j){ kf[2*j]=*(const __attribute__((address_space(3))) bf16x8*)(kp+j*2048); kf[2*j+1]=*(const __attribute__((address_space(3))) bf16x8*)(kp+j*2048+512); }
__device__ __forceinline__ s16x4 vtr(lds_cptr p){ return __builtin_bit_cast(s16x4,__builtin_amdgcn_ds_read_tr16_b64_v4i16((__attribute__((address_space(3))) v4i16_t*)p)); }
__device__ __forceinline__ float rowmax(const f32x16&p0,const f32x16&p1){
  float a=max3f(p0[0],p0[1],p1[0]),b=max3f(p0[2],p0[3],p1[1]);a=max3f(a,p1[2],p1[3]);
  #pragma unroll
  for(int r=4;r<16;r+=4){a=max3f(a,p0[r],p0[r+1]);b=max3f(b,p0[r+2],p0[r+3]);a=max3f(a,p1[r],p1[r+1]);b=max3f(b,p1[r+2],p1[r+3]);}
  const float m=max2f(a,b);
  auto rr=__builtin_amdgcn_permlane32_swap(__float_as_uint(m),__float_as_uint(m),false,false);
  return max2f(__uint_as_float(rr[0]),__uint_as_float(rr[1]));
}
__device__ __forceinline__ void pv(f32x16*o,int vb,bf16x8 pa0,bf16x8 pa1,bf16x8 pa2,bf16x8 pa3){
  #pragma unroll
  for(int d0=0;d0<2;++d0){s16x4 lo[4],hi[4];
    #pragma unroll
    for(int ks=0;ks<4;++ks){
      asm volatile("ds_read_b64_tr_b16 %0,%1 offset:%c2":"=&v"(lo[ks]):"v"(vb),"i"(d0*4096+ks*1024):"memory");
      asm volatile("ds_read_b64_tr_b16 %0,%1 offset:%c2":"=&v"(hi[ks]):"v"(vb),"i"(d0*4096+ks*1024+512):"memory");}
    asm volatile("s_waitcnt lgkmcnt(0)":::"memory");SBAR();
    #define PK(k) (bf16x8){lo[k][0],lo[k][1],lo[k][2],lo[k][3],hi[k][0],hi[k][1],hi[k][2],hi[k][3]}
    o[d0]=__builtin_amdgcn_mfma_f32_32x32x16_bf16(pa0,PK(0),o[d0],0,0,0);
    o[d0]=__builtin_amdgcn_mfma_f32_32x32x16_bf16(pa1,PK(1),o[d0],0,0,0);
    o[d0]=__builtin_amdgcn_mfma_f32_32x32x16_bf16(pa2,PK(2),o[d0],0,0,0);
    o[d0]=__builtin_amdgcn_mfma_f32_32x32x16_bf16(pa3,PK(3),o[d0],0,0,0);
    #undef PK
  }
}

#ifndef ATTN_STORE16
#define ATTN_STORE16(p,v) (*(u32x4*)(p)=(v))
#endif
template<int THRL> __device__ __forceinline__ void attn_unit(int b,int h,int qb,const bf16*Q,const bf16*__restrict__ K,const bf16*__restrict__ V,bf16*O,const float*__restrict__ CB,char*shm){
  const int tid=threadIdx.x,lane=tid&63,r32=lane&31,hi=lane>>5; const int wid=__builtin_amdgcn_readfirstlane(tid>>6);
  const long rowbase=(long)b*SEQ, kvbase=(long)b*KVROWS; const int q0=qb*QB;
  const bf16*Qw=Q+(rowbase+q0+wid*QBLK)*DM+h*D;
  const bf16*Kh=K+kvbase*DM+h*D,*Vh=V+kvbase*DM+h*D;
  const unsigned lds0=(unsigned)(uintptr_t)shm;
  float*wsf=(float*)(shm+LDS_WS)+wid*64;
  const bf16*ksrc=Kh+(long)lane*DM+wid*8;
  const bf16*vsrc=Vh+(long)(16*(wid&3)+(lane>>2))*DM+(wid>>2)*32+(lane&3)*8;
  const unsigned kdst=lds0+LDS_K+wid*1024, vdst=lds0+LDS_V+wid*1024;
  #define DMA_K(t,slot) glds16(ksrc+(long)(t)*KVBLK*DM,(unsigned)__builtin_amdgcn_readfirstlane(kdst+(slot)))
  #define DMA_V(t,slot) glds16(vsrc+(long)(t)*KVBLK*DM,(unsigned)__builtin_amdgcn_readfirstlane(vdst+(slot)))
  const int vb0=(int)(lds0+LDS_V)+((lane>>4)&1)*32+(lane&3)*8+(4*hi+((lane&15)>>2))*64;
  const char*Kbase=shm+LDS_K; bf16x8 kf[8];
  const lds_cptr shm3=(lds_cptr)shm; const lds_cptr kp0=shm3+LDS_K+hi*1024+r32*16; const lds_cptr vp0=shm3+LDS_V+((lane>>4)&1)*32+(lane&3)*8+(4*hi+((lane&15)>>2))*64;
  const int NT=(q0+QB)/KVBLK+1;
  typedef __attribute__((address_space(3))) float* lds_fptr; const lds_fptr cbt=(lds_fptr)(shm+LDS_CBT);
  { const float*cbg=CB+(long)(b*NHEAD+h)*KVROWS; const float ref=cbg[64+q0]; for(int i=tid;i<NT*KVBLK;i+=NW*64)cbt[i]=cbg[i]-ref; }
  DMA_K(0,0);DMA_V(0,0);DMA_K(1,SLOTB);
  bf16x8 qr[4];
  #pragma unroll
  for(int d0=0;d0<4;++d0)qr[d0]=*reinterpret_cast<const bf16x8*>(&Qw[(long)r32*DM+d0*16+hi*8]);
  float mhat=0.f,l_reg=0.f;f32x16 o[2];o[0]=f32x16{};o[1]=f32x16{};const f32x16 zero16=f32x16{}; f32x16 negm=f32x16{};
  const int qrel=wid*QBLK+r32;
  #define CMASK(P0,P1,t) do{int jb_=(t)-(NT-4); if(jb_>=0)cmask(P0,P1,jb_,qrel,hi);}while(0)
  typedef __attribute__((address_space(3))) const f32x4_t* lds_f4ptr;
  #define BIAS(P0,P1,t) do{ const lds_f4ptr bp_=(lds_f4ptr)(cbt+64*(t)+4*hi); \
    _Pragma("unroll") for(int g_=0;g_<4;++g_){ const f32x4_t b0_=bp_[2*g_], b1_=bp_[8+2*g_]; \
      _Pragma("unroll") for(int j_=0;j_<4;++j_){ P0[4*g_+j_]+=b0_[j_]; P1[4*g_+j_]+=b1_[j_]; } } }while(0)
  bool resc=false;
  #define START(P0,P1) do{ const float rm=rowmax(P0,P1); resc=false; \
    { const float dl=__builtin_fmaxf(rm,0.f); mhat=fadd_s(mhat,dl); _Pragma("unroll") for(int r=0;r<16;++r)negm[r]=-mhat; asm volatile("":"+v"(negm)); \
      _Pragma("unroll") for(int r=0;r<16;++r){P0[r]=fsub_s(P0[r],dl);P1[r]=fsub_s(P1[r],dl);} \
      } \
    _Pragma("unroll") for(int r=0;r<16;++r)P0[r]=__builtin_amdgcn_exp2f(P0[r]); }while(0)
  #define RESC() do{ if(resc){ asm volatile("s_waitcnt lgkmcnt(0)":::"memory"); \
      _Pragma("unroll") for(int d_=0;d_<2;++d_) _Pragma("unroll") for(int r=0;r<16;++r)o[d_][r]*=wsf[crow(r,hi)]; } }while(0)
  f32x16 pA0,pA1,pB0,pB1;
  int sl_prev=0,sl_cur=0,sl_next=SLOTB;
  #define ROT() do{sl_prev=sl_cur;sl_cur=sl_next;sl_next=(sl_next==(NSLOT-1)*SLOTB)?0:sl_next+SLOTB;}while(0)
  DMA_K(2,2*SLOTB);
  WAIT_BAR(3);
  mhat=cbt[64+q0+qrel]+14.0f; _Pragma("unroll") for(int r=0;r<16;++r)negm[r]=-mhat; asm volatile("":"+v"(negm));
  qkt(pA0,pA1,Kbase,qr,negm,r32,hi);asm volatile("s_nop 15\n\ts_nop 7":"+v"(pA0),"+v"(pA1));BIAS(pA0,pA1,0);CMASK(pA0,pA1,0);
  START(pA0,pA1);
  _Pragma("unroll") for(int r=0;r<16;++r)pA1[r]=__builtin_amdgcn_exp2f(pA1[r]);
  WAIT_BAR(0);
  DMA_K(3,0);DMA_V(1,SLOTB);
  ROT();
  kload8(kf,kp0+sl_cur);
  WAIT_BAR(2);
  s16x4 vlo[8],vhi[8]; u32x4 pw0,pw1,pw2,pw3;
  #define PKW(P,B) cvtpk_s(P[B],P[B+1])
  #define PAF(k) __builtin_bit_cast(bf16x8,pw##k)
  #define VFR(i) (bf16x8){vlo[i][0],vlo[i][1],vlo[i][2],vlo[i][3],vhi[i][0],vhi[i][1],vhi[i][2],vhi[i][3]}
  #define PIN(x) asm volatile("":"+v"(x))
  #define MX3(a,b,c) __builtin_fmaxf(__builtin_fmaxf((a),(b)),(c))
  #define GAPA(MF,A0,A1,A2,A3,W0,W1,PW) do{ MF; sacc+=A0; sacc+=A1; sacc+=A2; sacc+=A3; PIN(sacc); W0; W1; PIN(PW); SBAR(); }while(0)
  #define EX(v) __builtin_amdgcn_exp2f(v)
  #define GAPB(MF,X,B) do{ MF; X[B]=EX(X[B]); X[B+1]=EX(X[B+1]); X[B+2]=EX(X[B+2]); X[B+3]=EX(X[B+3]); PIN(X); SBAR(); }while(0)
  #define VRD(i) do{ vlo[i]=vtr(vp_+(((i)>>2)*4096+((i)&3)*1024)); vhi[i]=vtr(vp_+(((i)>>2)*4096+((i)&3)*1024+512)); }while(0)
  #define KRD(G,j) do{ if(G){ kload2(kf,kp0+sl_next,j); SBAR(); } }while(0)
  #define STEP(C0,C1,P0,P1,t,GK,GV,GL) do{ SBAR(); \
    const lds_cptr vp_=vp0+sl_prev; \
    VRD(0); SBAR(); float sacc=(P0[0]+P0[1]); \
    GAPA(C0=__builtin_amdgcn_mfma_f32_32x32x16_bf16(kf[0],qr[0],negm,0,0,0), P0[2],P0[3],P0[4],P0[5],     pw0[0]=PKW(P0,0), pw0[1]=PKW(P0,2), pw0); \
    VRD(4); SBAR(); GAPA(C1=__builtin_amdgcn_mfma_f32_32x32x16_bf16(kf[1],qr[0],negm,0,0,0), P0[6],P0[7],P0[8],P0[9],     pw0[2]=PKW(P0,4), pw0[3]=PKW(P0,6), pw0); \
    VRD(1); SBAR(); GAPA(C0=__builtin_amdgcn_mfma_f32_32x32x16_bf16(kf[2],qr[1],C0,0,0,0),   P0[10],P0[11],P0[12],P0[13], pw1[0]=PKW(P0,8), pw1[1]=PKW(P0,10), pw1); \
    VRD(5); SBAR(); GAPA(C1=__builtin_amdgcn_mfma_f32_32x32x16_bf16(kf[3],qr[1],C1,0,0,0),   P0[14],P0[15],P1[0],P1[1],   pw1[2]=PKW(P0,12),pw1[3]=PKW(P0,14), pw1); \
    VRD(2); SBAR(); GAPA(C0=__builtin_amdgcn_mfma_f32_32x32x16_bf16(kf[4],qr[2],C0,0,0,0),   P1[2],P1[3],P1[4],P1[5],     pw2[0]=PKW(P1,0), pw2[1]=PKW(P1,2), pw2); \
    VRD(6); SBAR(); GAPA(C1=__builtin_amdgcn_mfma_f32_32x32x16_bf16(kf[5],qr[2],C1,0,0,0),   P1[6],P1[7],P1[8],P1[9],     pw2[2]=PKW(P1,4), pw2[3]=PKW(P1,6), pw2); \
    VRD(3); SBAR(); GAPA(C0=__builtin_amdgcn_mfma_f32_32x32x16_bf16(kf[6],qr[3],C0,0,0,0),   P1[10],P1[11],P1[12],P1[13], pw3[0]=PKW(P1,8), pw3[1]=PKW(P1,10), pw3); \
    VRD(7); SBAR(); GAPA(C1=__builtin_amdgcn_mfma_f32_32x32x16_bf16(kf[7],qr[3],C1,0,0,0),   P1[14],P1[15],0.f,0.f,       pw3[2]=PKW(P1,12),pw3[3]=PKW(P1,14), pw3); \
    l_reg+=sacc; \
    if(GK){DMA_K((t)+3,sl_cur);} if(GV){DMA_V((t)+1,sl_next);} \
    BIAS(C0,C1,t); CMASK(C0,C1,t); \
    { float rm=__builtin_fmaxf(__builtin_fmaxf(C0[0],C0[15]),__builtin_fmaxf(C1[0],C1[15]));   \
      resc=false; \
      if(__builtin_expect(__any(rm>(float)THRL),0)){ const float dl=__builtin_fmaxf(rm,0.f); mhat+=dl; _Pragma("unroll") for(int r=0;r<16;++r)negm[r]=-mhat; asm volatile("":"+v"(negm)); \
        _Pragma("unroll") for(int r=0;r<16;++r){C0[r]-=dl;C1[r]-=dl;} \
        const float f=__builtin_amdgcn_exp2f(-dl); l_reg*=f; if(hi==0)wsf[r32]=f; resc=true; } } \
    SBAR(); \
    GAPB(o[0]=__builtin_amdgcn_mfma_f32_32x32x16_bf16(PAF(0),VFR(0),o[0],0,0,0), C0,0); \
    GAPB(o[1]=__builtin_amdgcn_mfma_f32_32x32x16_bf16(PAF(0),VFR(4),o[1],0,0,0), C0,4); \
    KRD(GL,0); GAPB(o[0]=__builtin_amdgcn_mfma_f32_32x32x16_bf16(PAF(1),VFR(1),o[0],0,0,0), C0,8); \
    KRD(GL,1); GAPB(o[1]=__builtin_amdgcn_mfma_f32_32x32x16_bf16(PAF(1),VFR(5),o[1],0,0,0), C0,12); \
    KRD(GL,2); GAPB(o[0]=__builtin_amdgcn_mfma_f32_32x32x16_bf16(PAF(2),VFR(2),o[0],0,0,0), C1,0); \
    KRD(GL,3); GAPB(o[1]=__builtin_amdgcn_mfma_f32_32x32x16_bf16(PAF(2),VFR(6),o[1],0,0,0), C1,4); \
    GAPB(o[0]=__builtin_amdgcn_mfma_f32_32x32x16_bf16(PAF(3),VFR(3),o[0],0,0,0), C1,8); \
    GAPB(o[1]=__builtin_amdgcn_mfma_f32_32x32x16_bf16(PAF(3),VFR(7),o[1],0,0,0), C1,12); \
    }while(0)
  int t=1;
  #undef CMASK
  #define CMASK(P0,P1,t) do{}while(0)
  for(;t+5<NT;t+=2){
    STEP(pB0,pB1,pA0,pA1,t,true,true,true);     WAIT_BAR(2); RESC(); ROT();
    STEP(pA0,pA1,pB0,pB1,t+1,true,true,true);   WAIT_BAR(2); RESC(); ROT();
  }
  #undef CMASK
  #define CMASK(P0,P1,t) do{int jb_=(t)-(NT-4); if(jb_>=0)cmask(P0,P1,jb_,qrel,hi);}while(0)
  #define ENDW(tt) do{ if((tt)+3<NT){WAIT_BAR(2);} else if((tt)+2<NT){WAIT_BAR(1);} else {WAIT_BAR(0);} }while(0)
  for(;t+2<NT;t+=2){
    STEP(pB0,pB1,pA0,pA1,t,(t+3<NT),(t+1<NT),(t+1<NT));       ENDW(t);   RESC(); ROT();
    STEP(pA0,pA1,pB0,pB1,t+1,(t+4<NT),(t+2<NT),(t+2<NT));     ENDW(t+1); RESC(); ROT();
  }
  STEP(pB0,pB1,pA0,pA1,NT-2,false,true,true); ENDW(NT-2); RESC(); ROT();
  STEP(pA0,pA1,pB0,pB1,NT-1,false,false,false); RESC();
  { float sacc=pA0[0]+pA0[1]; _Pragma("unroll") for(int r=2;r<16;++r)sacc+=pA0[r]; _Pragma("unroll") for(int r=0;r<16;++r)sacc+=pA1[r]; l_reg+=sacc;
    pw0=(u32x4){PKW(pA0,0),PKW(pA0,2),PKW(pA0,4),PKW(pA0,6)};pw1=(u32x4){PKW(pA0,8),PKW(pA0,10),PKW(pA0,12),PKW(pA0,14)};pw2=(u32x4){PKW(pA1,0),PKW(pA1,2),PKW(pA1,4),PKW(pA1,6)};pw3=(u32x4){PKW(pA1,8),PKW(pA1,10),PKW(pA1,12),PKW(pA1,14)};
    SBAR(); pv(o,vb0+sl_cur,PAF(0),PAF(1),PAF(2),PAF(3)); }
  #undef PKW
  #undef PAF
  #undef VFR
  #undef PIN
  #undef MX3
  #undef GAPA
  #undef GAPB
  #undef EX
  #undef VRD
  #undef KRD
  #undef STEP
  #undef ENDW
  {auto rr=__builtin_amdgcn_permlane32_swap(__float_as_uint(l_reg),__float_as_uint(l_reg),false,false);l_reg=__uint_as_float(rr[0])+__uint_as_float(rr[1]);}
  if(hi==0)wsf[32+r32]=l_reg;asm volatile("s_waitcnt lgkmcnt(0)":::"memory");
  float rli[16];
  #pragma unroll
  for(int r=0;r<16;++r)rli[r]=__builtin_amdgcn_rcpf(wsf[32+crow(r,hi)]);
  bf16*Ow=O+(rowbase+q0+wid*QBLK)*DM+h*D;
  { bf16*stg=(bf16*)(shm+LDS_OST)+wid*2048;
    #pragma unroll
    for(int r=0;r<16;++r){const int orow=crow(r,hi);
      #pragma unroll
      for(int d0=0;d0<2;++d0)stg[orow*64+d0*32+r32]=__float2bfloat16(o[d0][r]*rli[r]);}
    asm volatile("s_waitcnt lgkmcnt(0)":::"memory");
    #pragma unroll
    for(int i=0;i<4;++i){const int row=i*8+(lane>>3),ch=lane&7; const u32x4 v=*(const u32x4*)(stg+row*64+ch*8); ATTN_STORE16(Ow+(long)row*DM+ch*8,v);} }
  asm volatile("s_waitcnt lgkmcnt(0)\n\ts_barrier":::"memory");
  #undef DMA_K
  #undef DMA_V
  #undef CMASK
  #undef BIAS
  #undef START
  #undef RESC
  #undef ROT
}
constexpr int ATTN_LDS_BYTES=LDS_BYTES;
#undef SBAR
#undef WAIT_BAR
}

constexpr int NWAVES = 8;
#ifndef MK_N_LAUNCHES
#define MK_N_LAUNCHES 1
#endif
constexpr int N_PHASES = 9;
constexpr int DM = 1024, NB = 8, SEQ = 2048, NMETA = 16, NR = NB * SEQ, NRX = NR + 256;
constexpr int CWID = 512, CK = 31, NH = 8, HD = 64;
constexpr int INCOLS = 4616, N1 = 4608, FCOL = 2560, GCOL = 2568;
constexpr int NE = 64, DE = 256, MOE_CAP = NR, MAXT = 192;
constexpr int AROWS = 2080, KROWS = 2112;
constexpr float RMS_EPS = 1e-6f, LN_EPS = 1e-5f;
constexpr float LOG2E = 1.4426950408889634f;
constexpr float C2 = 0.125f * LOG2E;
constexpr float NEGBIG = -1e30f;

constexpr size_t MiB = 1u << 20;
constexpr size_t WS_CTL = 0, CTL_ZERO_BYTES = 1 * MiB;
constexpr size_t WS_BIAS1 = 1 * MiB, WS_WR = 1 * MiB + 32 * 1024, WS_RS = 1 * MiB + 512 * 1024;
constexpr size_t WS_W1T = 2 * MiB, WS_WCT = 11 * MiB, WS_WAT = 12 * MiB, WS_WOT = 13 * MiB, WS_WGU = 15 * MiB, WS_WD = 79 * MiB;
constexpr size_t WS_XN = 111 * MiB;
constexpr size_t WS_ABUF = 144 * MiB, WS_CACT = 161 * MiB;
constexpr size_t WS_QO = 177 * MiB, WS_KX = 193 * MiB, WS_VX = 210 * MiB;
constexpr size_t WS_CB = 227 * MiB, WS_LOGF = 228 * MiB, WS_TOK = 229 * MiB, WS_WL = 233 * MiB, WS_O = 237 * MiB, WS_END = 269 * MiB;
constexpr int CW_TMO = 0, CW_CODE = 1, CW_BAR = 4096, CW_CNT = 8192;

constexpr int RING_BYTES = 131072, LDSCTL_OFF = RING_BYTES, MISC_OFF = LDSCTL_OFF + 320, TAB_OFF = RING_BYTES + 1024;
constexpr int LDS_BYTES = 147456;

typedef GAS unsigned gu32;
#define RLX_AGENT __ATOMIC_RELAXED, __HIP_MEMORY_SCOPE_AGENT
#define LDS_WAIT() asm volatile("s_waitcnt lgkmcnt(0)" ::: "memory")
#define VM_WAIT() asm volatile("s_waitcnt vmcnt(0)" ::: "memory")
#define XB_TMO      128
#define XB_XCNT(j)  (256  + 64 * (j))
#define XB_XSUB(j)  (1280 + 64 * (j))
#define XB_XGEN(j)  (2304 + 64 * (j))
#define XB_TOP      3328
#define XB_TOPGEN   3392
#define XCD_BAR_WORDS 3456
#define XB_SPIN_CAP (1u << 18)

__device__ __forceinline__ unsigned xb_ld(unsigned* p)              { return __hip_atomic_load(p, __ATOMIC_RELAXED, __HIP_MEMORY_SCOPE_AGENT); }
__device__ __forceinline__ unsigned xb_add(unsigned* p, unsigned v) { return __hip_atomic_fetch_add(p, v, __ATOMIC_RELAXED, __HIP_MEMORY_SCOPE_AGENT); }
__device__ __forceinline__ unsigned xb_xcc_id() { return (unsigned)__builtin_amdgcn_s_getreg((3 << 11) | 20) & 0xFu; }
#define XB_SPIN(cond, bar) do { unsigned _sp = 0; while (cond) { __builtin_amdgcn_s_sleep(1); \
    if ((++_sp & 255u) == 0u) { if (xb_ld(&(bar)[XB_TMO])) break; if (_sp > XB_SPIN_CAP) { atomicAdd(&(bar)[XB_TMO], 1u); break; } } } } while (0)

struct XcdBarrier {
    unsigned* bar; unsigned x;
    volatile LAS unsigned* st;
};

__device__ __forceinline__ XcdBarrier xcd_barrier_post(unsigned* bar, volatile LAS unsigned* st) {
    XcdBarrier b; b.bar = bar; b.x = xb_xcc_id(); b.st = st;
    if (threadIdx.x == 0) (void)xb_add(&bar[XB_XCNT(b.x)], 1u);
    return b;
}
__device__ __forceinline__ void xcd_barrier_complete(unsigned* bar, unsigned x, unsigned& nloc, unsigned& nx) {
    const unsigned G = gridDim.x * gridDim.y * gridDim.z;
    unsigned sum, cnt, mine, sp = 0u;
    for (;;) {
        sum = 0u; cnt = 0u; mine = 0u;
#pragma unroll
        for (unsigned j = 0; j < 16; ++j) { const unsigned c = xb_ld(&bar[XB_XCNT(j)]); sum += c; cnt += (c > 0u) ? 1u : 0u; mine = (j == x) ? c : mine; }
        if (sum == G) break;
        __builtin_amdgcn_s_sleep(1);
        if ((++sp & 255u) == 0u) { if (xb_ld(&bar[XB_TMO])) break; if (sp > XB_SPIN_CAP) { atomicAdd(&bar[XB_TMO], 1u); break; } }
    }
    nloc = mine > 0u ? mine : 1u; nx = cnt > 0u ? cnt : 1u;
}

__device__ __forceinline__ void xcd_barrier(const XcdBarrier& b) {
    asm volatile("s_waitcnt vmcnt(0)" ::: "memory");
    __syncthreads();
    if (threadIdx.x == 0) {
        unsigned* bar = b.bar;
        __builtin_amdgcn_s_waitcnt(0);
        unsigned nloc = b.st[0], nx = b.st[1];
        if (nloc == 0u) { xcd_barrier_complete(bar, b.x, nloc, nx); b.st[0] = nloc; b.st[1] = nx; }
        const unsigned old = xb_add(&bar[XB_XSUB(b.x)], 1u);
        const unsigned gen = old / nloc;
        if (old + 1u == (gen + 1u) * nloc) {
            __builtin_amdgcn_fence(__ATOMIC_RELEASE, "agent");
            asm volatile("s_waitcnt vmcnt(0)" ::: "memory");
            const unsigned og = xb_add(&bar[XB_TOP], 1u);
            const unsigned tg = og / nx;
            if (og + 1u == (tg + 1u) * nx) xb_add(&bar[XB_TOPGEN], 1u);
            else XB_SPIN(xb_ld(&bar[XB_TOPGEN]) == tg, bar);
            __builtin_amdgcn_fence(__ATOMIC_ACQUIRE, "agent");
            xb_add(&bar[XB_XGEN(b.x)], 1u);
            asm volatile("s_waitcnt vmcnt(0)" ::: "memory");
        } else {
            XB_SPIN(xb_ld(&bar[XB_XGEN(b.x)]) == gen, bar);
            __builtin_amdgcn_fence(__ATOMIC_ACQUIRE, "agent");
            asm volatile("s_waitcnt vmcnt(0)" ::: "memory");
        }
    }
    __syncthreads();
}

struct Frame {
    LAS unsigned char* lds;
    volatile LAS unsigned* MISC;
    unsigned* ctl;
    int tid, lane, wave, vcu, G;
    const float *x, *meta, *norm1_g, *w_in, *b_in, *dw_w, *dw_b, *ln_g, *ln_b, *w_conv_out, *b_conv_out, *q_norm_g, *k_norm_g, *b_forget,
                *w_attn_out, *w_out, *norm2_g, *w_group, *b_group, *w_router, *b_router, *w_gate, *w_up, *w_down;
    float* out;
    float *BIAS1, *RS, *CB, *LOGF, *WL; bf16_t *WRH, *WRL;
    int* TOK;
    bf16_t *W1T, *WCT, *WAT, *WOT, *WGU, *WD, *XN, *MERGED, *ABUF, *CACT, *HN, *QO, *KX, *VX, *HB, *SG, *YB, *OB;
};

__device__ __forceinline__ float wave_sum(float v) {
#pragma unroll
    for (int o = 1; o < 64; o <<= 1) v += __shfl_xor(v, o);
    return v;
}

__device__ __forceinline__ int col1(int p) {
    const int pn = p >> 8, q = p & 255, bj = q >> 7, y = q & 127;
    if (pn < 4) return 128 * pn + y + 512 * bj;
    if (pn < 8) { const int wc = y >> 5, xx = y & 31, head = 4 * (pn & 1) + wc, dim = 32 * bj + xx; return (pn < 6 ? 1024 : 1536) + 64 * head + dim; }
    if (pn < 10) return 2048 + 256 * (pn - 8) + q;
    return GCOL + 256 * (pn - 10) + q;
}

__device__ __forceinline__ void tr_item(const float* W, int ldw, int k0, int n0, bf16_t* WT, int ldk, int row0, LAS float* scr, int lane) {
    { f32x4 v[8];
#pragma unroll
      for (int i = 0; i < 8; ++i) v[i] = *(const f32x4*)(W + (size_t)(k0 + 8 * i + (lane >> 3)) * ldw + n0 + 4 * (lane & 7));
#pragma unroll
      for (int i = 0; i < 8; ++i) { LAS float* d = scr + (8 * i + (lane >> 3)) * 33 + 4 * (lane & 7); d[0] = v[i][0]; d[1] = v[i][1]; d[2] = v[i][2]; d[3] = v[i][3]; } }
    LDS_WAIT(); asm volatile("" ::: "memory");
    const int c = lane & 7;
#pragma unroll
    for (int j = 0; j < 4; ++j) { const int n = (lane >> 3) + 8 * j; const LAS float* s = scr + (8 * c) * 33 + n;
        u32x4 o; o.x = cvt_pk_bf16(s[0 * 33], s[1 * 33]); o.y = cvt_pk_bf16(s[2 * 33], s[3 * 33]); o.z = cvt_pk_bf16(s[4 * 33], s[5 * 33]); o.w = cvt_pk_bf16(s[6 * 33], s[7 * 33]);
        *(u32x4*)(WT + (size_t)(row0 + n) * ldk + k0 + 8 * c) = o; }
    LDS_WAIT(); asm volatile("" ::: "memory");
}

__device__ __forceinline__ float log_sigmoid_(float z) { return z >= 0.f ? -log1pf(expf(-z)) : z - log1pf(expf(z)); }

__device__ __forceinline__ void p0_prologue(Frame& F) {
    LAS float* scr = (LAS float*)(F.lds + F.wave * 16384);
    const int gw = F.vcu * NWAVES + F.wave, NGW = F.G * NWAVES;
    constexpr int I_IN = 16 * 144, I_C = 8 * 32, I_O = 16 * 32;
    constexpr int NITEMS = I_IN + 2 * I_C + I_O;
    for (int it = gw; it < NITEMS; it += NGW) {
        int r = it;
        if (r < I_IN) { const int kb = r / 144, pb = r % 144; tr_item(F.w_in, INCOLS, 64 * kb, col1(32 * pb), F.W1T, 1024, 32 * pb, scr, F.lane); continue; } r -= I_IN;
        if (r < I_C) { tr_item(F.w_conv_out, 1024, 64 * (r / 32), 32 * (r % 32), F.WCT, 512, 32 * (r % 32), scr, F.lane); continue; } r -= I_C;
        if (r < I_C) { tr_item(F.w_attn_out, 1024, 64 * (r / 32), 32 * (r % 32), F.WAT, 512, 32 * (r % 32), scr, F.lane); continue; } r -= I_C;
        { tr_item(F.w_out, 1024, 64 * (r / 32), 32 * (r % 32), F.WOT, 1024, 32 * (r % 32), scr, F.lane); }
    }
    const int gt = F.vcu * (NWAVES * 64) + F.tid, NGT = F.G * NWAVES * 64;
    for (int p = gt; p < N1; p += NGT) F.BIAS1[p] = F.b_in[col1(p)];
    for (int i = gt; i < 1024 * 80; i += NGT) { const int c = i >> 10, k = i & 1023; float w = 0.f;
        if (c < 8) w = F.w_group[k * 8 + c]; else if (c < 72) w = F.w_router[k * 64 + (c - 8)];
        w *= F.norm2_g[k];
        const unsigned hi = cvt_pk_bf16(w, 0.f) & 0xffffu; const float rem = w - __uint_as_float(hi << 16);
        F.WRH[i] = (bf16_t)hi; F.WRL[i] = (bf16_t)(cvt_pk_bf16(rem, 0.f) & 0xffffu); }
    const u32x4 z4 = (u32x4){0u, 0u, 0u, 0u};
    for (int i = gt; i < NB * 16 * 64; i += NGT) { const int b = i / (16 * 64), r = (i / 64) % 16, c = i % 64; *(u32x4*)(F.ABUF + ((size_t)(b * AROWS + r)) * 512 + 8 * c) = z4; }
    for (int i = gt; i < NB * 48 * 64; i += NGT) { const int b = i / (48 * 64), r = (i / 64) % 48, c = i % 64;
        *(u32x4*)(F.KX + ((size_t)(b * KROWS + r)) * 512 + 8 * c) = z4; *(u32x4*)(F.VX + ((size_t)(b * KROWS + r)) * 512 + 8 * c) = z4; }
    __syncthreads();
    { LAS f32x4* wl = (LAS f32x4*)F.lds;
      for (int r = F.tid; r < 1024; r += NWAVES * 64) { const float* wp = F.w_in + (size_t)r * INCOLS + FCOL; wl[2 * r] = *(const f32x4*)wp; wl[2 * r + 1] = *(const f32x4*)(wp + 4); } }
    __syncthreads();
    if (gw < NR + NMETA) {
        f32x4 wf[4][4][2];
#pragma unroll
        for (int j = 0; j < 4; ++j)
#pragma unroll
            for (int jj = 0; jj < 4; ++jj) { const LAS f32x4* wp = (const LAS f32x4*)F.lds + 2 * (4 * F.lane + 256 * j + jj); wf[j][jj][0] = wp[0]; wf[j][jj][1] = wp[1]; }
        f32x4 g1[4];
#pragma unroll
        for (int j = 0; j < 4; ++j) g1[j] = *(const f32x4*)(F.norm1_g + 4 * F.lane + 256 * j);
        for (int m0 = gw; m0 < NR + NMETA; m0 += 2 * NGW) {
            f32x4 v[2][4]; float s[2], d[2][8]; bool ok[2];
#pragma unroll
            for (int u = 0; u < 2; ++u) { const int m = m0 + u * NGW; ok[u] = m < NR + NMETA; const int mm = ok[u] ? m : m0;
                const float* xrow = mm < NR ? F.x + (size_t)mm * DM : F.meta + (size_t)(mm - NR) * DM;
#pragma unroll
                for (int j = 0; j < 4; ++j) v[u][j] = *(const f32x4*)(xrow + 4 * F.lane + 256 * j); }
#pragma unroll
            for (int u = 0; u < 2; ++u) { s[u] = 0.f;
#pragma unroll
                for (int h = 0; h < 8; ++h) d[u][h] = 0.f;
#pragma unroll
                for (int j = 0; j < 4; ++j) { s[u] += (v[u][j].x * v[u][j].x + v[u][j].y * v[u][j].y) + (v[u][j].z * v[u][j].z + v[u][j].w * v[u][j].w);
                    v[u][j] = v[u][j] * g1[j];
#pragma unroll
                    for (int jj = 0; jj < 4; ++jj) { const float xv = v[u][j][jj];
#pragma unroll
                        for (int h = 0; h < 4; ++h) { d[u][h] += xv * wf[j][jj][0][h]; d[u][4 + h] += xv * wf[j][jj][1][h]; } } } }
            float rs[2], g[2];
            const bool u32_ = (F.lane & 32) != 0, u16_ = (F.lane & 16) != 0, u8_ = (F.lane & 8) != 0;
#pragma unroll
            for (int u = 0; u < 2; ++u) { rs[u] = 1.0f / sqrtf(wave_sum(s[u]) * (1.f / DM) + RMS_EPS);
                float e[4], f[2];
#pragma unroll
                for (int i = 0; i < 4; ++i) { const float snd = u32_ ? d[u][i] : d[u][4 + i], kp = u32_ ? d[u][4 + i] : d[u][i]; e[i] = kp + __shfl_xor(snd, 32); }
#pragma unroll
                for (int i = 0; i < 2; ++i) { const float snd = u16_ ? e[i] : e[2 + i], kp = u16_ ? e[2 + i] : e[i]; f[i] = kp + __shfl_xor(snd, 16); }
                float gg = (u8_ ? f[1] : f[0]) + __shfl_xor(u8_ ? f[0] : f[1], 8);
                gg += __shfl_xor(gg, 4); gg += __shfl_xor(gg, 2); gg += __shfl_xor(gg, 1); g[u] = gg; }
#pragma unroll
            for (int u = 0; u < 2; ++u) if (ok[u]) { const int m = m0 + u * NGW;
                bf16_t* orow = F.XN + (size_t)m * DM;
#pragma unroll
                for (int j = 0; j < 4; ++j) { const f32x4 y = v[u][j] * rs[u]; u32x2 o; o.x = cvt_pk_bf16(y.x, y.y); o.y = cvt_pk_bf16(y.z, y.w); *(u32x2*)(orow + 4 * F.lane + 256 * j) = o; }
                if ((F.lane & 7) == 0) { const int h = F.lane >> 3;
                    const float z = g[u] * rs[u] + F.b_in[FCOL + h] + F.b_forget[h];
                    F.LOGF[(size_t)m * 8 + h] = log_sigmoid_(z); } }
        }
    }
}

__device__ __forceinline__ void scan_bh(Frame& F, int bh) {
    const int b = bh >> 3, h = bh & 7, lane = F.lane;
    float loc[33]; float tot = 0.f;
#pragma unroll
    for (int i = 0; i < 33; ++i) { const int p = 33 * lane + i; float v = 0.f;
        if (p < NMETA) v = F.LOGF[(size_t)(NR + p) * 8 + h]; else if (p < SEQ + NMETA) v = F.LOGF[((size_t)b * SEQ + (p - NMETA)) * 8 + h];
        tot += v; loc[i] = tot; }
    float inc = tot;
#pragma unroll
    for (int o = 1; o < 64; o <<= 1) { const float n = __shfl_up(inc, o); if (lane >= o) inc += n; }
    const float excl = inc - tot;
    float* cb = F.CB + (size_t)bh * KROWS;
#pragma unroll
    for (int i = 0; i < 33; ++i) { const int p = 33 * lane + i; if (p < SEQ + NMETA) cb[48 + p] = -(excl + loc[i]) * LOG2E; }
    if (lane < 48) cb[lane] = NEGBIG;
}

struct StaticOrder {
    int nM, nN, nwg, G, c;
    __device__ __forceinline__ void init(int nM_, int nN_, int G_, int c_) { nM = nM_; nN = nN_; nwg = nM * nN; G = G_; c = c_; }
    __device__ __forceinline__ bool tile(int i, int& pm, int& pn) const {
        const long L = (long)i * G + c; if (L >= nwg) return false;
        int wgid = (int)L; { const int q = nwg / 8, r = nwg % 8, xcd = wgid % 8, off = wgid / 8; wgid = (xcd < r ? xcd * (q + 1) : r * (q + 1) + (xcd - r) * q) + off; }
        const int nig = 8 * nN, gid = wgid / nig, fm = gid * 8, gsz = (nM - fm) < 8 ? (nM - fm) : 8;
        pm = fm + ((wgid % nig) % gsz); pn = (wgid % nig) / gsz; return true;
    }
};
struct SchedPlain {
    StaticOrder so; const char* A; const char* B; int K;
    __device__ __forceinline__ bool next(int i, pg8::Unit& u) const { u.e = 0; return so.tile(i, u.pm, u.pn); }
    __device__ __forceinline__ const char* a_base(const pg8::Unit& u) const { return A + (size_t)u.pm * 256 * K * 2; }
    __device__ __forceinline__ const char* b_base(const pg8::Unit& u) const { return B + (size_t)u.pn * 256 * K * 2; }
    __device__ __forceinline__ void a_offs(const pg8::Unit&, const int (&)[2], const int (&)[2], unsigned (&)[2][2]) const {}
};
struct SchedDual {
    StaticOrder so; const char *A0, *B0, *A1, *B1; int K;
    __device__ __forceinline__ bool next(int i, pg8::Unit& u) const { u.e = i & 1; return so.tile(i >> 1, u.pm, u.pn); }
    __device__ __forceinline__ const char* a_base(const pg8::Unit& u) const { return (u.e ? A1 : A0) + (size_t)u.pm * 256 * K * 2; }
    __device__ __forceinline__ const char* b_base(const pg8::Unit& u) const { return (u.e ? B1 : B0) + (size_t)u.pn * 256 * K * 2; }
    __device__ __forceinline__ void a_offs(const pg8::Unit&, const int (&)[2], const int (&)[2], unsigned (&)[2][2]) const {}
};
struct SchedMoe {
    int first, last, stride, c, sh; const LAS int* tab; const LAS int* cnt; const char* A; const char* B; const int* TOK; int K, brows; bool gather;
    __device__ __forceinline__ bool next(int i, pg8::Unit& u) const { const int idx = first + i * stride + c; if (idx >= last) return false; u.pm = idx >> sh; u.pn = idx & ((1 << sh) - 1); u.e = tab[u.pm]; return true; }
    __device__ __forceinline__ int rows(const pg8::Unit& u) const { return cnt[u.e & 255] - 256 * (u.e >> 8); }
    __device__ __forceinline__ const char* a_base(const pg8::Unit& u) const { return gather ? A : A + (size_t)u.pm * 256 * K * 2; }
    __device__ __forceinline__ const char* b_base(const pg8::Unit& u) const { return B + ((size_t)(u.e & 255) * brows + (size_t)u.pn * 256) * K * 2; }
    __device__ __forceinline__ void a_offs(const pg8::Unit& u, const int (&R)[2], const int (&C)[2], unsigned (&ao)[2][2]) const {
        if (gather) {
            const int e = u.e & 255, rt = u.e >> 8, n = cnt[e];
#pragma unroll
            for (int h = 0; h < 2; ++h)
#pragma unroll
                for (int i = 0; i < 2; ++i) { const int pos = rt * 256 + 128 * h + R[i]; const int tok = TOK[(size_t)e * MOE_CAP + (pos < n ? pos : 0)] >> 1; ao[h][i] = (unsigned)(tok * K + C[i]) * 2u; }
            asm volatile("s_waitcnt vmcnt(0)" : "+v"(ao[0][0]), "+v"(ao[0][1]), "+v"(ao[1][0]), "+v"(ao[1][1]) :: "memory");
        }
    }
};

__device__ __forceinline__ u32x4 pack8(const f32x4& a, const f32x4& b) { u32x4 w; w.x = cvt_pk_bf16(a[0], a[1]); w.y = cvt_pk_bf16(a[2], a[3]); w.z = cvt_pk_bf16(b[0], b[1]); w.w = cvt_pk_bf16(b[2], b[3]); return w; }
__device__ __forceinline__ void unpack8(const u32x4& w, f32x4& a, f32x4& b) { a = (f32x4){bf_lo(w.x), bf_hi(w.x), bf_lo(w.y), bf_hi(w.y)}; b = (f32x4){bf_lo(w.z), bf_hi(w.z), bf_lo(w.w), bf_hi(w.w)}; }

struct Epi1 {
    static constexpr bool PERM = true;
    const float *bias1, *gq, *gk; bf16_t *ABUF, *Q, *KX, *VX, *SG;
    __device__ __forceinline__ bool operator()(f32x4 (&acc)[2][2][4][2], const pg8::Unit& u, int wr, int wc, int fr, int fq) {
        asm volatile("" : "+v"(fr), "+v"(fq));
        const int pn = u.pn; const bool meta = (u.pm == 64); const int cpos = 32 * wc + 8 * fq;
        if (meta && (pn == 4 || pn == 5 || pn >= 10)) return false;
        const float* bp = bias1 + pn * 256 + cpos;
        const f32x4 b00 = *(const f32x4*)(bp), b01 = *(const f32x4*)(bp + 4), b10 = *(const f32x4*)(bp + 128), b11 = *(const f32x4*)(bp + 132);
        const int row_w = u.pm * 256 + 64 * wr + fr;
        if (pn < 4) {
            const int col = 128 * pn + cpos;
#pragma unroll
            for (int ai = 0; ai < 2; ++ai)
#pragma unroll
                for (int m = 0; m < 4; ++m) {
                    const f32x4 x00 = acc[ai][0][m][0] + b00, x01 = acc[ai][0][m][1] + b01, x10 = acc[ai][1][m][0] + b10, x11 = acc[ai][1][m][1] + b11;
                    f32x4 o0, o1;
#pragma unroll
                    for (int j = 0; j < 4; ++j) { o0[j] = x00[j] * sigmoidf_(x10[j]); o1[j] = x01[j] * sigmoidf_(x11[j]); }
                    const u32x4 w = pack8(o0, o1);
                    const int Rg = row_w + 128 * ai + 16 * m;
                    if (!meta) { const int b = Rg >> 11, t = Rg & 2047; *(u32x4*)(ABUF + ((size_t)(b * AROWS + 32 + t)) * 512 + col) = w; }
                    else if (ai == 0 && m == 0 && wr == 0) { for (int bb = 0; bb < NB; ++bb) *(u32x4*)(ABUF + ((size_t)(bb * AROWS + 16 + fr)) * 512 + col) = w; }
                }
        } else if (pn < 8) {
            const bool isq = pn < 6; const float* g = isq ? gq : gk; const float sc = isq ? C2 : 1.0f;
            const f32x4 g00 = *(const f32x4*)(g + 8 * fq) * sc, g01 = *(const f32x4*)(g + 8 * fq + 4) * sc, g10 = *(const f32x4*)(g + 32 + 8 * fq) * sc, g11 = *(const f32x4*)(g + 36 + 8 * fq) * sc;
            const int col = 64 * (4 * (pn & 1) + wc) + 8 * fq;
#pragma unroll
            for (int ai = 0; ai < 2; ++ai)
#pragma unroll
                for (int m = 0; m < 4; ++m) {
                    const f32x4 x00 = acc[ai][0][m][0] + b00, x01 = acc[ai][0][m][1] + b01, x10 = acc[ai][1][m][0] + b10, x11 = acc[ai][1][m][1] + b11;
                    const f32x4 sq = x00 * x00 + x01 * x01 + x10 * x10 + x11 * x11;
                    float ss = (sq[0] + sq[1]) + (sq[2] + sq[3]);
                    ss += __shfl_xor(ss, 16); ss += __shfl_xor(ss, 32);
                    const float rs = 1.0f / sqrtf(ss * (1.f / 64.f) + RMS_EPS);
                    const u32x4 w0 = pack8(x00 * rs * g00, x01 * rs * g01), w1 = pack8(x10 * rs * g10, x11 * rs * g11);
                    const int Rg = row_w + 128 * ai + 16 * m; const int b = Rg >> 11, t = Rg & 2047;
                    if (isq) { bf16_t* o = Q + (size_t)Rg * 512 + col; *(u32x4*)o = w0; *(u32x4*)(o + 32) = w1; }
                    else if (!meta) { bf16_t* o = KX + ((size_t)(b * KROWS + 64 + t)) * 512 + col; *(u32x4*)o = w0; *(u32x4*)(o + 32) = w1; }
                    else if (ai == 0 && m == 0 && wr == 0) { for (int bb = 0; bb < NB; ++bb) { bf16_t* o = KX + ((size_t)(bb * KROWS + 48 + fr)) * 512 + col; *(u32x4*)o = w0; *(u32x4*)(o + 32) = w1; } }
                }
        } else if (pn < 10) {
            const int col = 256 * (pn - 8) + cpos;
#pragma unroll
            for (int ai = 0; ai < 2; ++ai)
#pragma unroll
                for (int m = 0; m < 4; ++m) {
                    const u32x4 w0 = pack8(acc[ai][0][m][0] + b00, acc[ai][0][m][1] + b01), w1 = pack8(acc[ai][1][m][0] + b10, acc[ai][1][m][1] + b11);
                    const int Rg = row_w + 128 * ai + 16 * m; const int b = Rg >> 11, t = Rg & 2047;
                    if (!meta) { bf16_t* o = VX + ((size_t)(b * KROWS + 64 + t)) * 512 + col; *(u32x4*)o = w0; *(u32x4*)(o + 128) = w1; }
                    else if (ai == 0 && m == 0 && wr == 0) { for (int bb = 0; bb < NB; ++bb) { bf16_t* o = VX + ((size_t)(bb * KROWS + 48 + fr)) * 512 + col; *(u32x4*)o = w0; *(u32x4*)(o + 128) = w1; } }
                }
        } else {
            const int col = 256 * (pn - 10) + cpos;
#pragma unroll
            for (int ai = 0; ai < 2; ++ai)
#pragma unroll
                for (int m = 0; m < 4; ++m) {
                    const f32x4 x00 = acc[ai][0][m][0] + b00, x01 = acc[ai][0][m][1] + b01, x10 = acc[ai][1][m][0] + b10, x11 = acc[ai][1][m][1] + b11;
                    f32x4 o00, o01, o10, o11;
#pragma unroll
                    for (int j = 0; j < 4; ++j) { o00[j] = sigmoidf_(x00[j]); o01[j] = sigmoidf_(x01[j]); o10[j] = sigmoidf_(x10[j]); o11[j] = sigmoidf_(x11[j]); }
                    bf16_t* o = SG + (size_t)(row_w + 128 * ai + 16 * m) * 2048 + col;
                    *(u32x4*)o = pack8(o00, o01); *(u32x4*)(o + 128) = pack8(o10, o11);
                }
        }
        return false;
    }
};

struct Epi3 {
    static constexpr bool PERM = true;
    const float* bc; const bf16_t* SG; bf16_t* MERGED;
    __device__ __forceinline__ bool operator()(f32x4 (&acc)[2][2][4][2], const pg8::Unit& u, int wr, int wc, int fr, int fq) {
        asm volatile("" : "+v"(fr), "+v"(fq));
        const int col0 = u.pn * 256 + 32 * wc + 8 * fq;
        const bf16_t* sgrow = SG + ((size_t)u.pm * 256 + 64 * wr + fr) * 2048 + col0;
        if (u.e == 0) {
            const f32x4 b00 = *(const f32x4*)(bc + col0), b01 = *(const f32x4*)(bc + col0 + 4), b10 = *(const f32x4*)(bc + col0 + 128), b11 = *(const f32x4*)(bc + col0 + 132);
#pragma unroll
            for (int ai = 0; ai < 2; ++ai)
#pragma unroll
                for (int m = 0; m < 4; ++m) {
                    const bf16_t* sp = sgrow + (size_t)(128 * ai + 16 * m) * 2048;
                    const u32x4 wc0 = *(const u32x4*)(sp), wc1 = *(const u32x4*)(sp + 128), wa0 = *(const u32x4*)(sp + 1024), wa1 = *(const u32x4*)(sp + 1152);
                    f32x4 c00, c01, c10, c11, a00, a01, a10, a11;
                    unpack8(wc0, c00, c01); unpack8(wc1, c10, c11); unpack8(wa0, a00, a01); unpack8(wa1, a10, a11);
#pragma unroll
                    for (int j = 0; j < 4; ++j) {
                        acc[ai][0][m][0][j] = (acc[ai][0][m][0][j] + b00[j]) * c00[j] * __builtin_amdgcn_rcpf(fmaxf(a00[j], 1e-20f));
                        acc[ai][0][m][1][j] = (acc[ai][0][m][1][j] + b01[j]) * c01[j] * __builtin_amdgcn_rcpf(fmaxf(a01[j], 1e-20f));
                        acc[ai][1][m][0][j] = (acc[ai][1][m][0][j] + b10[j]) * c10[j] * __builtin_amdgcn_rcpf(fmaxf(a10[j], 1e-20f));
                        acc[ai][1][m][1][j] = (acc[ai][1][m][1][j] + b11[j]) * c11[j] * __builtin_amdgcn_rcpf(fmaxf(a11[j], 1e-20f)); }
                }
            return true;
        }
        bf16_t* mrow = MERGED + ((size_t)u.pm * 256 + 64 * wr + fr) * 1024 + col0;
#pragma unroll
        for (int ai = 0; ai < 2; ++ai)
#pragma unroll
            for (int m = 0; m < 4; ++m) {
                const bf16_t* sp = sgrow + (size_t)(128 * ai + 16 * m) * 2048;
                const u32x4 wa0 = *(const u32x4*)(sp + 1024), wa1 = *(const u32x4*)(sp + 1152);
                f32x4 a00, a01, a10, a11; unpack8(wa0, a00, a01); unpack8(wa1, a10, a11);
                bf16_t* op = mrow + (size_t)(128 * ai + 16 * m) * 1024;
                *(u32x4*)op = pack8(acc[ai][0][m][0] * a00, acc[ai][0][m][1] * a01); *(u32x4*)(op + 128) = pack8(acc[ai][1][m][0] * a10, acc[ai][1][m][1] * a11);
            }
        return false;
    }
};

struct Epi4 {
    static constexpr bool PERM = false;
    const float* x; float* out;
    __device__ __forceinline__ bool operator()(f32x4 (&acc)[2][2][4][2], const pg8::Unit& u, int wr, int wc, int fr, int fq) {
        asm volatile("" : "+v"(fr), "+v"(fq));
        const size_t off0 = ((size_t)u.pm * 256 + 64 * wr + fr) * 1024 + u.pn * 256 + 32 * wc + 4 * fq;
#pragma unroll
        for (int ai = 0; ai < 2; ++ai) {
            f32x4 r[4][2][2];
#pragma unroll
            for (int m = 0; m < 4; ++m)
#pragma unroll
                for (int bj = 0; bj < 2; ++bj)
#pragma unroll
                    for (int n = 0; n < 2; ++n) r[m][bj][n] = *(const f32x4*)(x + off0 + (size_t)(128 * ai + 16 * m) * 1024 + 128 * bj + 16 * n);
#pragma unroll
            for (int m = 0; m < 4; ++m)
#pragma unroll
                for (int bj = 0; bj < 2; ++bj)
#pragma unroll
                    for (int n = 0; n < 2; ++n) *(f32x4*)(out + off0 + (size_t)(128 * ai + 16 * m) * 1024 + 128 * bj + 16 * n) = r[m][bj][n] + acc[ai][bj][m][n];
        }
        return false;
    }
};

struct Epi6 {
    static constexpr bool PERM = true;
    const LAS int* cnt; const int* TOK; const float* RS; bf16_t* HB;
    __device__ __forceinline__ bool operator()(f32x4 (&acc)[2][2][4][2], const pg8::Unit& u, int wr, int wc, int fr, int fq) {
        asm volatile("" : "+v"(fr), "+v"(fq));
        const int e = u.e & 255, rt = u.e >> 8, n = cnt[e];
        float rsv[2][4];
        { int tk[2][4];
#pragma unroll
          for (int ai = 0; ai < 2; ++ai)
#pragma unroll
              for (int m = 0; m < 4; ++m) { const int pos = rt * 256 + 128 * ai + 64 * wr + 16 * m + fr; tk[ai][m] = TOK[(size_t)e * MOE_CAP + (pos < n ? pos : 0)] >> 1; }
#pragma unroll
          for (int ai = 0; ai < 2; ++ai)
#pragma unroll
              for (int m = 0; m < 4; ++m) rsv[ai][m] = RS[tk[ai][m]]; }
#pragma unroll
        for (int ai = 0; ai < 2; ++ai)
#pragma unroll
            for (int m = 0; m < 4; ++m) {
                const int rl = 128 * ai + 64 * wr + 16 * m + fr;
                const float rs = rsv[ai][m];
                f32x4 o0, o1;
#pragma unroll
                for (int j = 0; j < 4; ++j) { const float g0 = acc[ai][0][m][0][j] * rs, g1 = acc[ai][0][m][1][j] * rs;
                    o0[j] = g0 * sigmoidf_(g0) * (acc[ai][1][m][0][j] * rs); o1[j] = g1 * sigmoidf_(g1) * (acc[ai][1][m][1][j] * rs); }
                *(u32x4*)(HB + ((size_t)u.pm * 256 + rl) * 256 + 128 * u.pn + 32 * wc + 8 * fq) = pack8(o0, o1);
            }
        return false;
    }
};

struct Epi7 {
    static constexpr bool PERM = true;
    const LAS int* cnt; const int* TOK; const float* WL; bf16_t* YB;
    __device__ __forceinline__ bool operator()(f32x4 (&acc)[2][2][4][2], const pg8::Unit& u, int wr, int wc, int fr, int fq) {
        asm volatile("" : "+v"(fr), "+v"(fq));
        const int e = u.e & 255, rt = u.e >> 8, n = cnt[e];
        const int col = u.pn * 256 + 32 * wc + 8 * fq;
#pragma unroll
        for (int ai = 0; ai < 2; ++ai) {
            int ent[4]; float wv[4];
#pragma unroll
            for (int m = 0; m < 4; ++m) { const int pos = rt * 256 + 128 * ai + 64 * wr + 16 * m + fr; const size_t li = (size_t)e * MOE_CAP + (pos < n ? pos : 0);
                ent[m] = TOK[li]; wv[m] = WL[li]; if (pos >= n) ent[m] = -1; }
#pragma unroll
            for (int m = 0; m < 4; ++m) if (ent[m] >= 0) {
                const float w = wv[m]; bf16_t* op = YB + (size_t)ent[m] * 1024 + col;
                *(u32x4*)op = pack8(acc[ai][0][m][0] * w, acc[ai][0][m][1] * w); *(u32x4*)(op + 128) = pack8(acc[ai][1][m][0] * w, acc[ai][1][m][1] * w); }
            asm volatile("" ::: "memory");
        }
        return false;
    }
};

__device__ __forceinline__ void conv_unit(Frame& F, int b, int chunk) {
    const int c = F.tid, t0 = chunk * 32;
    float w[CK];
#pragma unroll
    for (int j = 0; j < CK; ++j) w[j] = F.dw_w[j * CWID + c];
    float v[62];
    const bf16_t* base = F.ABUF + ((size_t)(b * AROWS + 32 + t0 - 30)) * 512 + c;
#pragma unroll
    for (int i = 0; i < 62; ++i) v[i] = bf2f(base[(size_t)i * 512]);
    float ov[32]; const float bias = F.dw_b[c];
#pragma unroll
    for (int i = 0; i < 32; ++i) { float s = bias;
#pragma unroll
        for (int j = 0; j < CK; ++j) s += w[j] * v[i + j];
        ov[i] = s; }
    LAS float* red = (LAS float*)F.lds; LAS float* st = red + 32 * 512;
    __syncthreads();
#pragma unroll
    for (int i = 0; i < 32; ++i) red[i * 512 + c] = ov[i];
    __syncthreads();
    { const int row = F.tid >> 4, seg = F.tid & 15; float s = 0.f;
#pragma unroll
      for (int qq = 0; qq < 32; ++qq) s += red[row * 512 + seg + 16 * qq];
      s += __shfl_xor(s, 1); s += __shfl_xor(s, 2); s += __shfl_xor(s, 4); s += __shfl_xor(s, 8);
      const float mean = s * (1.f / 512.f); float q2 = 0.f;
#pragma unroll
      for (int qq = 0; qq < 32; ++qq) { const float dlt = red[row * 512 + seg + 16 * qq] - mean; q2 += dlt * dlt; }
      q2 += __shfl_xor(q2, 1); q2 += __shfl_xor(q2, 2); q2 += __shfl_xor(q2, 4); q2 += __shfl_xor(q2, 8);
      if (seg == 0) { st[2 * row] = mean; st[2 * row + 1] = 1.0f / sqrtf(q2 * (1.f / 512.f) + LN_EPS); } }
    __syncthreads();
    const float g = F.ln_g[c], bb = F.ln_b[c];
    bf16_t* op = F.CACT + ((size_t)(b * SEQ + t0)) * 512 + c;
#pragma unroll
    for (int i = 0; i < 32; ++i) { const float y = (ov[i] - st[2 * i]) * st[2 * i + 1] * g + bb; const float z = y * sigmoidf_(y);
        op[(size_t)i * 512] = (bf16_t)(cvt_pk_bf16(z, 0.f) & 0xffffu); }
}

constexpr int CVT_GU = 64 * 16 * 16, CVT_D = 64 * 4 * 32, CVT_EARLY = 6400;
struct CvtItem { const float* W; int ldw, k0, n0; bf16_t* WT; int ldk, row0; const float* gk; };
__device__ __forceinline__ CvtItem cvt_decode(Frame& F, int r) {
    CvtItem it;
    if (r < CVT_GU) { const int e = r >> 8, r2 = r & 255, kb = r2 >> 4, pb = r2 & 15, p0 = 32 * pb, pn = p0 >> 8, bj = (p0 & 255) >> 7, y = p0 & 127;
        it.W = (bj ? F.w_up : F.w_gate) + (size_t)e * 1024 * 256; it.ldw = 256; it.k0 = 64 * kb; it.n0 = 128 * pn + y; it.WT = F.WGU + (size_t)e * 512 * 1024; it.ldk = 1024; it.row0 = p0; it.gk = F.norm2_g; }
    else { r -= CVT_GU; const int e = r >> 7, r2 = r & 127, kb = r2 >> 5, nb = r2 & 31;
        it.W = F.w_down + (size_t)e * 256 * 1024; it.ldw = 1024; it.k0 = 64 * kb; it.n0 = 32 * nb; it.WT = F.WD + (size_t)e * 1024 * 256; it.ldk = 256; it.row0 = 32 * nb; it.gk = nullptr; }
    return it;
}
__device__ __forceinline__ void cvt_load(const CvtItem& it, f32x4 (&v)[8], int lane) {
#pragma unroll
    for (int i = 0; i < 8; ++i) v[i] = *(const f32x4*)(it.W + (size_t)(it.k0 + 8 * i + (lane >> 3)) * it.ldw + it.n0 + 4 * (lane & 7));
}
__device__ __forceinline__ void cvt_store(const CvtItem& it, const f32x4 (&v)[8], LAS float* scr, int lane) {
    float gk[8];
#pragma unroll
    for (int i = 0; i < 8; ++i) gk[i] = it.gk ? it.gk[it.k0 + 8 * i + (lane >> 3)] : 1.0f;
#pragma unroll
    for (int i = 0; i < 8; ++i) { LAS float* d = scr + (8 * i + (lane >> 3)) * 33 + 4 * (lane & 7); d[0] = v[i][0] * gk[i]; d[1] = v[i][1] * gk[i]; d[2] = v[i][2] * gk[i]; d[3] = v[i][3] * gk[i]; }
    LDS_WAIT(); asm volatile("" ::: "memory");
    const int c = lane & 7;
#pragma unroll
    for (int j = 0; j < 4; ++j) { const int n = (lane >> 3) + 8 * j; const LAS float* s = scr + (8 * c) * 33 + n;
        u32x4 o; o.x = cvt_pk_bf16(s[0 * 33], s[1 * 33]); o.y = cvt_pk_bf16(s[2 * 33], s[3 * 33]); o.z = cvt_pk_bf16(s[4 * 33], s[5 * 33]); o.w = cvt_pk_bf16(s[6 * 33], s[7 * 33]);
        *(u32x4*)(it.WT + (size_t)(it.row0 + n) * it.ldk + it.k0 + 8 * c) = o; }
    LDS_WAIT(); asm volatile("" ::: "memory");
}
__device__ __forceinline__ void convert_experts(Frame& F, int first, int last, int w, int nw) {
    LAS float* scr = (LAS float*)(F.lds + F.wave * 16384);
    int r = first + w;
    if (r >= last) return;
    CvtItem cur = cvt_decode(F, r); f32x4 va[8], vb[8];
    cvt_load(cur, va, F.lane);
    for (;;) {
        const int rn = r + nw; const bool more = rn < last;
        CvtItem nxt = cur; if (more) { nxt = cvt_decode(F, rn); cvt_load(nxt, vb, F.lane); }
        cvt_store(cur, va, scr, F.lane);
        if (!more) break;
        const int rn2 = rn + nw; const bool more2 = rn2 < last;
        CvtItem nx2 = nxt; if (more2) { nx2 = cvt_decode(F, rn2); cvt_load(nx2, va, F.lane); }
        cvt_store(nxt, vb, scr, F.lane);
        if (!more2) break;
        cur = nx2; r = rn2;
    }
}

constexpr int RT_NRT = 2, RT_WAVES = 2;
__device__ __forceinline__ void p5_router(Frame& F) {
    const int lane = F.lane, row = lane & 15, q = lane >> 4;
    LAS float* Lw = (LAS float*)(F.lds + F.wave * 16384);
    unsigned* cnt = F.ctl + CW_CNT;
    constexpr int NTASK = NR / (16 * RT_NRT);
    if (F.wave < RT_WAVES) for (int task = F.wave * F.G + F.vcu; task < NTASK; task += RT_WAVES * F.G) {
        const int row0 = task * 16 * RT_NRT;
        const float* __restrict__ hp = F.out + (size_t)(row0 + row) * DM + 8 * q;
        bf16_t* __restrict__ hn = F.HN + (size_t)(row0 + row) * DM + 8 * q;
        const bf16_t* __restrict__ bh = F.WRH + (size_t)row * 1024 + 8 * q; const bf16_t* __restrict__ bl = F.WRL + (size_t)row * 1024 + 8 * q;
        f32x4 acc[RT_NRT][5];
#pragma unroll
        for (int rt = 0; rt < RT_NRT; ++rt)
#pragma unroll
            for (int tl = 0; tl < 5; ++tl) acc[rt][tl] = (f32x4){0.f, 0.f, 0.f, 0.f};
        float ss[RT_NRT];
#pragma unroll
        for (int rt = 0; rt < RT_NRT; ++rt) ss[rt] = 0.f;
        constexpr int HD_ = 2;
        f32x4 hq0[HD_][RT_NRT], hq1[HD_][RT_NRT]; bf16x8 Bc[10];
#pragma unroll
        for (int d = 0; d < HD_; ++d)
#pragma unroll
            for (int rt = 0; rt < RT_NRT; ++rt) { hq0[d][rt] = *(const f32x4*)(hp + (size_t)rt * 16 * DM + 32 * d); hq1[d][rt] = *(const f32x4*)(hp + (size_t)rt * 16 * DM + 32 * d + 4); }
#pragma unroll
        for (int tl = 0; tl < 5; ++tl) { Bc[2 * tl] = *(const bf16x8*)(bh + (size_t)tl * 16 * 1024); Bc[2 * tl + 1] = *(const bf16x8*)(bl + (size_t)tl * 16 * 1024); }
        constexpr int NS_ = 32;
        for (int s2 = 0; s2 < NS_; s2 += HD_) {
#pragma unroll
            for (int d = 0; d < HD_; ++d) {
                const int s = s2 + d, sn = s + 1 < NS_ ? s + 1 : s;
                bf16x8 Bn[10];
#pragma unroll
                for (int tl = 0; tl < 5; ++tl) { Bn[2 * tl] = *(const bf16x8*)(bh + (size_t)tl * 16 * 1024 + 32 * sn); Bn[2 * tl + 1] = *(const bf16x8*)(bl + (size_t)tl * 16 * 1024 + 32 * sn); }
                f32x4 h0[RT_NRT], h1[RT_NRT];
#pragma unroll
                for (int rt = 0; rt < RT_NRT; ++rt) { h0[rt] = hq0[d][rt]; h1[rt] = hq1[d][rt]; }
                if (s2 + HD_ < NS_) {
#pragma unroll
                    for (int rt = 0; rt < RT_NRT; ++rt) { hq0[d][rt] = *(const f32x4*)(hp + (size_t)rt * 16 * DM + 32 * (s + HD_)); hq1[d][rt] = *(const f32x4*)(hp + (size_t)rt * 16 * DM + 32 * (s + HD_) + 4); } }
#pragma unroll
                for (int rt = 0; rt < RT_NRT; ++rt) {
                    const f32x4 sq = h0[rt] * h0[rt] + h1[rt] * h1[rt]; ss[rt] += (sq[0] + sq[1]) + (sq[2] + sq[3]);
                    const u32x4 ahi = pack8(h0[rt], h1[rt]); f32x4 r0, r1; unpack8(ahi, r0, r1);
                    *(u32x4*)(hn + (size_t)rt * 16 * DM + 32 * s) = ahi;
                    const u32x4 alo = pack8(h0[rt] - r0, h1[rt] - r1);
                    const bf16x8 Ahi = __builtin_bit_cast(bf16x8, ahi), Alo = __builtin_bit_cast(bf16x8, alo);
#pragma unroll
                    for (int tl = 0; tl < 5; ++tl) {
                        acc[rt][tl] = __builtin_amdgcn_mfma_f32_16x16x32_bf16(Ahi, Bc[2 * tl], acc[rt][tl], 0, 0, 0);
                        acc[rt][tl] = __builtin_amdgcn_mfma_f32_16x16x32_bf16(Ahi, Bc[2 * tl + 1], acc[rt][tl], 0, 0, 0);
                        acc[rt][tl] = __builtin_amdgcn_mfma_f32_16x16x32_bf16(Alo, Bc[2 * tl], acc[rt][tl], 0, 0, 0); }
                }
#pragma unroll
                for (int i = 0; i < 10; ++i) Bc[i] = Bn[i];
            }
        }
        float rsv[RT_NRT];
#pragma unroll
        for (int rt = 0; rt < RT_NRT; ++rt) { float s_ = ss[rt]; s_ += __shfl_xor(s_, 16); s_ += __shfl_xor(s_, 32); rsv[rt] = 1.0f / sqrtf(s_ * (1.f / DM) + RMS_EPS);
#pragma unroll
            for (int tl = 0; tl < 5; ++tl)
#pragma unroll
                for (int r = 0; r < 4; ++r) Lw[(rt * 16 + 4 * q + r) * 80 + 16 * tl + row] = acc[rt][tl][r]; }
        LDS_WAIT(); asm volatile("" ::: "memory");
        if (lane < 16 * RT_NRT) {
            const float rs = (lane >> 4) == 0 ? rsv[0] : rsv[RT_NRT - 1];
            float lg[72];
#pragma unroll
            for (int c = 0; c < 72; ++c) lg[c] = Lw[lane * 80 + c] * rs + (c < 8 ? F.b_group[c] : F.b_router[c - 8]);
            int gi = 0; float gm = lg[0];
#pragma unroll
            for (int c = 1; c < 8; ++c) if (lg[c] > gm) { gm = lg[c]; gi = c; }
            float gs = 0.f;
#pragma unroll
            for (int c = 0; c < 8; ++c) gs += expf(lg[c] - gm);
            const float gwt = 1.0f / gs;
            float el[8];
#pragma unroll
            for (int i = 0; i < 8; ++i) el[i] = lg[8 + i];
#pragma unroll
            for (int g = 1; g < 8; ++g) if (gi == g) {
#pragma unroll
                for (int i = 0; i < 8; ++i) el[i] = lg[8 + 8 * g + i]; }
            int i1 = 0; float l1 = el[0];
#pragma unroll
            for (int i = 1; i < 8; ++i) if (el[i] > l1) { l1 = el[i]; i1 = i; }
            int i2 = -1; float l2 = -3e38f;
#pragma unroll
            for (int i = 0; i < 8; ++i) if (i != i1 && el[i] > l2) { l2 = el[i]; i2 = i; }
            const float ex = expf(l2 - l1), w1 = gwt / (1.0f + ex), w2 = gwt * ex / (1.0f + ex);
            const int e1 = gi * 8 + i1, e2 = gi * 8 + i2, tok = row0 + lane;
            {
            const unsigned p1 = atomicAdd(cnt + 64 * e1, 1u), p2 = atomicAdd(cnt + 64 * e2, 1u);
            F.TOK[(size_t)e1 * MOE_CAP + p1] = 2 * tok; F.WL[(size_t)e1 * MOE_CAP + p1] = w1;
            F.TOK[(size_t)e2 * MOE_CAP + p2] = 2 * tok + 1; F.WL[(size_t)e2 * MOE_CAP + p2] = w2;
            F.RS[tok] = rs; }
        }
        LDS_WAIT(); asm volatile("" ::: "memory");
    }
}

__device__ __forceinline__ int moe_table(Frame& F) {
    LAS int* cntl = (LAS int*)(F.lds + TAB_OFF); LAS int* tab = cntl + 64; LAS int* ntl = tab + MAXT;
    __syncthreads();
    if (F.tid < 64) cntl[F.tid] = (int)__hip_atomic_load(F.ctl + CW_CNT + 64 * F.tid, RLX_AGENT);
    __syncthreads();
    if (F.tid == 0) { int t = 0; for (int e = 0; e < NE; ++e) { const int nt = (cntl[e] + 255) >> 8; for (int r = 0; r < nt && t < MAXT; ++r) tab[t++] = e | (r << 8); } ntl[0] = t; }
    __syncthreads();
    return ntl[0];
}

__device__ __forceinline__ void p8_combine(Frame& F) {
    const int gw = F.vcu * NWAVES + F.wave, NGW = F.G * NWAVES;
    for (int t0 = gw; t0 < NR; t0 += 2 * NGW) {
        f32x4 h[2][4]; u32x2 a[2][4], b[2][4];
#pragma unroll
        for (int u = 0; u < 2; ++u) { const int t = (t0 + u * NGW < NR) ? t0 + u * NGW : t0;
            const float* op = F.out + (size_t)t * DM + 4 * F.lane; const bf16_t* y0 = F.YB + (size_t)(2 * t) * DM + 4 * F.lane;
#pragma unroll
            for (int j = 0; j < 4; ++j) { h[u][j] = *(const f32x4*)(op + 256 * j); a[u][j] = *(const u32x2*)(y0 + 256 * j); b[u][j] = *(const u32x2*)(y0 + DM + 256 * j); } }
#pragma unroll
        for (int u = 0; u < 2; ++u) if (t0 + u * NGW < NR) { float* op = F.out + (size_t)(t0 + u * NGW) * DM + 4 * F.lane;
#pragma unroll
            for (int j = 0; j < 4; ++j) { f32x4 o = h[u][j];
                o[0] += bf_lo(a[u][j].x) + bf_lo(b[u][j].x); o[1] += bf_hi(a[u][j].x) + bf_hi(b[u][j].x); o[2] += bf_lo(a[u][j].y) + bf_lo(b[u][j].y); o[3] += bf_hi(a[u][j].y) + bf_hi(b[u][j].y);
                *(f32x4*)(op + 256 * j) = o; } }
    }
}

struct Args { const float* in[24]; float* out; unsigned char* ws; int ph_lo, ph_hi; };
static_assert(sizeof(Args) == 24 * 8 + 8 + 8 + 8, "Args has no padding");

__global__ void __launch_bounds__(NWAVES * 64, 2) fwd_kernel(Args args) {
    extern __shared__ __attribute__((aligned(16))) unsigned char lds[];
    Frame F;
    F.lds = (LAS unsigned char*)lds;
    F.MISC = (volatile LAS unsigned*)(F.lds + MISC_OFF);
    F.tid = threadIdx.x; F.lane = F.tid & 63; F.wave = __builtin_amdgcn_readfirstlane(F.tid >> 6);
    F.G = gridDim.x; { const int bx = blockIdx.x; F.vcu = (F.G % 8 == 0) ? (bx % 8) * (F.G / 8) + bx / 8 : bx; }
    unsigned char* ws = args.ws;
    F.ctl = (unsigned*)(ws + WS_CTL);
    F.x = args.in[0]; F.meta = args.in[1]; F.norm1_g = args.in[2]; F.w_in = args.in[3]; F.b_in = args.in[4]; F.dw_w = args.in[5]; F.dw_b = args.in[6];
    F.ln_g = args.in[7]; F.ln_b = args.in[8]; F.w_conv_out = args.in[9]; F.b_conv_out = args.in[10]; F.q_norm_g = args.in[11]; F.k_norm_g = args.in[12];
    F.b_forget = args.in[13]; F.w_attn_out = args.in[14]; F.w_out = args.in[15]; F.norm2_g = args.in[16]; F.w_group = args.in[17]; F.b_group = args.in[18];
    F.w_router = args.in[19]; F.b_router = args.in[20]; F.w_gate = args.in[21]; F.w_up = args.in[22]; F.w_down = args.in[23];
    F.out = args.out;
    F.BIAS1 = (float*)(ws + WS_BIAS1); F.WRH = (bf16_t*)(ws + WS_WR); F.WRL = (bf16_t*)(ws + WS_WR + 160 * 1024); F.RS = (float*)(ws + WS_RS); F.CB = (float*)(ws + WS_CB); F.LOGF = (float*)(ws + WS_LOGF);
    F.WL = (float*)(ws + WS_WL); F.TOK = (int*)(ws + WS_TOK);
    F.W1T = (bf16_t*)(ws + WS_W1T); F.WCT = (bf16_t*)(ws + WS_WCT); F.WAT = (bf16_t*)(ws + WS_WAT); F.WOT = (bf16_t*)(ws + WS_WOT); F.WGU = (bf16_t*)(ws + WS_WGU); F.WD = (bf16_t*)(ws + WS_WD);
    F.XN = (bf16_t*)(ws + WS_XN); F.MERGED = (bf16_t*)(ws + WS_XN); F.ABUF = (bf16_t*)(ws + WS_ABUF); F.CACT = (bf16_t*)(ws + WS_CACT); F.HN = (bf16_t*)(ws + WS_O);
    F.QO = (bf16_t*)(ws + WS_QO); F.KX = (bf16_t*)(ws + WS_KX); F.VX = (bf16_t*)(ws + WS_VX); F.HB = (bf16_t*)(ws + WS_QO); F.SG = (bf16_t*)args.out; F.YB = (bf16_t*)(ws + WS_XN); F.OB = (bf16_t*)(ws + WS_O);
    for (int u = F.tid; u < (LDS_BYTES - LDSCTL_OFF) / 4; u += NWAVES * 64) ((LAS unsigned*)(F.lds + LDSCTL_OFF))[u] = 0u;
    __syncthreads();
    XcdBarrier bar; bar.bar = F.ctl + CW_BAR; bar.x = 0; bar.st = nullptr;
    if (MK_N_LAUNCHES == 1) bar = xcd_barrier_post(F.ctl + CW_BAR, F.MISC + 8);
#define GRID_BAR() do { if (MK_N_LAUNCHES == 1) xcd_barrier(bar); } while (0)
    const int lo = args.ph_lo, hi = args.ph_hi;
#ifndef P1_ALIGN
#define P1_ALIGN true
#endif
#ifndef PHASE_MASK
#define PHASE_MASK 0x1ff
#endif
#define IN(k) (((PHASE_MASK >> (k)) & 1) && lo <= (k) && (k) < hi)
#define BOTH(k) (IN(k) && IN((k) + 1))
    if (IN(0)) { p0_prologue(F); if (BOTH(0)) GRID_BAR();
    }

    if (IN(1)) {
        if (F.wave == 0) for (int bh = F.G - 1 - (int)blockIdx.x; bh < 64; bh += F.G) scan_bh(F, bh);
        SchedPlain S; S.so.init(NRX / 256, N1 / 256, F.G, (int)blockIdx.x); S.A = (const char*)F.XN; S.B = (const char*)F.W1T; S.K = 1024;
        Epi1 E{F.BIAS1, F.q_norm_g, F.k_norm_g, F.ABUF, F.QO, F.KX, F.VX, F.SG};
        pg8::gemm_phase<Epi1, SchedPlain, P1_ALIGN>(F.lds, 1024, S, E);
#ifndef CVT_EARLY_N
#define CVT_EARLY_N 8000
#endif
        { const int nfull = (NRX / 256) * (N1 / 256) - 4 * F.G;
          if (F.G == 256 && (int)blockIdx.x >= nfull) convert_experts(F, 0, CVT_EARLY_N, ((int)blockIdx.x - nfull) * NWAVES + F.wave, (F.G - nfull) * NWAVES); }
        if (BOTH(1)) GRID_BAR();
    }

    if (IN(2)) {
        for (int v = F.vcu; v < 256; v += F.G) { const int bh = v >> 2, s = v & 3;
            attn_body::attn_unit<8>(bh >> 3, bh & 7, s, (const attn_body::bf16*)F.QO, (const attn_body::bf16*)F.KX, (const attn_body::bf16*)F.VX, (attn_body::bf16*)F.OB, F.CB, (char*)lds);
            attn_body::attn_unit<8>(bh >> 3, bh & 7, 7 - s, (const attn_body::bf16*)F.QO, (const attn_body::bf16*)F.KX, (const attn_body::bf16*)F.VX, (attn_body::bf16*)F.OB, F.CB, (char*)lds); }
        __syncthreads();
        for (int u = (int)blockIdx.x; u < NB * 64; u += F.G) conv_unit(F, u >> 6, u & 63);
        __syncthreads();
        if (BOTH(2)) GRID_BAR();
    }

    if (IN(3)) {
        SchedDual S; S.so.init(NR / 256, 4, F.G, (int)blockIdx.x); S.A0 = (const char*)F.CACT; S.B0 = (const char*)F.WCT; S.A1 = (const char*)F.OB; S.B1 = (const char*)F.WAT; S.K = 512;
        Epi3 E{F.b_conv_out, F.SG, F.MERGED};
        pg8::gemm_phase<Epi3, SchedDual, true>(F.lds, 512, S, E);
        if (BOTH(3)) GRID_BAR();
    }

    if (IN(4)) {
        SchedPlain S; S.so.init(NR / 256, 4, F.G, (int)blockIdx.x); S.A = (const char*)F.MERGED; S.B = (const char*)F.WOT; S.K = 1024;
        Epi4 E{F.x, F.out};
        pg8::gemm_phase<Epi4, SchedPlain, true>(F.lds, 1024, S, E);
        if (BOTH(4)) GRID_BAR();
    }

    if (IN(5)) {
        if (F.wave >= RT_WAVES) convert_experts(F, F.G == 256 ? CVT_EARLY_N : 0, CVT_GU + CVT_D, F.vcu * (NWAVES - RT_WAVES) + (F.wave - RT_WAVES), F.G * (NWAVES - RT_WAVES)); else p5_router(F);
        if (BOTH(5)) GRID_BAR(); }

    if (IN(6)) {
        const int nt = moe_table(F);
        const LAS int* cntl = (const LAS int*)(F.lds + TAB_OFF);
        const int U6 = 2 * nt, G = F.G, c = F.vcu;
        const bool overlap = U6 > G && U6 <= 2 * G && (G & 1) == 0;
        int K7 = 256; asm volatile("" : "+s"(K7));
        Epi6 E6{cntl, F.TOK, F.RS, F.HB}; Epi7 E7{cntl, F.TOK, F.WL, F.YB};
        { SchedMoe S{0, overlap ? G : U6, G, c, 1, cntl + 64, cntl, (const char*)F.HN, (const char*)F.WGU, F.TOK, 1024, 512, true};
          pg8::gemm_phase<Epi6, SchedMoe, true, true>(F.lds, 1024, S, E6);
        }
        GRID_BAR();
        if (overlap) {
            if (c < U6 - G) { SchedMoe S{G, U6, G, c, 1, cntl + 64, cntl, (const char*)F.HN, (const char*)F.WGU, F.TOK, 1024, 512, true};
                pg8::gemm_phase<Epi6, SchedMoe, true, true>(F.lds, 1024, S, E6); }
            else { SchedMoe S{0, 2 * G, 2 * G - U6, c - (U6 - G), 2, cntl + 64, cntl, (const char*)F.HB, (const char*)F.WD, F.TOK, K7, 1024, false};
                pg8::gemm_phase<Epi7, SchedMoe, true>(F.lds, K7, S, E7); }
            GRID_BAR();
        }
        { SchedMoe S{overlap ? 2 * G : 0, 4 * nt, G, c, 2, cntl + 64, cntl, (const char*)F.HB, (const char*)F.WD, F.TOK, K7, 1024, false};
          pg8::gemm_phase<Epi7, SchedMoe, true>(F.lds, K7, S, E7);
        }
        GRID_BAR();
    }
    if (IN(8)) {
        p8_combine(F); }
#undef IN
#undef BOTH
}


extern "C" void kernel_launch(void* const* d_in, const int* in_sizes, int n_in, void* d_out, int out_size, void* d_ws, size_t ws_size, hipStream_t stream) {
    static int grid = 0;
    if (grid == 0) {
        if (n_in != 24 || in_sizes[0] != NR * DM || out_size != NR * DM || ws_size < WS_END) {
            fprintf(stderr, "kernel_launch: unexpected shapes (n_in %d, in0 %d, out %d, ws %zu); nothing launched\n", n_in, n_in > 0 ? in_sizes[0] : -1, out_size, ws_size); grid = -1; return; }
        int dev = 0, cus = 0, per_cu = 0;
        if (hipGetDevice(&dev) != hipSuccess || hipDeviceGetAttribute(&cus, hipDeviceAttributeMultiprocessorCount, dev) != hipSuccess) { grid = -1; return; }
        if (hipFuncSetAttribute((const void*)fwd_kernel, hipFuncAttributeMaxDynamicSharedMemorySize, LDS_BYTES) != hipSuccess) { fprintf(stderr, "kernel_launch: hipFuncSetAttribute failed\n"); grid = -1; return; }
        if (hipOccupancyMaxActiveBlocksPerMultiprocessor(&per_cu, (const void*)fwd_kernel, NWAVES * 64, LDS_BYTES) != hipSuccess || per_cu < 1) { fprintf(stderr, "kernel_launch: occupancy query reports %d blocks per CU\n", per_cu); (void)hipGetLastError(); grid = -1; return; }
        grid = cus;
    }
    if (grid < 0) return;
    if (hipMemsetAsync((char*)d_ws + WS_CTL, 0, CTL_ZERO_BYTES, stream) != hipSuccess) return;
    Args a{};
    for (int i = 0; i < 24; ++i) a.in[i] = (const float*)d_in[i];
    a.out = (float*)d_out; a.ws = (unsigned char*)d_ws;
    if (MK_N_LAUNCHES == 1) { a.ph_lo = 0; a.ph_hi = N_PHASES; hipLaunchKernelGGL(fwd_kernel, dim3(grid), dim3(NWAVES * 64), LDS_BYTES, stream, a); }
    else for (int p = 0; p < N_PHASES; ++p) { a.ph_lo = p; a.ph_hi = p + 1; hipLaunchKernelGGL(fwd_kernel, dim3(grid), dim3(NWAVES * 64), LDS_BYTES, stream, a); }
}
```

```cpp
#include <hip/hip_runtime.h>
#include <hip/hip_bf16.h>
#include <cstdio>
#include <cstdint>
#include <cmath>

#define GAS __attribute__((address_space(1)))
#define LAS __attribute__((address_space(3)))
typedef unsigned short bf16_t;
typedef short bf16x8 __attribute__((ext_vector_type(8)));
typedef float f32x4 __attribute__((ext_vector_type(4)));
typedef float f32x2 __attribute__((ext_vector_type(2)));
typedef unsigned u32x4 __attribute__((ext_vector_type(4)));
typedef unsigned u32x2 __attribute__((ext_vector_type(2)));

__device__ __forceinline__ unsigned cvt_pk_bf16(float lo, float hi) { unsigned r; asm volatile("v_cvt_pk_bf16_f32 %0, %1, %2" : "=v"(r) : "v"(lo), "v"(hi)); return r; }
__device__ __forceinline__ float bf_lo(unsigned w) { return __uint_as_float(w << 16); }
__device__ __forceinline__ float bf_hi(unsigned w) { return __uint_as_float(w & 0xffff0000u); }
__device__ __forceinline__ float bf2f(bf16_t b) { return __uint_as_float((unsigned)b << 16); }
__device__ __forceinline__ float sigmoidf_(float x) { return __builtin_amdgcn_rcpf(1.0f + __builtin_amdgcn_exp2f(-1.4426950408889634f * x)); }

namespace pg8 {
constexpr int BM = 256, BK = 64, HALF = 128, HTB = HALF * BK * 2  , STAGE_BYTES = 8 * HTB;

__host__ __device__ __forceinline__ int lds_byte(int r, int c) { const int st = (r >> 4) * 2 + (c >> 5), rr = r & 15, cc = c & 31, ob = rr * 64 + cc * 2; return st * 1024 + (ob ^ (((ob >> 9) & 1) << 5)); }
__host__ __device__ __forceinline__ void stage_rc(int b, int& R, int& C) { const int st = b / 1024, sb = b % 1024, swz = sb ^ (((sb >> 9) & 1) << 5); R = (st >> 1) * 16 + swz / 64; C = (st & 1) * 32 + (swz % 64) / 2; }
__host__ __device__ __forceinline__ int perm32(int rho) { const int n = rho >> 4, i = rho & 15; return 8 * (i >> 2) + 4 * n + (i & 3); }

struct Unit { int pm, pn, e; };

template <class Epi, class Sched, bool ALIGN_EPI, bool GATHER = false, bool PARTIAL = false>
__device__ __forceinline__ void gemm_phase(LAS unsigned char* lds, const int K, const Sched& S, Epi& E) {
    int tid = threadIdx.x; asm volatile("" : "+v"(tid));
    const int wid = __builtin_amdgcn_readfirstlane(tid >> 6), lane = tid & 63, wr = wid >> 2, wc = wid & 3, fr = lane & 15, fq = lane >> 4;
    const int nt = K / BK;
    int Rr[2], Cc[2]; unsigned voffB[2], voffA[2];
#pragma unroll
    for (int i = 0; i < 2; ++i) { stage_rc(tid * 16 + i * 8192, Rr[i], Cc[i]); const int Rb = Epi::PERM ? ((Rr[i] & ~31) + perm32(Rr[i] & 31)) : Rr[i]; voffB[i] = (unsigned)(Rb * K + Cc[i]) * 2u; voffA[i] = (unsigned)(Rr[i] * K + Cc[i]) * 2u; }
    const size_t kstep = (size_t)(BK * 2);
    const size_t hstep = (size_t)HALF * K * 2;
    const unsigned ldsw = (unsigned)wid * 1024u;
    const int aoff = lds_byte(wr * 64 + fr, fq * 8), boff = lds_byte(wc * 32 + fr, fq * 8);
#define PG8_SA(b, h) (((b) * 2 + (h)) * HTB)
#define PG8_SB(b, h) ((4 + (b) * 2 + (h)) * HTB)
#define PG8_STAGE(bufoff, gbase, voff) do { _Pragma("unroll") for (int _i = 0; _i < 2; ++_i) \
        __builtin_amdgcn_global_load_lds((const unsigned*)((const char*)(gbase) + (voff)[_i]), (LAS unsigned*)(lds + (bufoff) + ldsw + _i * 8192), 16, 0, 0); } while (0)
#define PG8_STAGE_A(bufoff, gbase, h, OFFS) do { _Pragma("unroll") for (int _i = 0; _i < 2; ++_i) { \
        const char* _src; if constexpr (GATHER) _src = (const char*)(gbase) + (OFFS)[h][_i]; else _src = (const char*)(gbase) + (size_t)(h) * hstep + voffA[_i]; \
        __builtin_amdgcn_global_load_lds((const unsigned*)_src, (LAS unsigned*)(lds + (bufoff) + ldsw + _i * 8192), 16, 0, 0); } } while (0)
#define PG8_LDA(dst, b, h) do { _Pragma("unroll") for (int m = 0; m < 4; ++m) _Pragma("unroll") for (int k = 0; k < 2; ++k) dst[m][k] = *(const LAS bf16x8*)(lds + PG8_SA(b, h) + aoff + m * 2048 + k * 1024); } while (0)
#define PG8_LDB(dst, b, h) do { _Pragma("unroll") for (int n = 0; n < 2; ++n) _Pragma("unroll") for (int k = 0; k < 2; ++k) dst[n][k] = *(const LAS bf16x8*)(lds + PG8_SB(b, h) + boff + n * 2048 + k * 1024); } while (0)
#define PG8_MMA(ai, bj, At, Bt) do { __builtin_amdgcn_s_setprio(1); _Pragma("unroll") for (int m = 0; m < 4; ++m) _Pragma("unroll") for (int n = 0; n < 2; ++n) _Pragma("unroll") for (int k = 0; k < 2; ++k) \
        acc[ai][bj][m][n] = __builtin_amdgcn_mfma_f32_16x16x32_bf16(Bt[n][k], At[m][k], acc[ai][bj][m][n], 0, 0, 0); __builtin_amdgcn_s_setprio(0); } while (0)
#define PG8_WAIT_V(n) asm volatile("s_waitcnt vmcnt(" #n ")" ::: "memory")
#define PG8_WAIT_L(n) asm volatile("s_waitcnt lgkmcnt(" #n ")" ::: "memory")
#define PG8_BAR __builtin_amdgcn_s_barrier()
#define PG8_SCHED __builtin_amdgcn_sched_barrier(0)
    Unit cur, nxt; int ui = 0;
    if (!S.next(0, cur)) return;
    f32x4 acc[2][2][4][2];
#pragma unroll
    for (int a = 0; a < 2; ++a)
#pragma unroll
        for (int b = 0; b < 2; ++b)
#pragma unroll
            for (int m = 0; m < 4; ++m)
#pragma unroll
                for (int n = 0; n < 2; ++n) acc[a][b][m][n] = (f32x4){0.f, 0.f, 0.f, 0.f};
    bf16x8 At[4][2], B0[2][2], B1[2][2];
    unsigned ao[2][2], nao[2][2];
    if constexpr (GATHER) S.a_offs(cur, Rr, Cc, ao);
    const char* cA = S.a_base(cur); const char* cB = S.b_base(cur);
    PG8_STAGE(PG8_SB(0, 0), cB, voffB); PG8_STAGE(PG8_SB(0, 1), cB + hstep, voffB); PG8_STAGE_A(PG8_SA(0, 0), cA, 0, ao); PG8_STAGE_A(PG8_SA(0, 1), cA, 1, ao);
    if (wr == 1) PG8_BAR;
    PG8_WAIT_V(2); PG8_BAR;
    PG8_STAGE(PG8_SB(1, 0), cB + kstep, voffB); PG8_STAGE_A(PG8_SA(1, 0), cA + kstep, 0, ao); PG8_STAGE(PG8_SB(1, 1), cB + hstep + kstep, voffB);
    PG8_WAIT_V(6); PG8_BAR;
    for (;;) {
        const bool has_next = S.next(ui + 1, nxt);
        const char* nA = cA; const char* nB = cB;
        if (has_next) { if constexpr (GATHER) S.a_offs(nxt, Rr, Cc, nao); nA = S.a_base(nxt); nB = S.b_base(nxt); }
        else if constexpr (GATHER) {
#pragma unroll
            for (int h = 0; h < 2; ++h)
#pragma unroll
                for (int i = 0; i < 2; ++i) nao[h][i] = ao[h][i];
        }
        for (int t = 0; t < nt; t += 2) {
            const bool last = (t == nt - 2);
            const char* a1 = cA + (size_t)(t + 1) * kstep;
            const char* a2 = last ? nA : cA + (size_t)(t + 2) * kstep; const char* b2 = last ? nB : cB + (size_t)(t + 2) * kstep;
            const char* a3 = a2 + kstep; const char* b3 = b2 + kstep;
            unsigned xo[2][2];
            if constexpr (GATHER) {
#pragma unroll
                for (int h = 0; h < 2; ++h)
#pragma unroll
                    for (int i = 0; i < 2; ++i) xo[h][i] = last ? nao[h][i] : ao[h][i];
            }
            PG8_LDB(B0, 0, 0); PG8_LDB(B1, 0, 1); PG8_SCHED; PG8_LDA(At, 0, 0); PG8_STAGE_A(PG8_SA(1, 1), a1, 1, ao);
            PG8_WAIT_V(8); PG8_WAIT_L(0); PG8_BAR; PG8_MMA(0, 0, At, B0); PG8_MMA(0, 1, At, B1); PG8_BAR; PG8_SCHED;
            PG8_LDA(At, 0, 1); PG8_STAGE(PG8_SB(0, 0), b2, voffB); PG8_STAGE(PG8_SB(0, 1), b2 + hstep, voffB); PG8_STAGE_A(PG8_SA(0, 0), a2, 0, xo);
            PG8_WAIT_V(8); PG8_WAIT_L(0); PG8_BAR; PG8_MMA(1, 0, At, B0); PG8_MMA(1, 1, At, B1); PG8_BAR; PG8_SCHED;
            PG8_LDB(B0, 1, 0); PG8_LDB(B1, 1, 1); PG8_SCHED; PG8_LDA(At, 1, 0); PG8_STAGE_A(PG8_SA(0, 1), a2, 1, xo);
            PG8_WAIT_V(8); PG8_WAIT_L(0); PG8_BAR; PG8_MMA(0, 0, At, B0); PG8_MMA(0, 1, At, B1); PG8_BAR; PG8_SCHED;
            PG8_LDA(At, 1, 1); PG8_STAGE(PG8_SB(1, 0), b3, voffB); PG8_STAGE(PG8_SB(1, 1), b3 + hstep, voffB); PG8_STAGE_A(PG8_SA(1, 0), a3, 0, xo);
            PG8_WAIT_V(8); PG8_WAIT_L(0); PG8_BAR; PG8_MMA(1, 0, At, B0); PG8_MMA(1, 1, At, B1); PG8_BAR; PG8_SCHED;
        }
        if constexpr (ALIGN_EPI) { if (wr == 0) PG8_BAR; }
        const bool keep = E(acc, cur, wr, wc, fr, fq);
        if (!has_next) break;
        if (!keep) {
#pragma unroll
            for (int a = 0; a < 2; ++a)
#pragma unroll
                for (int b = 0; b < 2; ++b)
#pragma unroll
                    for (int m = 0; m < 4; ++m)
#pragma unroll
                        for (int n = 0; n < 2; ++n) acc[a][b][m][n] = (f32x4){0.f, 0.f, 0.f, 0.f};
        }
        cur = nxt; cA = nA; cB = nB; ++ui;
        if constexpr (GATHER) {
#pragma unroll
            for (int h = 0; h < 2; ++h)
#pragma unroll
                for (int i = 0; i < 2; ++i) ao[h][i] = nao[h][i];
        }
        if constexpr (ALIGN_EPI) { if (wr == 1) PG8_BAR; }
    }
    PG8_WAIT_V(0);
    if constexpr (!ALIGN_EPI) { if (wr == 0) PG8_BAR; }
    PG8_BAR;
#undef PG8_SA
#undef PG8_SB
#undef PG8_STAGE
#undef PG8_STAGE_A
#undef PG8_LDA
#undef PG8_LDB
#undef PG8_MMA
#undef PG8_WAIT_V
#undef PG8_WAIT_L
#undef PG8_BAR
#undef PG8_SCHED
}
}
namespace attn_body {
using bf16=__hip_bfloat16;
using bf16x8=__attribute__((ext_vector_type(8)))short;
using s16x4=__attribute__((ext_vector_type(4)))short;
using f32x16=__attribute__((ext_vector_type(16)))float;
using u32x4=__attribute__((ext_vector_type(4)))unsigned;
constexpr int BATCH=8,NHEAD=8,SEQ=2048,KVROWS=2112,D=64,DM=NHEAD*D;
constexpr int NW=8,QBLK=32,QB=QBLK*NW,KVBLK=64,NQB=SEQ/QB;
constexpr int ATTN_PITCH=DM, ATTN_UNIT_ROWS=QB;
__device__ __forceinline__ int crow(int r,int hi){return (r&3)+8*(r>>2)+4*hi;}
#define SBAR() __builtin_amdgcn_sched_barrier(0)
__device__ __forceinline__ void cmask(f32x16&p0,f32x16&p1,int jb,int qrel,int hi){
  asm volatile("":"+v"(hi),"+v"(qrel));
  const float NEG=-INFINITY; int kb=64*jb+4*hi;
  #pragma unroll
  for(int r=0;r<16;++r){int kv=kb+(r&3)+8*(r>>2); if(kv>qrel)p0[r]=NEG; if(kv+32>qrel)p1[r]=NEG;}
}

constexpr int NSLOT=3, SLOTB=8192;
constexpr int LDS_K=0, LDS_V=NSLOT*SLOTB, LDS_WS=2*NSLOT*SLOTB, LDS_OST=LDS_WS+NW*64*4, LDS_CBT=LDS_OST+NW*4096, LDS_BYTES=LDS_CBT+KVROWS*4;
constexpr float C2=0.125f*1.4426950408889634f;
__device__ __forceinline__ void glds16(const void*gsrc,unsigned lds_dst){unsigned keep;
  asm volatile("s_mov_b32 %0, m0\n\ts_mov_b32 m0, %2\n\ts_nop 0\n\tglobal_load_lds_dwordx4 %1, off\n\ts_mov_b32 m0, %0":"=&s"(keep):"v"(gsrc),"s"(lds_dst):"memory");}
__device__ __forceinline__ float max3f(float a,float b,float c){float r;asm("v_max3_f32 %0, %1, %2, %3":"=v"(r):"v"(a),"v"(b),"v"(c));return r;}
__device__ __forceinline__ float max2f(float a,float b){float r;asm("v_max_f32_e32 %0, %1, %2":"=v"(r):"v"(a),"v"(b));return r;}
__device__ __forceinline__ float fadd_s(float a,float b){float r;asm("v_add_f32_e32 %0, %1, %2":"=v"(r):"v"(a),"v"(b));return r;}
__device__ __forceinline__ float fsub_s(float a,float b){float r;asm("v_sub_f32_e32 %0, %1, %2":"=v"(r):"v"(a),"v"(b));return r;}
typedef float f32x2_t __attribute__((ext_vector_type(2))); typedef float f32x4_t __attribute__((ext_vector_type(4))); typedef __bf16 bf16x2_t __attribute__((ext_vector_type(2)));
__device__ __forceinline__ unsigned cvtpk_s(float lo,float hi){f32x2_t v={lo,hi};bf16x2_t b=__builtin_convertvector(v,bf16x2_t);return __builtin_bit_cast(unsigned,b);}
#define WAIT_BAR(N) asm volatile("s_waitcnt vmcnt(" #N ") lgkmcnt(0)\n\ts_barrier":::"memory")

__device__ __forceinline__ void qkt(f32x16&p0,f32x16&p1,const char*Kslot,const bf16x8*qr,const f32x16&negm,int r32,int hi){
  const char*kb=Kslot+hi*1024+r32*16;
  #pragma unroll
  for(int d0=0;d0<4;++d0){
    const bf16x8 b0=*reinterpret_cast<const bf16x8*>(kb+d0*2048);
    const bf16x8 b1=*reinterpret_cast<const bf16x8*>(kb+d0*2048+512);
    if(d0==0){p0=__builtin_amdgcn_mfma_f32_32x32x16_bf16(b0,qr[0],negm,0,0,0);p1=__builtin_amdgcn_mfma_f32_32x32x16_bf16(b1,qr[0],negm,0,0,0);}
    else{p0=__builtin_amdgcn_mfma_f32_32x32x16_bf16(b0,qr[d0],p0,0,0,0);p1=__builtin_amdgcn_mfma_f32_32x32x16_bf16(b1,qr[d0],p1,0,0,0);}}
}
typedef __attribute__((address_space(3))) const char* lds_cptr;
typedef short v4i16_t __attribute__((ext_vector_type(4)));
__device__ __forceinline__ void kload8(bf16x8*kf,lds_cptr kp){
  kf[0]=*(const __attribute__((address_space(3))) bf16x8*)(kp);      kf[1]=*(const __attribute__((address_space(3))) bf16x8*)(kp+512);
  kf[2]=*(const __attribute__((address_space(3))) bf16x8*)(kp+2048); kf[3]=*(const __attribute__((address_space(3))) bf16x8*)(kp+2560);
  kf[4]=*(const __attribute__((address_space(3))) bf16x8*)(kp+4096); kf[5]=*(const __attribute__((address_space(3))) bf16x8*)(kp+4608);
  kf[6]=*(const __attribute__((address_space(3))) bf16x8*)(kp+6144); kf[7]=*(const __attribute__((address_space(3))) bf16x8*)(kp+6656);
}
__device__ __forceinline__ void kload2(bf16x8*kf,lds_cptr kp,int j){ kf[2*j]=*(const __attribute__((address_space(3))) bf16x8*)(kp+j*2048); kf[2*j+1]=*(const __attribute__((address_space(3))) bf16x8*)(kp+j*2048+512); }
__device__ __forceinline__ s16x4 vtr(lds_cptr p){ return __builtin_bit_cast(s16x4,__builtin_amdgcn_ds_read_tr16_b64_v4i16((__attribute__((address_space(3))) v4i16_t*)p)); }
__device__ __forceinline__ float rowmax(const f32x16&p0,const f32x16&p1){
  float a=max3f(p0[0],p0[1],p1[0]),b=max3f(p0[2],p0[3],p1[1]);a=max3f(a,p1[2],p1[3]);
  #pragma unroll
  for(int r=4;r<16;r+=4){a=max3f(a,p0[r],p0[r+1]);b=max3f(b,p0[r+2],p0[r+3]);a=max3f(a,p1[r],p1[r+1]);b=max3f(b,p1[r+2],p1[r+3]);}
  const float m=max2f(a,b);
  auto rr=__builtin_amdgcn_permlane32_swap(__float_as_uint(m),__float_as_uint(m),false,false);
  return max2f(__uint_as_float(rr[0]),__uint_as_float(rr[1]));
}
__device__ __forceinline__ void pv(f32x16*o,int vb,bf16x8 pa0,bf16x8 pa1,bf16x8 pa2,bf16x8 pa3){
  #pragma unroll
  for(int d0=0;d0<2;++d0){s16x4 lo[4],hi[4];
    #pragma unroll
    for(int ks=0;ks<4;++ks){
      asm volatile("ds_read_b64_tr_b16 %0,%1 offset:%c2":"=&v"(lo[ks]):"v"(vb),"i"(d0*4096+ks*1024):"memory");
      asm volatile("ds_read_b64_tr_b16 %0,%1 offset:%c2":"=&v"(hi[ks]):"v"(vb),"i"(d0*4096+ks*1024+512):"memory");}
    asm volatile("s_waitcnt lgkmcnt(0)":::"memory");SBAR();
    #define PK(k) (bf16x8){lo[k][0],lo[k][1],lo[k][2],lo[k][3],hi[k][0],hi[k][1],hi[k][2],hi[k][3]}
    o[d0]=__builtin_amdgcn_mfma_f32_32x32x16_bf16(pa0,PK(0),o[d0],0,0,0);
    o[d0]=__builtin_amdgcn_mfma_f32_32x32x16_bf16(pa1,PK(1),o[d0],0,0,0);
    o[d0]=__builtin_amdgcn_mfma_f32_32x32x16_bf16(pa2,PK(2),o[d0],0,0,0);
    o[d0]=__builtin_amdgcn_mfma_f32_32x32x16_bf16(pa3,PK(3),o[d0],0,0,0);
    #undef PK
  }
}

#ifndef ATTN_STORE16
#define ATTN_STORE16(p,v) (*(u32x4*)(p)=(v))
#endif
template<int THRL> __device__ __forceinline__ void attn_unit(int b,int h,int qb,const bf16*Q,const bf16*__restrict__ K,const bf16*__restrict__ V,bf16*O,const float*__restrict__ CB,char*shm){
  const int tid=threadIdx.x,lane=tid&63,r32=lane&31,hi=lane>>5; const int wid=__builtin_amdgcn_readfirstlane(tid>>6);
  const long rowbase=(long)b*SEQ, kvbase=(long)b*KVROWS; const int q0=qb*QB;
  const bf16*Qw=Q+(rowbase+q0+wid*QBLK)*DM+h*D;
  const bf16*Kh=K+kvbase*DM+h*D,*Vh=V+kvbase*DM+h*D;
  const unsigned lds0=(unsigned)(uintptr_t)shm;
  float*wsf=(float*)(shm+LDS_WS)+wid*64;
  const bf16*ksrc=Kh+(long)lane*DM+wid*8;
  const bf16*vsrc=Vh+(long)(16*(wid&3)+(lane>>2))*DM+(wid>>2)*32+(lane&3)*8;
  const unsigned kdst=lds0+LDS_K+wid*1024, vdst=lds0+LDS_V+wid*1024;
  #define DMA_K(t,slot) glds16(ksrc+(long)(t)*KVBLK*DM,(unsigned)__builtin_amdgcn_readfirstlane(kdst+(slot)))
  #define DMA_V(t,slot) glds16(vsrc+(long)(t)*KVBLK*DM,(unsigned)__builtin_amdgcn_readfirstlane(vdst+(slot)))
  const int vb0=(int)(lds0+LDS_V)+((lane>>4)&1)*32+(lane&3)*8+(4*hi+((lane&15)>>2))*64;
  const char*Kbase=shm+LDS_K; bf16x8 kf[8];
  const lds_cptr shm3=(lds_cptr)shm; const lds_cptr kp0=shm3+LDS_K+hi*1024+r32*16; const lds_cptr vp0=shm3+LDS_V+((lane>>4)&1)*32+(lane&3)*8+(4*hi+((lane&15)>>2))*64;
  const int NT=(q0+QB)/KVBLK+1;
  typedef __attribute__((address_space(3))) float* lds_fptr; const lds_fptr cbt=(lds_fptr)(shm+LDS_CBT);
  { const float*cbg=CB+(long)(b*NHEAD+h)*KVROWS; const float ref=cbg[64+q0]; for(int i=tid;i<NT*KVBLK;i+=NW*64)cbt[i]=cbg[i]-ref; }
  DMA_K(0,0);DMA_V(0,0);DMA_K(1,SLOTB);
  bf16x8 qr[4];
  #pragma unroll
  for(int d0=0;d0<4;++d0)qr[d0]=*reinterpret_cast<const bf16x8*>(&Qw[(long)r32*DM+d0*16+hi*8]);
  float mhat=0.f,l_reg=0.f;f32x16 o[2];o[0]=f32x16{};o[1]=f32x16{};const f32x16 zero16=f32x16{}; f32x16 negm=f32x16{};
  const int qrel=wid*QBLK+r32;
  #define CMASK(P0,P1,t) do{int jb_=(t)-(NT-4); if(jb_>=0)cmask(P0,P1,jb_,qrel,hi);}while(0)
  typedef __attribute__((address_space(3))) const f32x4_t* lds_f4ptr;
  #define BIAS(P0,P1,t) do{ const lds_f4ptr bp_=(lds_f4ptr)(cbt+64*(t)+4*hi); \
    _Pragma("unroll") for(int g_=0;g_<4;++g_){ const f32x4_t b0_=bp_[2*g_], b1_=bp_[8+2*g_]; \
      _Pragma("unroll") for(int j_=0;j_<4;++j_){ P0[4*g_+j_]+=b0_[j_]; P1[4*g_+j_]+=b1_[j_]; } } }while(0)
  bool resc=false;
  #define START(P0,P1) do{ const float rm=rowmax(P0,P1); resc=false; \
    { const float dl=__builtin_fmaxf(rm,0.f); mhat=fadd_s(mhat,dl); _Pragma("unroll") for(int r=0;r<16;++r)negm[r]=-mhat; asm volatile("":"+v"(negm)); \
      _Pragma("unroll") for(int r=0;r<16;++r){P0[r]=fsub_s(P0[r],dl);P1[r]=fsub_s(P1[r],dl);} \
      } \
    _Pragma("unroll") for(int r=0;r<16;++r)P0[r]=__builtin_amdgcn_exp2f(P0[r]); }while(0)
  #define RESC() do{ if(resc){ asm volatile("s_waitcnt lgkmcnt(0)":::"memory"); \
      _Pragma("unroll") for(int d_=0;d_<2;++d_) _Pragma("unroll") for(int r=0;r<16;++r)o[d_][r]*=wsf[crow(r,hi)]; } }while(0)
  f32x16 pA0,pA1,pB0,pB1;
  int sl_prev=0,sl_cur=0,sl_next=SLOTB;
  #define ROT() do{sl_prev=sl_cur;sl_cur=sl_next;sl_next=(sl_next==(NSLOT-1)*SLOTB)?0:sl_next+SLOTB;}while(0)
  DMA_K(2,2*SLOTB);
  WAIT_BAR(3);
  mhat=cbt[64+q0+qrel]+14.0f; _Pragma("unroll") for(int r=0;r<16;++r)negm[r]=-mhat; asm volatile("":"+v"(negm));
  qkt(pA0,pA1,Kbase,qr,negm,r32,hi);asm volatile("s_nop 15\n\ts_nop 7":"+v"(pA0),"+v"(pA1));BIAS(pA0,pA1,0);CMASK(pA0,pA1,0);
  START(pA0,pA1);
  _Pragma("unroll") for(int r=0;r<16;++r)pA1[r]=__builtin_amdgcn_exp2f(pA1[r]);
  WAIT_BAR(0);
  DMA_K(3,0);DMA_V(1,SLOTB);
  ROT();
  kload8(kf,kp0+sl_cur);
  WAIT_BAR(2);
  s16x4 vlo[8],vhi[8]; u32x4 pw0,pw1,pw2,pw3;
  #define PKW(P,B) cvtpk_s(P[B],P[B+1])
  #define PAF(k) __builtin_bit_cast(bf16x8,pw##k)
  #define VFR(i) (bf16x8){vlo[i][0],vlo[i][1],vlo[i][2],vlo[i][3],vhi[i][0],vhi[i][1],vhi[i][2],vhi[i][3]}
  #define PIN(x) asm volatile("":"+v"(x))
  #define MX3(a,b,c) __builtin_fmaxf(__builtin_fmaxf((a),(b)),(c))
  #define GAPA(MF,A0,A1,A2,A3,W0,W1,PW) do{ MF; sacc+=A0; sacc+=A1; sacc+=A2; sacc+=A3; PIN(sacc); W0; W1; PIN(PW); SBAR(); }while(0)
  #define EX(v) __builtin_amdgcn_exp2f(v)
  #define GAPB(MF,X,B) do{ MF; X[B]=EX(X[B]); X[B+1]=EX(X[B+1]); X[B+2]=EX(X[B+2]); X[B+3]=EX(X[B+3]); PIN(X); SBAR(); }while(0)
  #define VRD(i) do{ vlo[i]=vtr(vp_+(((i)>>2)*4096+((i)&3)*1024)); vhi[i]=vtr(vp_+(((i)>>2)*4096+((i)&3)*1024+512)); }while(0)
  #define KRD(G,j) do{ if(G){ kload2(kf,kp0+sl_next,j); SBAR(); } }while(0)
  #define STEP(C0,C1,P0,P1,t,GK,GV,GL) do{ SBAR(); \
    const lds_cptr vp_=vp0+sl_prev; \
    VRD(0); SBAR(); float sacc=(P0[0]+P0[1]); \
    GAPA(C0=__builtin_amdgcn_mfma_f32_32x32x16_bf16(kf[0],qr[0],negm,0,0,0), P0[2],P0[3],P0[4],P0[5],     pw0[0]=PKW(P0,0), pw0[1]=PKW(P0,2), pw0); \
    VRD(4); SBAR(); GAPA(C1=__builtin_amdgcn_mfma_f32_32x32x16_bf16(kf[1],qr[0],negm,0,0,0), P0[6],P0[7],P0[8],P0[9],     pw0[2]=PKW(P0,4), pw0[3]=PKW(P0,6), pw0); \
    VRD(1); SBAR(); GAPA(C0=__builtin_amdgcn_mfma_f32_32x32x16_bf16(kf[2],qr[1],C0,0,0,0),   P0[10],P0[11],P0[12],P0[13], pw1[0]=PKW(P0,8), pw1[1]=PKW(P0,10), pw1); \
    VRD(5); SBAR(); GAPA(C1=__builtin_amdgcn_mfma_f32_32x32x16_bf16(kf[3],qr[1],C1,0,0,0),   P0[14],P0[15],P1[0],P1[1],   pw1[2]=PKW(P0,12),pw1[3]=PKW(P0,14), pw1); \
    VRD(2); SBAR(); GAPA(C0=__builtin_amdgcn_mfma_f32_32x32x16_bf16(kf[4],qr[2],C0,0,0,0),   P1[2],P1[3],P1[4],P1[5],     pw2[0]=PKW(P1,0), pw2[1]=PKW(P1,2), pw2); \
    VRD(6); SBAR(); GAPA(C1=__builtin_amdgcn_mfma_f32_32x32x16_bf16(kf[5],qr[2],C1,0,0,0),   P1[6],P1[7],P1[8],P1[9],     pw2[2]=PKW(P1,4), pw2[3]=PKW(P1,6), pw2); \
    VRD(3); SBAR(); GAPA(C0=__builtin_amdgcn_mfma_f32_32x32x16_bf16(kf[6],qr[3],C0,0,0,0),   P1[10],P1[11],P1[12],P1[13], pw3[0]=PKW(P1,8), pw3[1]=PKW(P1,10), pw3); \
    VRD(7); SBAR(); GAPA(C1=__builtin_amdgcn_mfma_f32_32x32x16_bf16(kf[7],qr[3],C1,0,0,0),   P1[14],P1[15],0.f,0.f,       pw3[2]=PKW(P1,12),pw3[3]=PKW(P1,14), pw3); \
    l_reg+=sacc; \
    if(GK){DMA_K((t)+3,sl_cur);} if(GV){DMA_V((t)+1,sl_next);} \
    BIAS(C0,C1,t); CMASK(C0,C1,t); \
    { float rm=__builtin_fmaxf(__builtin_fmaxf(C0[0],C0[15]),__builtin_fmaxf(C1[0],C1[15]));   \
      resc=false; \
      if(__builtin_expect(__any(rm>(float)THRL),0)){ const float dl=__builtin_fmaxf(rm,0.f); mhat+=dl; _Pragma("unroll") for(int r=0;r<16;++r)negm[r]=-mhat; asm volatile("":"+v"(negm)); \
        _Pragma("unroll") for(int r=0;r<16;++r){C0[r]-=dl;C1[r]-=dl;} \
        const float f=__builtin_amdgcn_exp2f(-dl); l_reg*=f; if(hi==0)wsf[r32]=f; resc=true; } } \
    SBAR(); \
    GAPB(o[0]=__builtin_amdgcn_mfma_f32_32x32x16_bf16(PAF(0),VFR(0),o[0],0,0,0), C0,0); \
    GAPB(o[1]=__builtin_amdgcn_mfma_f32_32x32x16_bf16(PAF(0),VFR(4),o[1],0,0,0), C0,4); \
    KRD(GL,0); GAPB(o[0]=__builtin_amdgcn_mfma_f32_32x32x16_bf16(PAF(1),VFR(1),o[0],0,0,0), C0,8); \
    KRD(GL,1); GAPB(o[1]=__builtin_amdgcn_mfma_f32_32x32x16_bf16(PAF(1),VFR(5),o[1],0,0,0), C0,12); \
    KRD(GL,2); GAPB(o[0]=__builtin_amdgcn_mfma_f32_32x32x16_bf16(PAF(2),VFR(2),o[0],0,0,0), C1,0); \
    KRD(GL,3); GAPB(o[1]=__builtin_amdgcn_mfma_f32_32x32x16_bf16(PAF(2),VFR(6),o[1],0,0,0), C1,4); \
    GAPB(o[0]=__builtin_amdgcn_mfma_f32_32x32x16_bf16(PAF(3),VFR(3),o[0],0,0,0), C1,8); \
    GAPB(o[1]=__builtin_amdgcn_mfma_f32_32x32x16_bf16(PAF(3),VFR(7),o[1],0,0,0), C1,12); \
    }while(0)
  int t=1;
  #undef CMASK
  #define CMASK(P0,P1,t) do{}while(0)
  for(;t+5<NT;t+=2){
    STEP(pB0,pB1,pA0,pA1,t,true,true,true);     WAIT_BAR(2); RESC(); ROT();
    STEP(pA0,pA1,pB0,pB1,t+1,true,true,true);   WAIT_BAR(2); RESC(); ROT();
  }
  #undef CMASK
  #define CMASK(P0,P1,t) do{int jb_=(t)-(NT-4); if(jb_>=0)cmask(P0,P1,jb_,qrel,hi);}while(0)
  #define ENDW(tt) do{ if((tt)+3<NT){WAIT_BAR(2);} else if((tt)+2<NT){WAIT_BAR(1);} else {WAIT_BAR(0);} }while(0)
  for(;t+2<NT;t+=2){
    STEP(pB0,pB1,pA0,pA1,t,(t+3<NT),(t+1<NT),(t+1<NT));       ENDW(t);   RESC(); ROT();
    STEP(pA0,pA1,pB0,pB1,t+1,(t+4<NT),(t+2<NT),(t+2<NT));     ENDW(t+1); RESC(); ROT();
  }
  STEP(pB0,pB1,pA0,pA1,NT-2,false,true,true); ENDW(NT-2); RESC(); ROT();
  STEP(pA0,pA1,pB0,pB1,NT-1,false,false,false); RESC();
  { float sacc=pA0[0]+pA0[1]; _Pragma("unroll") for(int r=2;r<16;++r)sacc+=pA0[r]; _Pragma("unroll") for(int r=0;r<16;++r)sacc+=pA1[r]; l_reg+=sacc;
    pw0=(u32x4){PKW(pA0,0),PKW(pA0,2),PKW(pA0,4),PKW(pA0,6)};pw1=(u32x4){PKW(pA0,8),PKW(pA0,10),PKW(pA0,12),PKW(pA0,14)};pw2=(u32x4){PKW(pA1,0),PKW(pA1,2),PKW(pA1,4),PKW(pA1,6)};pw3=(u32x4){PKW(pA1,8),PKW(pA1,10),PKW(pA1,12),PKW(pA1,14)};
    SBAR(); pv(o,vb0+sl_cur,PAF(0),PAF(1),PAF(2),PAF(3)); }
  #undef PKW
  #undef PAF
  #undef VFR
  #undef PIN
  #undef MX3
  #undef GAPA
  #undef GAPB
  #undef EX
  #undef VRD
  #undef KRD
  #undef STEP
  #undef ENDW
  {auto rr=__builtin_amdgcn_permlane32_swap(__float_as_uint(l_reg),__float_as_uint(l_reg),false,false);l_reg=__uint_as_float(rr[0])+__uint_as_float(rr[1]);}
  if(hi==0)wsf[32+r32]=l_reg;asm volatile("s_waitcnt lgkmcnt(0)":::"memory");
  float rli[16];
  #pragma unroll
  for(int r=0;r<16;++r)rli[r]=__builtin_amdgcn_rcpf(wsf[32+crow(r,hi)]);
  bf16*Ow=O+(rowbase+q0+wid*QBLK)*DM+h*D;
  { bf16*stg=(bf16*)(shm+LDS_OST)+wid*2048;
    #pragma unroll
    for(int r=0;r<16;++r){const int orow=crow(r,hi);
      #pragma unroll
      for(int d0=0;d0<2;++d0)stg[orow*64+d0*32+r32]=__float2bfloat16(o[d0][r]*rli[r]);}
    asm volatile("s_waitcnt lgkmcnt(0)":::"memory");
    #pragma unroll
    for(int i=0;i<4;++i){const int row=i*8+(lane>>3),ch=lane&7; const u32x4 v=*(const u32x4*)(stg+row*64+ch*8); ATTN_STORE16(Ow+(long)row*DM+ch*8,v);} }
  asm volatile("s_waitcnt lgkmcnt(0)\n\ts_barrier":::"memory");
  #undef DMA_K
  #undef DMA_V
  #undef CMASK
  #undef BIAS
  #undef START
  #undef RESC
  #undef ROT
}
constexpr int ATTN_LDS_BYTES=LDS_BYTES;
#undef SBAR
#undef WAIT_BAR
}

constexpr int NWAVES = 8;
#ifndef MK_N_LAUNCHES
#define MK_N_LAUNCHES 1
#endif
constexpr int N_PHASES = 9;
constexpr int DM = 1024, NB = 8, SEQ = 2048, NMETA = 16, NR = NB * SEQ, NRX = NR + 256;
constexpr int CWID = 512, CK = 31, NH = 8, HD = 64;
constexpr int INCOLS = 4616, N1 = 4608, FCOL = 2560, GCOL = 2568;
constexpr int NE = 64, DE = 256, MOE_CAP = NR, MAXT = 192;
constexpr int AROWS = 2080, KROWS = 2112;
constexpr float RMS_EPS = 1e-6f, LN_EPS = 1e-5f;
constexpr float LOG2E = 1.4426950408889634f;
constexpr float C2 = 0.125f * LOG2E;
constexpr float NEGBIG = -1e30f;

constexpr size_t MiB = 1u << 20;
constexpr size_t WS_CTL = 0, CTL_ZERO_BYTES = 1 * MiB;
constexpr size_t WS_BIAS1 = 1 * MiB, WS_WR = 1 * MiB + 32 * 1024, WS_RS = 1 * MiB + 512 * 1024;
constexpr size_t WS_W1T = 2 * MiB, WS_WCT = 11 * MiB, WS_WAT = 12 * MiB, WS_WOT = 13 * MiB, WS_WGU = 15 * MiB, WS_WD = 79 * MiB;
constexpr size_t WS_XN = 111 * MiB;
constexpr size_t WS_ABUF = 144 * MiB, WS_CACT = 161 * MiB;
constexpr size_t WS_QO = 177 * MiB, WS_KX = 193 * MiB, WS_VX = 210 * MiB;
constexpr size_t WS_CB = 227 * MiB, WS_LOGF = 228 * MiB, WS_TOK = 229 * MiB, WS_WL = 233 * MiB, WS_O = 237 * MiB, WS_END = 269 * MiB;
constexpr int CW_TMO = 0, CW_CODE = 1, CW_BAR = 4096, CW_CNT = 8192;

constexpr int RING_BYTES = 131072, LDSCTL_OFF = RING_BYTES, MISC_OFF = LDSCTL_OFF + 320, TAB_OFF = RING_BYTES + 1024;
constexpr int LDS_BYTES = 147456;

typedef GAS unsigned gu32;
#define RLX_AGENT __ATOMIC_RELAXED, __HIP_MEMORY_SCOPE_AGENT
#define LDS_WAIT() asm volatile("s_waitcnt lgkmcnt(0)" ::: "memory")
#define VM_WAIT() asm volatile("s_waitcnt vmcnt(0)" ::: "memory")
#define XB_TMO      128
#define XB_XCNT(j)  (256  + 64 * (j))
#define XB_XSUB(j)  (1280 + 64 * (j))
#define XB_XGEN(j)  (2304 + 64 * (j))
#define XB_TOP      3328
#define XB_TOPGEN   3392
#define XCD_BAR_WORDS 3456
#define XB_SPIN_CAP (1u << 18)

__device__ __forceinline__ unsigned xb_ld(unsigned* p)              { return __hip_atomic_load(p, __ATOMIC_RELAXED, __HIP_MEMORY_SCOPE_AGENT); }
__device__ __forceinline__ unsigned xb_add(unsigned* p, unsigned v) { return __hip_atomic_fetch_add(p, v, __ATOMIC_RELAXED, __HIP_MEMORY_SCOPE_AGENT); }
__device__ __forceinline__ unsigned xb_xcc_id() { return (unsigned)__builtin_amdgcn_s_getreg((3 << 11) | 20) & 0xFu; }
#define XB_SPIN(cond, bar) do { unsigned _sp = 0; while (cond) { __builtin_amdgcn_s_sleep(1); \
    if ((++_sp & 255u) == 0u) { if (xb_ld(&(bar)[XB_TMO])) break; if (_sp > XB_SPIN_CAP) { atomicAdd(&(bar)[XB_TMO], 1u); break; } } } } while (0)

struct XcdBarrier {
    unsigned* bar; unsigned x;
    volatile LAS unsigned* st;
};

__device__ __forceinline__ XcdBarrier xcd_barrier_post(unsigned* bar, volatile LAS unsigned* st) {
    XcdBarrier b; b.bar = bar; b.x = xb_xcc_id(); b.st = st;
    if (threadIdx.x == 0) (void)xb_add(&bar[XB_XCNT(b.x)], 1u);
    return b;
}
__device__ __forceinline__ void xcd_barrier_complete(unsigned* bar, unsigned x, unsigned& nloc, unsigned& nx) {
    const unsigned G = gridDim.x * gridDim.y * gridDim.z;
    unsigned sum, cnt, mine, sp = 0u;
    for (;;) {
        sum = 0u; cnt = 0u; mine = 0u;
#pragma unroll
        for (unsigned j = 0; j < 16; ++j) { const unsigned c = xb_ld(&bar[XB_XCNT(j)]); sum += c; cnt += (c > 0u) ? 1u : 0u; mine = (j == x) ? c : mine; }
        if (sum == G) break;
        __builtin_amdgcn_s_sleep(1);
        if ((++sp & 255u) == 0u) { if (xb_ld(&bar[XB_TMO])) break; if (sp > XB_SPIN_CAP) { atomicAdd(&bar[XB_TMO], 1u); break; } }
    }
    nloc = mine > 0u ? mine : 1u; nx = cnt > 0u ? cnt : 1u;
}

__device__ __forceinline__ void xcd_barrier(const XcdBarrier& b) {
    asm volatile("s_waitcnt vmcnt(0)" ::: "memory");
    __syncthreads();
    if (threadIdx.x == 0) {
        unsigned* bar = b.bar;
        __builtin_amdgcn_s_waitcnt(0);
        unsigned nloc = b.st[0], nx = b.st[1];
        if (nloc == 0u) { xcd_barrier_complete(bar, b.x, nloc, nx); b.st[0] = nloc; b.st[1] = nx; }
        const unsigned old = xb_add(&bar[XB_XSUB(b.x)], 1u);
        const unsigned gen = old / nloc;
        if (old + 1u == (gen + 1u) * nloc) {
            __builtin_amdgcn_fence(__ATOMIC_RELEASE, "agent");
            asm volatile("s_waitcnt vmcnt(0)" ::: "memory");
            const unsigned og = xb_add(&bar[XB_TOP], 1u);
            const unsigned tg = og / nx;
            if (og + 1u == (tg + 1u) * nx) xb_add(&bar[XB_TOPGEN], 1u);
            else XB_SPIN(xb_ld(&bar[XB_TOPGEN]) == tg, bar);
            __builtin_amdgcn_fence(__ATOMIC_ACQUIRE, "agent");
            xb_add(&bar[XB_XGEN(b.x)], 1u);
            asm volatile("s_waitcnt vmcnt(0)" ::: "memory");
        } else {
            XB_SPIN(xb_ld(&bar[XB_XGEN(b.x)]) == gen, bar);
            __builtin_amdgcn_fence(__ATOMIC_ACQUIRE, "agent");
            asm volatile("s_waitcnt vmcnt(0)" ::: "memory");
        }
    }
    __syncthreads();
}

struct Frame {
    LAS unsigned char* lds;
    volatile LAS unsigned* MISC;
    unsigned* ctl;
    int tid, lane, wave, vcu, G;
    const float *x, *meta, *norm1_g, *w_in, *b_in, *dw_w, *dw_b, *ln_g, *ln_b, *w_conv_out, *b_conv_out, *q_norm_g, *k_norm_g, *b_forget,
                *w_attn_out, *w_out, *norm2_g, *w_group, *b_group, *w_router, *b_router, *w_gate, *w_up, *w_down;
    float* out;
    float *BIAS1, *RS, *CB, *LOGF, *WL; bf16_t *WRH, *WRL;
    int* TOK;
    bf16_t *W1T, *WCT, *WAT, *WOT, *WGU, *WD, *XN, *MERGED, *ABUF, *CACT, *HN, *QO, *KX, *VX, *HB, *SG, *YB, *OB;
};

__device__ __forceinline__ float wave_sum(float v) {
#pragma unroll
    for (int o = 1; o < 64; o <<= 1) v += __shfl_xor(v, o);
    return v;
}

__device__ __forceinline__ int col1(int p) {
    const int pn = p >> 8, q = p & 255, bj = q >> 7, y = q & 127;
    if (pn < 4) return 128 * pn + y + 512 * bj;
    if (pn < 8) { const int wc = y >> 5, xx = y & 31, head = 4 * (pn & 1) + wc, dim = 32 * bj + xx; return (pn < 6 ? 1024 : 1536) + 64 * head + dim; }
    if (pn < 10) return 2048 + 256 * (pn - 8) + q;
    return GCOL + 256 * (pn - 10) + q;
}

__device__ __forceinline__ void tr_item(const float* W, int ldw, int k0, int n0, bf16_t* WT, int ldk, int row0, LAS float* scr, int lane) {
    { f32x4 v[8];
#pragma unroll
      for (int i = 0; i < 8; ++i) v[i] = *(const f32x4*)(W + (size_t)(k0 + 8 * i + (lane >> 3)) * ldw + n0 + 4 * (lane & 7));
#pragma unroll
      for (int i = 0; i < 8; ++i) { LAS float* d = scr + (8 * i + (lane >> 3)) * 33 + 4 * (lane & 7); d[0] = v[i][0]; d[1] = v[i][1]; d[2] = v[i][2]; d[3] = v[i][3]; } }
    LDS_WAIT(); asm volatile("" ::: "memory");
    const int c = lane & 7;
#pragma unroll
    for (int j = 0; j < 4; ++j) { const int n = (lane >> 3) + 8 * j; const LAS float* s = scr + (8 * c) * 33 + n;
        u32x4 o; o.x = cvt_pk_bf16(s[0 * 33], s[1 * 33]); o.y = cvt_pk_bf16(s[2 * 33], s[3 * 33]); o.z = cvt_pk_bf16(s[4 * 33], s[5 * 33]); o.w = cvt_pk_bf16(s[6 * 33], s[7 * 33]);
        *(u32x4*)(WT + (size_t)(row0 + n) * ldk + k0 + 8 * c) = o; }
    LDS_WAIT(); asm volatile("" ::: "memory");
}

__device__ __forceinline__ float log_sigmoid_(float z) { return z >= 0.f ? -log1pf(expf(-z)) : z - log1pf(expf(z)); }

__device__ __forceinline__ void p0_prologue(Frame& F) {
    LAS float* scr = (LAS float*)(F.lds + F.wave * 16384);
    const int gw = F.vcu * NWAVES + F.wave, NGW = F.G * NWAVES;
    constexpr int I_IN = 16 * 144, I_C = 8 * 32, I_O = 16 * 32;
    constexpr int NITEMS = I_IN + 2 * I_C + I_O;
    for (int it = gw; it < NITEMS; it += NGW) {
        int r = it;
        if (r < I_IN) { const int kb = r / 144, pb = r % 144; tr_item(F.w_in, INCOLS, 64 * kb, col1(32 * pb), F.W1T, 1024, 32 * pb, scr, F.lane); continue; } r -= I_IN;
        if (r < I_C) { tr_item(F.w_conv_out, 1024, 64 * (r / 32), 32 * (r % 32), F.WCT, 512, 32 * (r % 32), scr, F.lane); continue; } r -= I_C;
        if (r < I_C) { tr_item(F.w_attn_out, 1024, 64 * (r / 32), 32 * (r % 32), F.WAT, 512, 32 * (r % 32), scr, F.lane); continue; } r -= I_C;
        { tr_item(F.w_out, 1024, 64 * (r / 32), 32 * (r % 32), F.WOT, 1024, 32 * (r % 32), scr, F.lane); }
    }
    const int gt = F.vcu * (NWAVES * 64) + F.tid, NGT = F.G * NWAVES * 64;
    for (int p = gt; p < N1; p += NGT) F.BIAS1[p] = F.b_in[col1(p)];
    for (int i = gt; i < 1024 * 80; i += NGT) { const int c = i >> 10, k = i & 1023; float w = 0.f;
        if (c < 8) w = F.w_group[k * 8 + c]; else if (c < 72) w = F.w_router[k * 64 + (c - 8)];
        w *= F.norm2_g[k];
        const unsigned hi = cvt_pk_bf16(w, 0.f) & 0xffffu; const float rem = w - __uint_as_float(hi << 16);
        F.WRH[i] = (bf16_t)hi; F.WRL[i] = (bf16_t)(cvt_pk_bf16(rem, 0.f) & 0xffffu); }
    const u32x4 z4 = (u32x4){0u, 0u, 0u, 0u};
    for (int i = gt; i < NB * 16 * 64; i += NGT) { const int b = i / (16 * 64), r = (i / 64) % 16, c = i % 64; *(u32x4*)(F.ABUF + ((size_t)(b * AROWS + r)) * 512 + 8 * c) = z4; }
    for (int i = gt; i < NB * 48 * 64; i += NGT) { const int b = i / (48 * 64), r = (i / 64) % 48, c = i % 64;
        *(u32x4*)(F.KX + ((size_t)(b * KROWS + r)) * 512 + 8 * c) = z4; *(u32x4*)(F.VX + ((size_t)(b * KROWS + r)) * 512 + 8 * c) = z4; }
    __syncthreads();
    { LAS f32x4* wl = (LAS f32x4*)F.lds;
      for (int r = F.tid; r < 1024; r += NWAVES * 64) { const float* wp = F.w_in + (size_t)r * INCOLS + FCOL; wl[2 * r] = *(const f32x4*)wp; wl[2 * r + 1] = *(const f32x4*)(wp + 4); } }
    __syncthreads();
    if (gw < NR + NMETA) {
        f32x4 wf[4][4][2];
#pragma unroll
        for (int j = 0; j < 4; ++j)
#pragma unroll
            for (int jj = 0; jj < 4; ++jj) { const LAS f32x4* wp = (const LAS f32x4*)F.lds + 2 * (4 * F.lane + 256 * j + jj); wf[j][jj][0] = wp[0]; wf[j][jj][1] = wp[1]; }
        f32x4 g1[4];
#pragma unroll
        for (int j = 0; j < 4; ++j) g1[j] = *(const f32x4*)(F.norm1_g + 4 * F.lane + 256 * j);
        for (int m0 = gw; m0 < NR + NMETA; m0 += 2 * NGW) {
            f32x4 v[2][4]; float s[2], d[2][8]; bool ok[2];
#pragma unroll
            for (int u = 0; u < 2; ++u) { const int m = m0 + u * NGW; ok[u] = m < NR + NMETA; const int mm = ok[u] ? m : m0;
                const float* xrow = mm < NR ? F.x + (size_t)mm * DM : F.meta + (size_t)(mm - NR) * DM;
#pragma unroll
                for (int j = 0; j < 4; ++j) v[u][j] = *(const f32x4*)(xrow + 4 * F.lane + 256 * j); }
#pragma unroll
            for (int u = 0; u < 2; ++u) { s[u] = 0.f;
#pragma unroll
                for (int h = 0; h < 8; ++h) d[u][h] = 0.f;
#pragma unroll
                for (int j = 0; j < 4; ++j) { s[u] += (v[u][j].x * v[u][j].x + v[u][j].y * v[u][j].y) + (v[u][j].z * v[u][j].z + v[u][j].w * v[u][j].w);
                    v[u][j] = v[u][j] * g1[j];
#pragma unroll
                    for (int jj = 0; jj < 4; ++jj) { const float xv = v[u][j][jj];
#pragma unroll
                        for (int h = 0; h < 4; ++h) { d[u][h] += xv * wf[j][jj][0][h]; d[u][4 + h] += xv * wf[j][jj][1][h]; } } } }
            float rs[2], g[2];
            const bool u32_ = (F.lane & 32) != 0, u16_ = (F.lane & 16) != 0, u8_ = (F.lane & 8) != 0;
#pragma unroll
            for (int u = 0; u < 2; ++u) { rs[u] = 1.0f / sqrtf(wave_sum(s[u]) * (1.f / DM) + RMS_EPS);
                float e[4], f[2];
#pragma unroll
                for (int i = 0; i < 4; ++i) { const float snd = u32_ ? d[u][i] : d[u][4 + i], kp = u32_ ? d[u][4 + i] : d[u][i]; e[i] = kp + __shfl_xor(snd, 32); }
#pragma unroll
                for (int i = 0; i < 2; ++i) { const float snd = u16_ ? e[i] : e[2 + i], kp = u16_ ? e[2 + i] : e[i]; f[i] = kp + __shfl_xor(snd, 16); }
                float gg = (u8_ ? f[1] : f[0]) + __shfl_xor(u8_ ? f[0] : f[1], 8);
                gg += __shfl_xor(gg, 4); gg += __shfl_xor(gg, 2); gg += __shfl_xor(gg, 1); g[u] = gg; }
#pragma unroll
            for (int u = 0; u < 2; ++u) if (ok[u]) { const int m = m0 + u * NGW;
                bf16_t* orow = F.XN + (size_t)m * DM;
#pragma unroll
                for (int j = 0; j < 4; ++j) { const f32x4 y = v[u][j] * rs[u]; u32x2 o; o.x = cvt_pk_bf16(y.x, y.y); o.y = cvt_pk_bf16(y.z, y.w); *(u32x2*)(orow + 4 * F.lane + 256 * j) = o; }
                if ((F.lane & 7) == 0) { const int h = F.lane >> 3;
                    const float z = g[u] * rs[u] + F.b_in[FCOL + h] + F.b_forget[h];
                    F.LOGF[(size_t)m * 8 + h] = log_sigmoid_(z); } }
        }
    }
}

__device__ __forceinline__ void scan_bh(Frame& F, int bh) {
    const int b = bh >> 3, h = bh & 7, lane = F.lane;
    float loc[33]; float tot = 0.f;
#pragma unroll
    for (int i = 0; i < 33; ++i) { const int p = 33 * lane + i; float v = 0.f;
        if (p < NMETA) v = F.LOGF[(size_t)(NR + p) * 8 + h]; else if (p < SEQ + NMETA) v = F.LOGF[((size_t)b * SEQ + (p - NMETA)) * 8 + h];
        tot += v; loc[i] = tot; }
    float inc = tot;
#pragma unroll
    for (int o = 1; o < 64; o <<= 1) { const float n = __shfl_up(inc, o); if (lane >= o) inc += n; }
    const float excl = inc - tot;
    float* cb = F.CB + (size_t)bh * KROWS;
#pragma unroll
    for (int i = 0; i < 33; ++i) { const int p = 33 * lane + i; if (p < SEQ + NMETA) cb[48 + p] = -(excl + loc[i]) * LOG2E; }
    if (lane < 48) cb[lane] = NEGBIG;
}

struct StaticOrder {
    int nM, nN, nwg, G, c;
    __device__ __forceinline__ void init(int nM_, int nN_, int G_, int c_) { nM = nM_; nN = nN_; nwg = nM * nN; G = G_; c = c_; }
    __device__ __forceinline__ bool tile(int i, int& pm, int& pn) const {
        const long L = (long)i * G + c; if (L >= nwg) return false;
        int wgid = (int)L; { const int q = nwg / 8, r = nwg % 8, xcd = wgid % 8, off = wgid / 8; wgid = (xcd < r ? xcd * (q + 1) : r * (q + 1) + (xcd - r) * q) + off; }
        const int nig = 8 * nN, gid = wgid / nig, fm = gid * 8, gsz = (nM - fm) < 8 ? (nM - fm) : 8;
        pm = fm + ((wgid % nig) % gsz); pn = (wgid % nig) / gsz; return true;
    }
};
struct SchedPlain {
    StaticOrder so; const char* A; const char* B; int K;
    __device__ __forceinline__ bool next(int i, pg8::Unit& u) const { u.e = 0; return so.tile(i, u.pm, u.pn); }
    __device__ __forceinline__ const char* a_base(const pg8::Unit& u) const { return A + (size_t)u.pm * 256 * K * 2; }
    __device__ __forceinline__ const char* b_base(const pg8::Unit& u) const { return B + (size_t)u.pn * 256 * K * 2; }
    __device__ __forceinline__ void a_offs(const pg8::Unit&, const int (&)[2], const int (&)[2], unsigned (&)[2][2]) const {}
};
struct SchedDual {
    StaticOrder so; const char *A0, *B0, *A1, *B1; int K;
    __device__ __forceinline__ bool next(int i, pg8::Unit& u) const { u.e = i & 1; return so.tile(i >> 1, u.pm, u.pn); }
    __device__ __forceinline__ const char* a_base(const pg8::Unit& u) const { return (u.e ? A1 : A0) + (size_t)u.pm * 256 * K * 2; }
    __device__ __forceinline__ const char* b_base(const pg8::Unit& u) const { return (u.e ? B1 : B0) + (size_t)u.pn * 256 * K * 2; }
    __device__ __forceinline__ void a_offs(const pg8::Unit&, const int (&)[2], const int (&)[2], unsigned (&)[2][2]) const {}
};
struct SchedMoe {
    int first, last, stride, c, sh; const LAS int* tab; const LAS int* cnt; const char* A; const char* B; const int* TOK; int K, brows; bool gather;
    __device__ __forceinline__ bool next(int i, pg8::Unit& u) const { const int idx = first + i * stride + c; if (idx >= last) return false; u.pm = idx >> sh; u.pn = idx & ((1 << sh) - 1); u.e = tab[u.pm]; return true; }
    __device__ __forceinline__ int rows(const pg8::Unit& u) const { return cnt[u.e & 255] - 256 * (u.e >> 8); }
    __device__ __forceinline__ const char* a_base(const pg8::Unit& u) const { return gather ? A : A + (size_t)u.pm * 256 * K * 2; }
    __device__ __forceinline__ const char* b_base(const pg8::Unit& u) const { return B + ((size_t)(u.e & 255) * brows + (size_t)u.pn * 256) * K * 2; }
    __device__ __forceinline__ void a_offs(const pg8::Unit& u, const int (&R)[2], const int (&C)[2], unsigned (&ao)[2][2]) const {
        if (gather) {
            const int e = u.e & 255, rt = u.e >> 8, n = cnt[e];
#pragma unroll
            for (int h = 0; h < 2; ++h)
#pragma unroll
                for (int i = 0; i < 2; ++i) { const int pos = rt * 256 + 128 * h + R[i]; const int tok = TOK[(size_t)e * MOE_CAP + (pos < n ? pos : 0)] >> 1; ao[h][i] = (unsigned)(tok * K + C[i]) * 2u; }
            asm volatile("s_waitcnt vmcnt(0)" : "+v"(ao[0][0]), "+v"(ao[0][1]), "+v"(ao[1][0]), "+v"(ao[1][1]) :: "memory");
        }
    }
};

__device__ __forceinline__ u32x4 pack8(const f32x4& a, const f32x4& b) { u32x4 w; w.x = cvt_pk_bf16(a[0], a[1]); w.y = cvt_pk_bf16(a[2], a[3]); w.z = cvt_pk_bf16(b[0], b[1]); w.w = cvt_pk_bf16(b[2], b[3]); return w; }
__device__ __forceinline__ void unpack8(const u32x4& w, f32x4& a, f32x4& b) { a = (f32x4){bf_lo(w.x), bf_hi(w.x), bf_lo(w.y), bf_hi(w.y)}; b = (f32x4){bf_lo(w.z), bf_hi(w.z), bf_lo(w.w), bf_hi(w.w)}; }

struct Epi1 {
    static constexpr bool PERM = true;
    const float *bias1, *gq, *gk; bf16_t *ABUF, *Q, *KX, *VX, *SG;
    __device__ __forceinline__ bool operator()(f32x4 (&acc)[2][2][4][2], const pg8::Unit& u, int wr, int wc, int fr, int fq) {
        asm volatile("" : "+v"(fr), "+v"(fq));
        const int pn = u.pn; const bool meta = (u.pm == 64); const int cpos = 32 * wc + 8 * fq;
        if (meta && (pn == 4 || pn == 5 || pn >= 10)) return false;
        const float* bp = bias1 + pn * 256 + cpos;
        const f32x4 b00 = *(const f32x4*)(bp), b01 = *(const f32x4*)(bp + 4), b10 = *(const f32x4*)(bp + 128), b11 = *(const f32x4*)(bp + 132);
        const int row_w = u.pm * 256 + 64 * wr + fr;
        if (pn < 4) {
            const int col = 128 * pn + cpos;
#pragma unroll
            for (int ai = 0; ai < 2; ++ai)
#pragma unroll
                for (int m = 0; m < 4; ++m) {
                    const f32x4 x00 = acc[ai][0][m][0] + b00, x01 = acc[ai][0][m][1] + b01, x10 = acc[ai][1][m][0] + b10, x11 = acc[ai][1][m][1] + b11;
                    f32x4 o0, o1;
#pragma unroll
                    for (int j = 0; j < 4; ++j) { o0[j] = x00[j] * sigmoidf_(x10[j]); o1[j] = x01[j] * sigmoidf_(x11[j]); }
                    const u32x4 w = pack8(o0, o1);
                    const int Rg = row_w + 128 * ai + 16 * m;
                    if (!meta) { const int b = Rg >> 11, t = Rg & 2047; *(u32x4*)(ABUF + ((size_t)(b * AROWS + 32 + t)) * 512 + col) = w; }
                    else if (ai == 0 && m == 0 && wr == 0) { for (int bb = 0; bb < NB; ++bb) *(u32x4*)(ABUF + ((size_t)(bb * AROWS + 16 + fr)) * 512 + col) = w; }
                }
        } else if (pn < 8) {
            const bool isq = pn < 6; const float* g = isq ? gq : gk; const float sc = isq ? C2 : 1.0f;
            const f32x4 g00 = *(const f32x4*)(g + 8 * fq) * sc, g01 = *(const f32x4*)(g + 8 * fq + 4) * sc, g10 = *(const f32x4*)(g + 32 + 8 * fq) * sc, g11 = *(const f32x4*)(g + 36 + 8 * fq) * sc;
            const int col = 64 * (4 * (pn & 1) + wc) + 8 * fq;
#pragma unroll
            for (int ai = 0; ai < 2; ++ai)
#pragma unroll
                for (int m = 0; m < 4; ++m) {
                    const f32x4 x00 = acc[ai][0][m][0] + b00, x01 = acc[ai][0][m][1] + b01, x10 = acc[ai][1][m][0] + b10, x11 = acc[ai][1][m][1] + b11;
                    const f32x4 sq = x00 * x00 + x01 * x01 + x10 * x10 + x11 * x11;
                    float ss = (sq[0] + sq[1]) + (sq[2] + sq[3]);
                    ss += __shfl_xor(ss, 16); ss += __shfl_xor(ss, 32);
                    const float rs = 1.0f / sqrtf(ss * (1.f / 64.f) + RMS_EPS);
                    const u32x4 w0 = pack8(x00 * rs * g00, x01 * rs * g01), w1 = pack8(x10 * rs * g10, x11 * rs * g11);
                    const int Rg = row_w + 128 * ai + 16 * m; const int b = Rg >> 11, t = Rg & 2047;
                    if (isq) { bf16_t* o = Q + (size_t)Rg * 512 + col; *(u32x4*)o = w0; *(u32x4*)(o + 32) = w1; }
                    else if (!meta) { bf16_t* o = KX + ((size_t)(b * KROWS + 64 + t)) * 512 + col; *(u32x4*)o = w0; *(u32x4*)(o + 32) = w1; }
                    else if (ai == 0 && m == 0 && wr == 0) { for (int bb = 0; bb < NB; ++bb) { bf16_t* o = KX + ((size_t)(bb * KROWS + 48 + fr)) * 512 + col; *(u32x4*)o = w0; *(u32x4*)(o + 32) = w1; } }
                }
        } else if (pn < 10) {
            const int col = 256 * (pn - 8) + cpos;
#pragma unroll
            for (int ai = 0; ai < 2; ++ai)
#pragma unroll
                for (int m = 0; m < 4; ++m) {
                    const u32x4 w0 = pack8(acc[ai][0][m][0] + b00, acc[ai][0][m][1] + b01), w1 = pack8(acc[ai][1][m][0] + b10, acc[ai][1][m][1] + b11);
                    const int Rg = row_w + 128 * ai + 16 * m; const int b = Rg >> 11, t = Rg & 2047;
                    if (!meta) { bf16_t* o = VX + ((size_t)(b * KROWS + 64 + t)) * 512 + col; *(u32x4*)o = w0; *(u32x4*)(o + 128) = w1; }
                    else if (ai == 0 && m == 0 && wr == 0) { for (int bb = 0; bb < NB; ++bb) { bf16_t* o = VX + ((size_t)(bb * KROWS + 48 + fr)) * 512 + col; *(u32x4*)o = w0; *(u32x4*)(o + 128) = w1; } }
                }
        } else {
            const int col = 256 * (pn - 10) + cpos;
#pragma unroll
            for (int ai = 0; ai < 2; ++ai)
#pragma unroll
                for (int m = 0; m < 4; ++m) {
                    const f32x4 x00 = acc[ai][0][m][0] + b00, x01 = acc[ai][0][m][1] + b01, x10 = acc[ai][1][m][0] + b10, x11 = acc[ai][1][m][1] + b11;
                    f32x4 o00, o01, o10, o11;
#pragma unroll
                    for (int j = 0; j < 4; ++j) { o00[j] = sigmoidf_(x00[j]); o01[j] = sigmoidf_(x01[j]); o10[j] = sigmoidf_(x10[j]); o11[j] = sigmoidf_(x11[j]); }
                    bf16_t* o = SG + (size_t)(row_w + 128 * ai + 16 * m) * 2048 + col;
                    *(u32x4*)o = pack8(o00, o01); *(u32x4*)(o + 128) = pack8(o10, o11);
                }
        }
        return false;
    }
};

struct Epi3 {
    static constexpr bool PERM = true;
    const float* bc; const bf16_t* SG; bf16_t* MERGED;
    __device__ __forceinline__ bool operator()(f32x4 (&acc)[2][2][4][2], const pg8::Unit& u, int wr, int wc, int fr, int fq) {
        asm volatile("" : "+v"(fr), "+v"(fq));
        const int col0 = u.pn * 256 + 32 * wc + 8 * fq;
        const bf16_t* sgrow = SG + ((size_t)u.pm * 256 + 64 * wr + fr) * 2048 + col0;
        if (u.e == 0) {
            const f32x4 b00 = *(const f32x4*)(bc + col0), b01 = *(const f32x4*)(bc + col0 + 4), b10 = *(const f32x4*)(bc + col0 + 128), b11 = *(const f32x4*)(bc + col0 + 132);
#pragma unroll
            for (int ai = 0; ai < 2; ++ai)
#pragma unroll
                for (int m = 0; m < 4; ++m) {
                    const bf16_t* sp = sgrow + (size_t)(128 * ai + 16 * m) * 2048;
                    const u32x4 wc0 = *(const u32x4*)(sp), wc1 = *(const u32x4*)(sp + 128), wa0 = *(const u32x4*)(sp + 1024), wa1 = *(const u32x4*)(sp + 1152);
                    f32x4 c00, c01, c10, c11, a00, a01, a10, a11;
                    unpack8(wc0, c00, c01); unpack8(wc1, c10, c11); unpack8(wa0, a00, a01); unpack8(wa1, a10, a11);
#pragma unroll
                    for (int j = 0; j < 4; ++j) {
                        acc[ai][0][m][0][j] = (acc[ai][0][m][0][j] + b00[j]) * c00[j] * __builtin_amdgcn_rcpf(fmaxf(a00[j], 1e-20f));
                        acc[ai][0][m][1][j] = (acc[ai][0][m][1][j] + b01[j]) * c01[j] * __builtin_amdgcn_rcpf(fmaxf(a01[j], 1e-20f));
                        acc[ai][1][m][0][j] = (acc[ai][1][m][0][j] + b10[j]) * c10[j] * __builtin_amdgcn_rcpf(fmaxf(a10[j], 1e-20f));
                        acc[ai][1][m][1][j] = (acc[ai][1][m][1][j] + b11[j]) * c11[j] * __builtin_amdgcn_rcpf(fmaxf(a11[j], 1e-20f)); }
                }
            return true;
        }
        bf16_t* mrow = MERGED + ((size_t)u.pm * 256 + 64 * wr + fr) * 1024 + col0;
#pragma unroll
        for (int ai = 0; ai < 2; ++ai)
#pragma unroll
            for (int m = 0; m < 4; ++m) {
                const bf16_t* sp = sgrow + (size_t)(128 * ai + 16 * m) * 2048;
                const u32x4 wa0 = *(const u32x4*)(sp + 1024), wa1 = *(const u32x4*)(sp + 1152);
                f32x4 a00, a01, a10, a11; unpack8(wa0, a00, a01); unpack8(wa1, a10, a11);
                bf16_t* op = mrow + (size_t)(128 * ai + 16 * m) * 1024;
                *(u32x4*)op = pack8(acc[ai][0][m][0] * a00, acc[ai][0][m][1] * a01); *(u32x4*)(op + 128) = pack8(acc[ai][1][m][0] * a10, acc[ai][1][m][1] * a11);
            }
        return false;
    }
};

struct Epi4 {
    static constexpr bool PERM = false;
    const float* x; float* out;
    __device__ __forceinline__ bool operator()(f32x4 (&acc)[2][2][4][2], const pg8::Unit& u, int wr, int wc, int fr, int fq) {
        asm volatile("" : "+v"(fr), "+v"(fq));
        const size_t off0 = ((size_t)u.pm * 256 + 64 * wr + fr) * 1024 + u.pn * 256 + 32 * wc + 4 * fq;
#pragma unroll
        for (int ai = 0; ai < 2; ++ai) {
            f32x4 r[4][2][2];
#pragma unroll
            for (int m = 0; m < 4; ++m)
#pragma unroll
                for (int bj = 0; bj < 2; ++bj)
#pragma unroll
                    for (int n = 0; n < 2; ++n) r[m][bj][n] = *(const f32x4*)(x + off0 + (size_t)(128 * ai + 16 * m) * 1024 + 128 * bj + 16 * n);
#pragma unroll
            for (int m = 0; m < 4; ++m)
#pragma unroll
                for (int bj = 0; bj < 2; ++bj)
#pragma unroll
                    for (int n = 0; n < 2; ++n) *(f32x4*)(out + off0 + (size_t)(128 * ai + 16 * m) * 1024 + 128 * bj + 16 * n) = r[m][bj][n] + acc[ai][bj][m][n];
        }
        return false;
    }
};

struct Epi6 {
    static constexpr bool PERM = true;
    const LAS int* cnt; const int* TOK; const float* RS; bf16_t* HB;
    __device__ __forceinline__ bool operator()(f32x4 (&acc)[2][2][4][2], const pg8::Unit& u, int wr, int wc, int fr, int fq) {
        asm volatile("" : "+v"(fr), "+v"(fq));
        const int e = u.e & 255, rt = u.e >> 8, n = cnt[e];
        float rsv[2][4];
        { int tk[2][4];
#pragma unroll
          for (int ai = 0; ai < 2; ++ai)
#pragma unroll
              for (int m = 0; m < 4; ++m) { const int pos = rt * 256 + 128 * ai + 64 * wr + 16 * m + fr; tk[ai][m] = TOK[(size_t)e * MOE_CAP + (pos < n ? pos : 0)] >> 1; }
#pragma unroll
          for (int ai = 0; ai < 2; ++ai)
#pragma unroll
              for (int m = 0; m < 4; ++m) rsv[ai][m] = RS[tk[ai][m]]; }
#pragma unroll
        for (int ai = 0; ai < 2; ++ai)
#pragma unroll
            for (int m = 0; m < 4; ++m) {
                const int rl = 128 * ai + 64 * wr + 16 * m + fr;
                const float rs = rsv[ai][m];
                f32x4 o0, o1;
#pragma unroll
                for (int j = 0; j < 4; ++j) { const float g0 = acc[ai][0][m][0][j] * rs, g1 = acc[ai][0][m][1][j] * rs;
                    o0[j] = g0 * sigmoidf_(g0) * (acc[ai][1][m][0][j] * rs); o1[j] = g1 * sigmoidf_(g1) * (acc[ai][1][m][1][j] * rs); }
                *(u32x4*)(HB + ((size_t)u.pm * 256 + rl) * 256 + 128 * u.pn + 32 * wc + 8 * fq) = pack8(o0, o1);
            }
        return false;
    }
};

struct Epi7 {
    static constexpr bool PERM = true;
    const LAS int* cnt; const int* TOK; const float* WL; bf16_t* YB;
    __device__ __forceinline__ bool operator()(f32x4 (&acc)[2][2][4][2], const pg8::Unit& u, int wr, int wc, int fr, int fq) {
        asm volatile("" : "+v"(fr), "+v"(fq));
        const int e = u.e & 255, rt = u.e >> 8, n = cnt[e];
        const int col = u.pn * 256 + 32 * wc + 8 * fq;
#pragma unroll
        for (int ai = 0; ai < 2; ++ai) {
            int ent[4]; float wv[4];
#pragma unroll
            for (int m = 0; m < 4; ++m) { const int pos = rt * 256 + 128 * ai + 64 * wr + 16 * m + fr; const size_t li = (size_t)e * MOE_CAP + (pos < n ? pos : 0);
                ent[m] = TOK[li]; wv[m] = WL[li]; if (pos >= n) ent[m] = -1; }
#pragma unroll
            for (int m = 0; m < 4; ++m) if (ent[m] >= 0) {
                const float w = wv[m]; bf16_t* op = YB + (size_t)ent[m] * 1024 + col;
                *(u32x4*)op = pack8(acc[ai][0][m][0] * w, acc[ai][0][m][1] * w); *(u32x4*)(op + 128) = pack8(acc[ai][1][m][0] * w, acc[ai][1][m][1] * w); }
            asm volatile("" ::: "memory");
        }
        return false;
    }
};

__device__ __forceinline__ void conv_unit(Frame& F, int b, int chunk) {
    const int c = F.tid, t0 = chunk * 32;
    float w[CK];
#pragma unroll
    for (int j = 0; j < CK; ++j) w[j] = F.dw_w[j * CWID + c];
    float v[62];
    const bf16_t* base = F.ABUF + ((size_t)(b * AROWS + 32 + t0 - 30)) * 512 + c;
#pragma unroll
    for (int i = 0; i < 62; ++i) v[i] = bf2f(base[(size_t)i * 512]);
    float ov[32]; const float bias = F.dw_b[c];
#pragma unroll
    for (int i = 0; i < 32; ++i) { float s = bias;
#pragma unroll
        for (int j = 0; j < CK; ++j) s += w[j] * v[i + j];
        ov[i] = s; }
    LAS float* red = (LAS float*)F.lds; LAS float* st = red + 32 * 512;
    __syncthreads();
#pragma unroll
    for (int i = 0; i < 32; ++i) red[i * 512 + c] = ov[i];
    __syncthreads();
    { const int row = F.tid >> 4, seg = F.tid & 15; float s = 0.f;
#pragma unroll
      for (int qq = 0; qq < 32; ++qq) s += red[row * 512 + seg + 16 * qq];
      s += __shfl_xor(s, 1); s += __shfl_xor(s, 2); s += __shfl_xor(s, 4); s += __shfl_xor(s, 8);
      const float mean = s * (1.f / 512.f); float q2 = 0.f;
#pragma unroll
      for (int qq = 0; qq < 32; ++qq) { const float dlt = red[row * 512 + seg + 16 * qq] - mean; q2 += dlt * dlt; }
      q2 += __shfl_xor(q2, 1); q2 += __shfl_xor(q2, 2); q2 += __shfl_xor(q2, 4); q2 += __shfl_xor(q2, 8);
      if (seg == 0) { st[2 * row] = mean; st[2 * row + 1] = 1.0f / sqrtf(q2 * (1.f / 512.f) + LN_EPS); } }
    __syncthreads();
    const float g = F.ln_g[c], bb = F.ln_b[c];
    bf16_t* op = F.CACT + ((size_t)(b * SEQ + t0)) * 512 + c;
#pragma unroll
    for (int i = 0; i < 32; ++i) { const float y = (ov[i] - st[2 * i]) * st[2 * i + 1] * g + bb; const float z = y * sigmoidf_(y);
        op[(size_t)i * 512] = (bf16_t)(cvt_pk_bf16(z, 0.f) & 0xffffu); }
}

constexpr int CVT_GU = 64 * 16 * 16, CVT_D = 64 * 4 * 32, CVT_EARLY = 6400;
struct CvtItem { const float* W; int ldw, k0, n0; bf16_t* WT; int ldk, row0; const float* gk; };
__device__ __forceinline__ CvtItem cvt_decode(Frame& F, int r) {
    CvtItem it;
    if (r < CVT_GU) { const int e = r >> 8, r2 = r & 255, kb = r2 >> 4, pb = r2 & 15, p0 = 32 * pb, pn = p0 >> 8, bj = (p0 & 255) >> 7, y = p0 & 127;
        it.W = (bj ? F.w_up : F.w_gate) + (size_t)e * 1024 * 256; it.ldw = 256; it.k0 = 64 * kb; it.n0 = 128 * pn + y; it.WT = F.WGU + (size_t)e * 512 * 1024; it.ldk = 1024; it.row0 = p0; it.gk = F.norm2_g; }
    else { r -= CVT_GU; const int e = r >> 7, r2 = r & 127, kb = r2 >> 5, nb = r2 & 31;
        it.W = F.w_down + (size_t)e * 256 * 1024; it.ldw = 1024; it.k0 = 64 * kb; it.n0 = 32 * nb; it.WT = F.WD + (size_t)e * 1024 * 256; it.ldk = 256; it.row0 = 32 * nb; it.gk = nullptr; }
    return it;
}
__device__ __forceinline__ void cvt_load(const CvtItem& it, f32x4 (&v)[8], int lane) {
#pragma unroll
    for (int i = 0; i < 8; ++i) v[i] = *(const f32x4*)(it.W + (size_t)(it.k0 + 8 * i + (lane >> 3)) * it.ldw + it.n0 + 4 * (lane & 7));
}
__device__ __forceinline__ void cvt_store(const CvtItem& it, const f32x4 (&v)[8], LAS float* scr, int lane) {
    float gk[8];
#pragma unroll
    for (int i = 0; i < 8; ++i) gk[i] = it.gk ? it.gk[it.k0 + 8 * i + (lane >> 3)] : 1.0f;
#pragma unroll
    for (int i = 0; i < 8; ++i) { LAS float* d = scr + (8 * i + (lane >> 3)) * 33 + 4 * (lane & 7); d[0] = v[i][0] * gk[i]; d[1] = v[i][1] * gk[i]; d[2] = v[i][2] * gk[i]; d[3] = v[i][3] * gk[i]; }
    LDS_WAIT(); asm volatile("" ::: "memory");
    const int c = lane & 7;
#pragma unroll
    for (int j = 0; j < 4; ++j) { const int n = (lane >> 3) + 8 * j; const LAS float* s = scr + (8 * c) * 33 + n;
        u32x4 o; o.x = cvt_pk_bf16(s[0 * 33], s[1 * 33]); o.y = cvt_pk_bf16(s[2 * 33], s[3 * 33]); o.z = cvt_pk_bf16(s[4 * 33], s[5 * 33]); o.w = cvt_pk_bf16(s[6 * 33], s[7 * 33]);
        *(u32x4*)(it.WT + (size_t)(it.row0 + n) * it.ldk + it.k0 + 8 * c) = o; }
    LDS_WAIT(); asm volatile("" ::: "memory");
}
__device__ __forceinline__ void convert_experts(Frame& F, int first, int last, int w, int nw) {
    LAS float* scr = (LAS float*)(F.lds + F.wave * 16384);
    int r = first + w;
    if (r >= last) return;
    CvtItem cur = cvt_decode(F, r); f32x4 va[8], vb[8];
    cvt_load(cur, va, F.lane);
    for (;;) {
        const int rn = r + nw; const bool more = rn < last;
        CvtItem nxt = cur; if (more) { nxt = cvt_decode(F, rn); cvt_load(nxt, vb, F.lane); }
        cvt_store(cur, va, scr, F.lane);
        if (!more) break;
        const int rn2 = rn + nw; const bool more2 = rn2 < last;
        CvtItem nx2 = nxt; if (more2) { nx2 = cvt_decode(F, rn2); cvt_load(nx2, va, F.lane); }
        cvt_store(nxt, vb, scr, F.lane);
        if (!more2) break;
        cur = nx2; r = rn2;
    }
}

constexpr int RT_NRT = 2, RT_WAVES = 2;
__device__ __forceinline__ void p5_router(Frame& F) {
    const int lane = F.lane, row = lane & 15, q = lane >> 4;
    LAS float* Lw = (LAS float*)(F.lds + F.wave * 16384);
    unsigned* cnt = F.ctl + CW_CNT;
    constexpr int NTASK = NR / (16 * RT_NRT);
    if (F.wave < RT_WAVES) for (int task = F.wave * F.G + F.vcu; task < NTASK; task += RT_WAVES * F.G) {
        const int row0 = task * 16 * RT_NRT;
        const float* __restrict__ hp = F.out + (size_t)(row0 + row) * DM + 8 * q;
        bf16_t* __restrict__ hn = F.HN + (size_t)(row0 + row) * DM + 8 * q;
        const bf16_t* __restrict__ bh = F.WRH + (size_t)row * 1024 + 8 * q; const bf16_t* __restrict__ bl = F.WRL + (size_t)row * 1024 + 8 * q;
        f32x4 acc[RT_NRT][5];
#pragma unroll
        for (int rt = 0; rt < RT_NRT; ++rt)
#pragma unroll
            for (int tl = 0; tl < 5; ++tl) acc[rt][tl] = (f32x4){0.f, 0.f, 0.f, 0.f};
        float ss[RT_NRT];
#pragma unroll
        for (int rt = 0; rt < RT_NRT; ++rt) ss[rt] = 0.f;
        constexpr int HD_ = 2;
        f32x4 hq0[HD_][RT_NRT], hq1[HD_][RT_NRT]; bf16x8 Bc[10];
#pragma unroll
        for (int d = 0; d < HD_; ++d)
#pragma unroll
            for (int rt = 0; rt < RT_NRT; ++rt) { hq0[d][rt] = *(const f32x4*)(hp + (size_t)rt * 16 * DM + 32 * d); hq1[d][rt] = *(const f32x4*)(hp + (size_t)rt * 16 * DM + 32 * d + 4); }
#pragma unroll
        for (int tl = 0; tl < 5; ++tl) { Bc[2 * tl] = *(const bf16x8*)(bh + (size_t)tl * 16 * 1024); Bc[2 * tl + 1] = *(const bf16x8*)(bl + (size_t)tl * 16 * 1024); }
        constexpr int NS_ = 32;
        for (int s2 = 0; s2 < NS_; s2 += HD_) {
#pragma unroll
            for (int d = 0; d < HD_; ++d) {
                const int s = s2 + d, sn = s + 1 < NS_ ? s + 1 : s;
                bf16x8 Bn[10];
#pragma unroll
                for (int tl = 0; tl < 5; ++tl) { Bn[2 * tl] = *(const bf16x8*)(bh + (size_t)tl * 16 * 1024 + 32 * sn); Bn[2 * tl + 1] = *(const bf16x8*)(bl + (size_t)tl * 16 * 1024 + 32 * sn); }
                f32x4 h0[RT_NRT], h1[RT_NRT];
#pragma unroll
                for (int rt = 0; rt < RT_NRT; ++rt) { h0[rt] = hq0[d][rt]; h1[rt] = hq1[d][rt]; }
                if (s2 + HD_ < NS_) {
#pragma unroll
                    for (int rt = 0; rt < RT_NRT; ++rt) { hq0[d][rt] = *(const f32x4*)(hp + (size_t)rt * 16 * DM + 32 * (s + HD_)); hq1[d][rt] = *(const f32x4*)(hp + (size_t)rt * 16 * DM + 32 * (s + HD_) + 4); } }
#pragma unroll
                for (int rt = 0; rt < RT_NRT; ++rt) {
                    const f32x4 sq = h0[rt] * h0[rt] + h1[rt] * h1[rt]; ss[rt] += (sq[0] + sq[1]) + (sq[2] + sq[3]);
                    const u32x4 ahi = pack8(h0[rt], h1[rt]); f32x4 r0, r1; unpack8(ahi, r0, r1);
                    *(u32x4*)(hn + (size_t)rt * 16 * DM + 32 * s) = ahi;
                    const u32x4 alo = pack8(h0[rt] - r0, h1[rt] - r1);
                    const bf16x8 Ahi = __builtin_bit_cast(bf16x8, ahi), Alo = __builtin_bit_cast(bf16x8, alo);
#pragma unroll
                    for (int tl = 0; tl < 5; ++tl) {
                        acc[rt][tl] = __builtin_amdgcn_mfma_f32_16x16x32_bf16(Ahi, Bc[2 * tl], acc[rt][tl], 0, 0, 0);
                        acc[rt][tl] = __builtin_amdgcn_mfma_f32_16x16x32_bf16(Ahi, Bc[2 * tl + 1], acc[rt][tl], 0, 0, 0);
                        acc[rt][tl] = __builtin_amdgcn_mfma_f32_16x16x32_bf16(Alo, Bc[2 * tl], acc[rt][tl], 0, 0, 0); }
                }
#pragma unroll
                for (int i = 0; i < 10; ++i) Bc[i] = Bn[i];
            }
        }
        float rsv[RT_NRT];
#pragma unroll
        for (int rt = 0; rt < RT_NRT; ++rt) { float s_ = ss[rt]; s_ += __shfl_xor(s_, 16); s_ += __shfl_xor(s_, 32); rsv[rt] = 1.0f / sqrtf(s_ * (1.f / DM) + RMS_EPS);
#pragma unroll
            for (int tl = 0; tl < 5; ++tl)
#pragma unroll
                for (int r = 0; r < 4; ++r) Lw[(rt * 16 + 4 * q + r) * 80 + 16 * tl + row] = acc[rt][tl][r]; }
        LDS_WAIT(); asm volatile("" ::: "memory");
        if (lane < 16 * RT_NRT) {
            const float rs = (lane >> 4) == 0 ? rsv[0] : rsv[RT_NRT - 1];
            float lg[72];
#pragma unroll
            for (int c = 0; c < 72; ++c) lg[c] = Lw[lane * 80 + c] * rs + (c < 8 ? F.b_group[c] : F.b_router[c - 8]);
            int gi = 0; float gm = lg[0];
#pragma unroll
            for (int c = 1; c < 8; ++c) if (lg[c] > gm) { gm = lg[c]; gi = c; }
            float gs = 0.f;
#pragma unroll
            for (int c = 0; c < 8; ++c) gs += expf(lg[c] - gm);
            const float gwt = 1.0f / gs;
            float el[8];
#pragma unroll
            for (int i = 0; i < 8; ++i) el[i] = lg[8 + i];
#pragma unroll
            for (int g = 1; g < 8; ++g) if (gi == g) {
#pragma unroll
                for (int i = 0; i < 8; ++i) el[i] = lg[8 + 8 * g + i]; }
            int i1 = 0; float l1 = el[0];
#pragma unroll
            for (int i = 1; i < 8; ++i) if (el[i] > l1) { l1 = el[i]; i1 = i; }
            int i2 = -1; float l2 = -3e38f;
#pragma unroll
            for (int i = 0; i < 8; ++i) if (i != i1 && el[i] > l2) { l2 = el[i]; i2 = i; }
            const float ex = expf(l2 - l1), w1 = gwt / (1.0f + ex), w2 = gwt * ex / (1.0f + ex);
            const int e1 = gi * 8 + i1, e2 = gi * 8 + i2, tok = row0 + lane;
            {
            const unsigned p1 = atomicAdd(cnt + 64 * e1, 1u), p2 = atomicAdd(cnt + 64 * e2, 1u);
            F.TOK[(size_t)e1 * MOE_CAP + p1] = 2 * tok; F.WL[(size_t)e1 * MOE_CAP + p1] = w1;
            F.TOK[(size_t)e2 * MOE_CAP + p2] = 2 * tok + 1; F.WL[(size_t)e2 * MOE_CAP + p2] = w2;
            F.RS[tok] = rs; }
        }
        LDS_WAIT(); asm volatile("" ::: "memory");
    }
}

__device__ __forceinline__ int moe_table(Frame& F) {
    LAS int* cntl = (LAS int*)(F.lds + TAB_OFF); LAS int* tab = cntl + 64; LAS int* ntl = tab + MAXT;
    __syncthreads();
    if (F.tid < 64) cntl[F.tid] = (int)__hip_atomic_load(F.ctl + CW_CNT + 64 * F.tid, RLX_AGENT);
    __syncthreads();
    if (F.tid == 0) { int t = 0; for (int e = 0; e < NE; ++e) { const int nt = (cntl[e] + 255) >> 8; for (int r = 0; r < nt && t < MAXT; ++r) tab[t++] = e | (r << 8); } ntl[0] = t; }
    __syncthreads();
    return ntl[0];
}

__device__ __forceinline__ void p8_combine(Frame& F) {
    const int gw = F.vcu * NWAVES + F.wave, NGW = F.G * NWAVES;
    for (int t0 = gw; t0 < NR; t0 += 2 * NGW) {
        f32x4 h[2][4]; u32x2 a[2][4], b[2][4];
#pragma unroll
        for (int u = 0; u < 2; ++u) { const int t = (t0 + u * NGW < NR) ? t0 + u * NGW : t0;
            const float* op = F.out + (size_t)t * DM + 4 * F.lane; const bf16_t* y0 = F.YB + (size_t)(2 * t) * DM + 4 * F.lane;
#pragma unroll
            for (int j = 0; j < 4; ++j) { h[u][j] = *(const f32x4*)(op + 256 * j); a[u][j] = *(const u32x2*)(y0 + 256 * j); b[u][j] = *(const u32x2*)(y0 + DM + 256 * j); } }
#pragma unroll
        for (int u = 0; u < 2; ++u) if (t0 + u * NGW < NR) { float* op = F.out + (size_t)(t0 + u * NGW) * DM + 4 * F.lane;
#pragma unroll
            for (int j = 0; j < 4; ++j) { f32x4 o = h[u][j];
                o[0] += bf_lo(a[u][j].x) + bf_lo(b[u][j].x); o[1] += bf_hi(a[u][j].x) + bf_hi(b[u][j].x); o[2] += bf_lo(a[u][j].y) + bf_lo(b[u][j].y); o[3] += bf_hi(a[u][j].y) + bf_hi(b[u][j].y);
                *(f32x4*)(op + 256 * j) = o; } }
    }
}

struct Args { const float* in[24]; float* out; unsigned char* ws; int ph_lo, ph_hi; };
static_assert(sizeof(Args) == 24 * 8 + 8 + 8 + 8, "Args has no padding");

__global__ void __launch_bounds__(NWAVES * 64, 2) fwd_kernel(Args args) {
    extern __shared__ __attribute__((aligned(16))) unsigned char lds[];
    Frame F;
    F.lds = (LAS unsigned char*)lds;
    F.MISC = (volatile LAS unsigned*)(F.lds + MISC_OFF);
    F.tid = threadIdx.x; F.lane = F.tid & 63; F.wave = __builtin_amdgcn_readfirstlane(F.tid >> 6);
    F.G = gridDim.x; { const int bx = blockIdx.x; F.vcu = (F.G % 8 == 0) ? (bx % 8) * (F.G / 8) + bx / 8 : bx; }
    unsigned char* ws = args.ws;
    F.ctl = (unsigned*)(ws + WS_CTL);
    F.x = args.in[0]; F.meta = args.in[1]; F.norm1_g = args.in[2]; F.w_in = args.in[3]; F.b_in = args.in[4]; F.dw_w = args.in[5]; F.dw_b = args.in[6];
    F.ln_g = args.in[7]; F.ln_b = args.in[8]; F.w_conv_out = args.in[9]; F.b_conv_out = args.in[10]; F.q_norm_g = args.in[11]; F.k_norm_g = args.in[12];
    F.b_forget = args.in[13]; F.w_attn_out = args.in[14]; F.w_out = args.in[15]; F.norm2_g = args.in[16]; F.w_group = args.in[17]; F.b_group = args.in[18];
    F.w_router = args.in[19]; F.b_router = args.in[20]; F.w_gate = args.in[21]; F.w_up = args.in[22]; F.w_down = args.in[23];
    F.out = args.out;
    F.BIAS1 = (float*)(ws + WS_BIAS1); F.WRH = (bf16_t*)(ws + WS_WR); F.WRL = (bf16_t*)(ws + WS_WR + 160 * 1024); F.RS = (float*)(ws + WS_RS); F.CB = (float*)(ws + WS_CB); F.LOGF = (float*)(ws + WS_LOGF);
    F.WL = (float*)(ws + WS_WL); F.TOK = (int*)(ws + WS_TOK);
    F.W1T = (bf16_t*)(ws + WS_W1T); F.WCT = (bf16_t*)(ws + WS_WCT); F.WAT = (bf16_t*)(ws + WS_WAT); F.WOT = (bf16_t*)(ws + WS_WOT); F.WGU = (bf16_t*)(ws + WS_WGU); F.WD = (bf16_t*)(ws + WS_WD);
    F.XN = (bf16_t*)(ws + WS_XN); F.MERGED = (bf16_t*)(ws + WS_XN); F.ABUF = (bf16_t*)(ws + WS_ABUF); F.CACT = (bf16_t*)(ws + WS_CACT); F.HN = (bf16_t*)(ws + WS_O);
    F.QO = (bf16_t*)(ws + WS_QO); F.KX = (bf16_t*)(ws + WS_KX); F.VX = (bf16_t*)(ws + WS_VX); F.HB = (bf16_t*)(ws + WS_QO); F.SG = (bf16_t*)args.out; F.YB = (bf16_t*)(ws + WS_XN); F.OB = (bf16_t*)(ws + WS_O);
    for (int u = F.tid; u < (LDS_BYTES - LDSCTL_OFF) / 4; u += NWAVES * 64) ((LAS unsigned*)(F.lds + LDSCTL_OFF))[u] = 0u;
    __syncthreads();
    XcdBarrier bar; bar.bar = F.ctl + CW_BAR; bar.x = 0; bar.st = nullptr;
    if (MK_N_LAUNCHES == 1) bar = xcd_barrier_post(F.ctl + CW_BAR, F.MISC + 8);
#define GRID_BAR() do { if (MK_N_LAUNCHES == 1) xcd_barrier(bar); } while (0)
    const int lo = args.ph_lo, hi = args.ph_hi;
#ifndef P1_ALIGN
#define P1_ALIGN true
#endif
#ifndef PHASE_MASK
#define PHASE_MASK 0x1ff
#endif
#define IN(k) (((PHASE_MASK >> (k)) & 1) && lo <= (k) && (k) < hi)
#define BOTH(k) (IN(k) && IN((k) + 1))
    if (IN(0)) { p0_prologue(F); if (BOTH(0)) GRID_BAR();
    }

    if (IN(1)) {
        if (F.wave == 0) for (int bh = F.G - 1 - (int)blockIdx.x; bh < 64; bh += F.G) scan_bh(F, bh);
        SchedPlain S; S.so.init(NRX / 256, N1 / 256, F.G, (int)blockIdx.x); S.A = (const char*)F.XN; S.B = (const char*)F.W1T; S.K = 1024;
        Epi1 E{F.BIAS1, F.q_norm_g, F.k_norm_g, F.ABUF, F.QO, F.KX, F.VX, F.SG};
        pg8::gemm_phase<Epi1, SchedPlain, P1_ALIGN>(F.lds, 1024, S, E);
#ifndef CVT_EARLY_N
#define CVT_EARLY_N 8000
#endif
        { const int nfull = (NRX / 256) * (N1 / 256) - 4 * F.G;
          if (F.G == 256 && (int)blockIdx.x >= nfull) convert_experts(F, 0, CVT_EARLY_N, ((int)blockIdx.x - nfull) * NWAVES + F.wave, (F.G - nfull) * NWAVES); }
        if (BOTH(1)) GRID_BAR();
    }

    if (IN(2)) {
        for (int v = F.vcu; v < 256; v += F.G) { const int bh = v >> 2, s = v & 3;
            attn_body::attn_unit<8>(bh >> 3, bh & 7, s, (const attn_body::bf16*)F.QO, (const attn_body::bf16*)F.KX, (const attn_body::bf16*)F.VX, (attn_body::bf16*)F.OB, F.CB, (char*)lds);
            attn_body::attn_unit<8>(bh >> 3, bh & 7, 7 - s, (const attn_body::bf16*)F.QO, (const attn_body::bf16*)F.KX, (const attn_body::bf16*)F.VX, (attn_body::bf16*)F.OB, F.CB, (char*)lds); }
        __syncthreads();
        for (int u = (int)blockIdx.x; u < NB * 64; u += F.G) conv_unit(F, u >> 6, u & 63);
        __syncthreads();
        if (BOTH(2)) GRID_BAR();
    }

    if (IN(3)) {
        SchedDual S; S.so.init(NR / 256, 4, F.G, (int)blockIdx.x); S.A0 = (const char*)F.CACT; S.B0 = (const char*)F.WCT; S.A1 = (const char*)F.OB; S.B1 = (const char*)F.WAT; S.K = 512;
        Epi3 E{F.b_conv_out, F.SG, F.MERGED};
        pg8::gemm_phase<Epi3, SchedDual, true>(F.lds, 512, S, E);
        if (BOTH(3)) GRID_BAR();
    }

    if (IN(4)) {
        SchedPlain S; S.so.init(NR / 256, 4, F.G, (int)blockIdx.x); S.A = (const char*)F.MERGED; S.B = (const char*)F.WOT; S.K = 1024;
        Epi4 E{F.x, F.out};
        pg8::gemm_phase<Epi4, SchedPlain, true>(F.lds, 1024, S, E);
        if (BOTH(4)) GRID_BAR();
    }

    if (IN(5)) {
        if (F.wave >= RT_WAVES) convert_experts(F, F.G == 256 ? CVT_EARLY_N : 0, CVT_GU + CVT_D, F.vcu * (NWAVES - RT_WAVES) + (F.wave - RT_WAVES), F.G * (NWAVES - RT_WAVES)); else p5_router(F);
        if (BOTH(5)) GRID_BAR(); }

    if (IN(6)) {
        const int nt = moe_table(F);
        const LAS int* cntl = (const LAS int*)(F.lds + TAB_OFF);
        const int U6 = 2 * nt, G = F.G, c = F.vcu;
        const bool overlap = U6 > G && U6 <= 2 * G && (G & 7) == 0;
        int K7 = 256; asm volatile("" : "+s"(K7));
        Epi6 E6{cntl, F.TOK, F.RS, F.HB}; Epi7 E7{cntl, F.TOK, F.WL, F.YB};
        { SchedMoe S{0, overlap ? G : U6, G, c, 1, cntl + 64, cntl, (const char*)F.HN, (const char*)F.WGU, F.TOK, 1024, 512, true};
          pg8::gemm_phase<Epi6, SchedMoe, true, true>(F.lds, 1024, S, E6);
        }
        GRID_BAR();
        const int cpx = G / 8, xq = c / cpx, jq = c % cpx;
        if (overlap) {
            const int nP = U6 - G, shareP = (nP + 7) / 8; int before = 0, mine = 0;
            for (int x2 = 0; x2 < 8; ++x2) { int n2 = nP - x2 * shareP; n2 = n2 < 0 ? 0 : (n2 > shareP ? shareP : n2); if (x2 < xq) before += n2; if (x2 == xq) mine = n2; }
            if (jq < mine) { SchedMoe S{G, U6, 1 << 28, xq * shareP + jq, 1, cntl + 64, cntl, (const char*)F.HN, (const char*)F.WGU, F.TOK, 1024, 512, true};
                pg8::gemm_phase<Epi6, SchedMoe, true, true>(F.lds, 1024, S, E6); }
            else { SchedMoe S{0, 2 * G, 2 * G - U6, c - before - mine, 2, cntl + 64, cntl, (const char*)F.HB, (const char*)F.WD, F.TOK, K7, 1024, false};
                pg8::gemm_phase<Epi7, SchedMoe, true>(F.lds, K7, S, E7); }
            GRID_BAR();
        }
        { const int c0 = overlap ? 2 * G : 0, nC = 4 * nt - c0, shareC = (nC + 7) / 8;
          const bool spread = overlap && nC <= G && shareC <= cpx;
          SchedMoe S{c0, 4 * nt, spread ? (1 << 28) : G, spread ? (jq < shareC ? xq * shareC + jq : (1 << 28)) : c, 2, cntl + 64, cntl, (const char*)F.HB, (const char*)F.WD, F.TOK, K7, 1024, false};
          pg8::gemm_phase<Epi7, SchedMoe, true>(F.lds, K7, S, E7);
        }
        GRID_BAR();
    }
    if (IN(8)) {
        p8_combine(F); }
#undef IN
#undef BOTH
}


extern "C" void kernel_launch(void* const* d_in, const int* in_sizes, int n_in, void* d_out, int out_size, void* d_ws, size_t ws_size, hipStream_t stream) {
    static int grid = 0;
    if (grid == 0) {
        if (n_in != 24 || in_sizes[0] != NR * DM || out_size != NR * DM || ws_size < WS_END) {
            fprintf(stderr, "kernel_launch: unexpected shapes (n_in %d, in0 %d, out %d, ws %zu); nothing launched\n", n_in, n_in > 0 ? in_sizes[0] : -1, out_size, ws_size); grid = -1; return; }
        int dev = 0, cus = 0, per_cu = 0;
        if (hipGetDevice(&dev) != hipSuccess || hipDeviceGetAttribute(&cus, hipDeviceAttributeMultiprocessorCount, dev) != hipSuccess) { grid = -1; return; }
        if (hipFuncSetAttribute((const void*)fwd_kernel, hipFuncAttributeMaxDynamicSharedMemorySize, LDS_BYTES) != hipSuccess) { fprintf(stderr, "kernel_launch: hipFuncSetAttribute failed\n"); grid = -1; return; }
        if (hipOccupancyMaxActiveBlocksPerMultiprocessor(&per_cu, (const void*)fwd_kernel, NWAVES * 64, LDS_BYTES) != hipSuccess || per_cu < 1) { fprintf(stderr, "kernel_launch: occupancy query reports %d blocks per CU\n", per_cu); (void)hipGetLastError(); grid = -1; return; }
        grid = cus;
    }
    if (grid < 0) return;
    if (hipMemsetAsync((char*)d_ws + WS_CTL, 0, CTL_ZERO_BYTES, stream) != hipSuccess) return;
    Args a{};
    for (int i = 0; i < 24; ++i) a.in[i] = (const float*)d_in[i];
    a.out = (float*)d_out; a.ws = (unsigned char*)d_ws;
    if (MK_N_LAUNCHES == 1) { a.ph_lo = 0; a.ph_hi = N_PHASES; hipLaunchKernelGGL(fwd_kernel, dim3(grid), dim3(NWAVES * 64), LDS_BYTES, stream, a); }
    else for (int p = 0; p < N_PHASES; ++p) { a.ph_lo = p; a.ph_hi = p + 1; hipLaunchKernelGGL(fwd_kernel, dim3(grid), dim3(NWAVES * 64), LDS_BYTES, stream, a); }
}
```

```cpp
#include <hip/hip_runtime.h>
#include <hip/hip_bf16.h>
#include <cstdio>
#include <cstdint>
#include <cmath>

#define GAS __attribute__((address_space(1)))
#define LAS __attribute__((address_space(3)))
typedef unsigned short bf16_t;
typedef short bf16x8 __attribute__((ext_vector_type(8)));
typedef float f32x4 __attribute__((ext_vector_type(4)));
typedef float f32x2 __attribute__((ext_vector_type(2)));
typedef unsigned u32x4 __attribute__((ext_vector_type(4)));
typedef unsigned u32x2 __attribute__((ext_vector_type(2)));

__device__ __forceinline__ unsigned cvt_pk_bf16(float lo, float hi) { unsigned r; asm volatile("v_cvt_pk_bf16_f32 %0, %1, %2" : "=v"(r) : "v"(lo), "v"(hi)); return r; }
__device__ __forceinline__ float bf_lo(unsigned w) { return __uint_as_float(w << 16); }
__device__ __forceinline__ float bf_hi(unsigned w) { return __uint_as_float(w & 0xffff0000u); }
__device__ __forceinline__ float bf2f(bf16_t b) { return __uint_as_float((unsigned)b << 16); }
__device__ __forceinline__ float sigmoidf_(float x) { return __builtin_amdgcn_rcpf(1.0f + __builtin_amdgcn_exp2f(-1.4426950408889634f * x)); }

namespace pg8 {
constexpr int BM = 256, BK = 64, HALF = 128, HTB = HALF * BK * 2  , STAGE_BYTES = 8 * HTB;

__host__ __device__ __forceinline__ int lds_byte(int r, int c) { const int st = (r >> 4) * 2 + (c >> 5), rr = r & 15, cc = c & 31, ob = rr * 64 + cc * 2; return st * 1024 + (ob ^ (((ob >> 9) & 1) << 5)); }
__host__ __device__ __forceinline__ void stage_rc(int b, int& R, int& C) { const int st = b / 1024, sb = b % 1024, swz = sb ^ (((sb >> 9) & 1) << 5); R = (st >> 1) * 16 + swz / 64; C = (st & 1) * 32 + (swz % 64) / 2; }
__host__ __device__ __forceinline__ int perm32(int rho) { const int n = rho >> 4, i = rho & 15; return 8 * (i >> 2) + 4 * n + (i & 3); }

struct Unit { int pm, pn, e; };

template <class Epi, class Sched, bool ALIGN_EPI, bool GATHER = false, bool PARTIAL = false>
__device__ __forceinline__ void gemm_phase(LAS unsigned char* lds, const int K, const Sched& S, Epi& E) {
    int tid = threadIdx.x; asm volatile("" : "+v"(tid));
    const int wid = __builtin_amdgcn_readfirstlane(tid >> 6), lane = tid & 63, wr = wid >> 2, wc = wid & 3, fr = lane & 15, fq = lane >> 4;
    const int nt = K / BK;
    int Rr[2], Cc[2]; unsigned voffB[2], voffA[2];
#pragma unroll
    for (int i = 0; i < 2; ++i) { stage_rc(tid * 16 + i * 8192, Rr[i], Cc[i]); const int Rb = Epi::PERM ? ((Rr[i] & ~31) + perm32(Rr[i] & 31)) : Rr[i]; voffB[i] = (unsigned)(Rb * K + Cc[i]) * 2u; voffA[i] = (unsigned)(Rr[i] * K + Cc[i]) * 2u; }
    const size_t kstep = (size_t)(BK * 2);
    const size_t hstep = (size_t)HALF * K * 2;
    const unsigned ldsw = (unsigned)wid * 1024u;
    const int aoff = lds_byte(wr * 64 + fr, fq * 8), boff = lds_byte(wc * 32 + fr, fq * 8);
#define PG8_SA(b, h) (((b) * 2 + (h)) * HTB)
#define PG8_SB(b, h) ((4 + (b) * 2 + (h)) * HTB)
#define PG8_STAGE(bufoff, gbase, voff) do { _Pragma("unroll") for (int _i = 0; _i < 2; ++_i) \
        __builtin_amdgcn_global_load_lds((const unsigned*)((const char*)(gbase) + (voff)[_i]), (LAS unsigned*)(lds + (bufoff) + ldsw + _i * 8192), 16, 0, 0); } while (0)
#define PG8_STAGE_A(bufoff, gbase, h, OFFS) do { _Pragma("unroll") for (int _i = 0; _i < 2; ++_i) { \
        const char* _src; if constexpr (GATHER) _src = (const char*)(gbase) + (OFFS)[h][_i]; else _src = (const char*)(gbase) + (size_t)(h) * hstep + voffA[_i]; \
        __builtin_amdgcn_global_load_lds((const unsigned*)_src, (LAS unsigned*)(lds + (bufoff) + ldsw + _i * 8192), 16, 0, 0); } } while (0)
#define PG8_LDA(dst, b, h) do { _Pragma("unroll") for (int m = 0; m < 4; ++m) _Pragma("unroll") for (int k = 0; k < 2; ++k) dst[m][k] = *(const LAS bf16x8*)(lds + PG8_SA(b, h) + aoff + m * 2048 + k * 1024); } while (0)
#define PG8_LDB(dst, b, h) do { _Pragma("unroll") for (int n = 0; n < 2; ++n) _Pragma("unroll") for (int k = 0; k < 2; ++k) dst[n][k] = *(const LAS bf16x8*)(lds + PG8_SB(b, h) + boff + n * 2048 + k * 1024); } while (0)
#define PG8_MMA(ai, bj, At, Bt) do { __builtin_amdgcn_s_setprio(1); _Pragma("unroll") for (int m = 0; m < 4; ++m) _Pragma("unroll") for (int n = 0; n < 2; ++n) _Pragma("unroll") for (int k = 0; k < 2; ++k) \
        acc[ai][bj][m][n] = __builtin_amdgcn_mfma_f32_16x16x32_bf16(Bt[n][k], At[m][k], acc[ai][bj][m][n], 0, 0, 0); __builtin_amdgcn_s_setprio(0); } while (0)
#define PG8_WAIT_V(n) asm volatile("s_waitcnt vmcnt(" #n ")" ::: "memory")
#define PG8_WAIT_L(n) asm volatile("s_waitcnt lgkmcnt(" #n ")" ::: "memory")
#define PG8_BAR __builtin_amdgcn_s_barrier()
#define PG8_SCHED __builtin_amdgcn_sched_barrier(0)
#define PG8_MMA0(ai, bj, At, Bt) do { __builtin_amdgcn_s_setprio(1); _Pragma("unroll") for (int m = 0; m < 4; ++m) _Pragma("unroll") for (int n = 0; n < 2; ++n) { \
        acc[ai][bj][m][n] = __builtin_amdgcn_mfma_f32_16x16x32_bf16(Bt[n][0], At[m][0], (f32x4){0.f, 0.f, 0.f, 0.f}, 0, 0, 0); \
        acc[ai][bj][m][n] = __builtin_amdgcn_mfma_f32_16x16x32_bf16(Bt[n][1], At[m][1], acc[ai][bj][m][n], 0, 0, 0); } __builtin_amdgcn_s_setprio(0); } while (0)
#define PG8_ITER(MMA_A) do { \
            const bool last = (t == nt - 2); \
            const char* a1 = cA + (size_t)(t + 1) * kstep; \
            const char* a2 = last ? nA : cA + (size_t)(t + 2) * kstep; const char* b2 = last ? nB : cB + (size_t)(t + 2) * kstep; \
            const char* a3 = a2 + kstep; const char* b3 = b2 + kstep; \
            unsigned xo[2][2]; \
            if constexpr (GATHER) { \
_Pragma("unroll") \
                for (int h = 0; h < 2; ++h) \
_Pragma("unroll") \
                    for (int i = 0; i < 2; ++i) xo[h][i] = last ? nao[h][i] : ao[h][i]; \
            } \
            PG8_LDB(B0, 0, 0); PG8_LDB(B1, 0, 1); PG8_SCHED; PG8_LDA(At, 0, 0); PG8_STAGE_A(PG8_SA(1, 1), a1, 1, ao); \
            PG8_WAIT_V(8); PG8_WAIT_L(0); PG8_BAR; if (MMA_A && t == 0) { PG8_MMA0(0, 0, At, B0); PG8_MMA0(0, 1, At, B1); } else { PG8_MMA(0, 0, At, B0); PG8_MMA(0, 1, At, B1); } PG8_BAR; PG8_SCHED; \
            PG8_LDA(At, 0, 1); PG8_STAGE(PG8_SB(0, 0), b2, voffB); PG8_STAGE(PG8_SB(0, 1), b2 + hstep, voffB); PG8_STAGE_A(PG8_SA(0, 0), a2, 0, xo); \
            if (last && has_next) S.lists(nxt, lds, wid, lane); \
            PG8_WAIT_V(8); PG8_WAIT_L(0); PG8_BAR; if (MMA_A && t == 0) { PG8_MMA0(1, 0, At, B0); PG8_MMA0(1, 1, At, B1); } else { PG8_MMA(1, 0, At, B0); PG8_MMA(1, 1, At, B1); } PG8_BAR; PG8_SCHED; \
            PG8_LDB(B0, 1, 0); PG8_LDB(B1, 1, 1); PG8_SCHED; PG8_LDA(At, 1, 0); PG8_STAGE_A(PG8_SA(0, 1), a2, 1, xo); \
            PG8_WAIT_V(8); PG8_WAIT_L(0); PG8_BAR; PG8_MMA(0, 0, At, B0); PG8_MMA(0, 1, At, B1); PG8_BAR; PG8_SCHED; \
            PG8_LDA(At, 1, 1); PG8_STAGE(PG8_SB(1, 0), b3, voffB); PG8_STAGE(PG8_SB(1, 1), b3 + hstep, voffB); PG8_STAGE_A(PG8_SA(1, 0), a3, 0, xo); \
            PG8_WAIT_V(8); PG8_WAIT_L(0); PG8_BAR; PG8_MMA(1, 0, At, B0); PG8_MMA(1, 1, At, B1); PG8_BAR; PG8_SCHED; \
        } while (0)
    Unit cur, nxt; int ui = 0;
    if (!S.next(0, cur)) return;
    f32x4 acc[2][2][4][2];
    E.init(acc, cur, wc, fq);
    bf16x8 At[4][2], B0[2][2], B1[2][2];
    unsigned ao[2][2], nao[2][2];
    if constexpr (GATHER) S.a_offs(cur, Rr, Cc, ao);
    const char* cA = S.a_base(cur); const char* cB = S.b_base(cur);
    PG8_STAGE(PG8_SB(0, 0), cB, voffB); PG8_STAGE(PG8_SB(0, 1), cB + hstep, voffB); PG8_STAGE_A(PG8_SA(0, 0), cA, 0, ao); PG8_STAGE_A(PG8_SA(0, 1), cA, 1, ao);
    if (wr == 1) PG8_BAR;
    PG8_WAIT_V(2); PG8_BAR;
    PG8_STAGE(PG8_SB(1, 0), cB + kstep, voffB); PG8_STAGE_A(PG8_SA(1, 0), cA + kstep, 0, ao); PG8_STAGE(PG8_SB(1, 1), cB + hstep + kstep, voffB);
    PG8_WAIT_V(6); PG8_BAR;
    S.lists(cur, lds, wid, lane);
    for (;;) {
        const bool has_next = S.next(ui + 1, nxt);
        const char* nA = cA; const char* nB = cB;
        if (has_next) { if constexpr (GATHER) S.a_offs(nxt, Rr, Cc, nao); nA = S.a_base(nxt); nB = S.b_base(nxt); }
        else if constexpr (GATHER) {
#pragma unroll
            for (int h = 0; h < 2; ++h)
#pragma unroll
                for (int i = 0; i < 2; ++i) nao[h][i] = ao[h][i];
        }
        for (int t = 0; t < nt; t += 2) PG8_ITER(Epi::ZERO_C);
        if constexpr (ALIGN_EPI) { if (wr == 0) PG8_BAR; }
        const bool keep = E(acc, cur, wr, wc, fr, fq);
        if (!has_next) break;
        if constexpr (!Epi::ZERO_C) if (!keep) E.init(acc, nxt, wc, fq);
        cur = nxt; cA = nA; cB = nB; ++ui;
        if constexpr (GATHER) {
#pragma unroll
            for (int h = 0; h < 2; ++h)
#pragma unroll
                for (int i = 0; i < 2; ++i) ao[h][i] = nao[h][i];
        }
        if constexpr (ALIGN_EPI) { if (wr == 1) PG8_BAR; }
    }
    PG8_WAIT_V(0);
    if constexpr (!ALIGN_EPI) { if (wr == 0) PG8_BAR; }
    PG8_BAR;
#undef PG8_SA
#undef PG8_SB
#undef PG8_STAGE
#undef PG8_STAGE_A
#undef PG8_LDA
#undef PG8_LDB
#undef PG8_MMA
#undef PG8_MMA0
#undef PG8_ITER
#undef PG8_WAIT_V
#undef PG8_WAIT_L
#undef PG8_BAR
#undef PG8_SCHED
}
}
namespace attn_body {
using bf16=__hip_bfloat16;
using bf16x8=__attribute__((ext_vector_type(8)))short;
using s16x4=__attribute__((ext_vector_type(4)))short;
using f32x16=__attribute__((ext_vector_type(16)))float;
using u32x4=__attribute__((ext_vector_type(4)))unsigned;
constexpr int BATCH=8,NHEAD=8,SEQ=2048,KVROWS=2112,D=64,DM=NHEAD*D;
constexpr int NW=8,QBLK=32,QB=QBLK*NW,KVBLK=64,NQB=SEQ/QB;
constexpr int ATTN_PITCH=DM, ATTN_UNIT_ROWS=QB;
__device__ __forceinline__ int crow(int r,int hi){return (r&3)+8*(r>>2)+4*hi;}
#define SBAR() __builtin_amdgcn_sched_barrier(0)
__device__ __forceinline__ void cmask(f32x16&p0,f32x16&p1,int jb,int qrel,int hi){
  asm volatile("":"+v"(hi),"+v"(qrel));
  const float NEG=-INFINITY; int kb=64*jb+4*hi;
  #pragma unroll
  for(int r=0;r<16;++r){int kv=kb+(r&3)+8*(r>>2); if(kv>qrel)p0[r]=NEG; if(kv+32>qrel)p1[r]=NEG;}
}

constexpr int NSLOT=3, SLOTB=8192;
constexpr int LDS_K=0, LDS_V=NSLOT*SLOTB, LDS_WS=2*NSLOT*SLOTB, LDS_OST=LDS_WS+NW*64*4, LDS_CBT=LDS_OST+NW*4096, LDS_BYTES=LDS_CBT+KVROWS*4;
constexpr float C2=0.125f*1.4426950408889634f;
__device__ __forceinline__ void glds16(const void*gsrc,unsigned lds_dst){unsigned keep;
  asm volatile("s_mov_b32 %0, m0\n\ts_mov_b32 m0, %2\n\ts_nop 0\n\tglobal_load_lds_dwordx4 %1, off\n\ts_mov_b32 m0, %0":"=&s"(keep):"v"(gsrc),"s"(lds_dst):"memory");}
__device__ __forceinline__ float max3f(float a,float b,float c){float r;asm("v_max3_f32 %0, %1, %2, %3":"=v"(r):"v"(a),"v"(b),"v"(c));return r;}
__device__ __forceinline__ float max2f(float a,float b){float r;asm("v_max_f32_e32 %0, %1, %2":"=v"(r):"v"(a),"v"(b));return r;}
__device__ __forceinline__ float fadd_s(float a,float b){float r;asm("v_add_f32_e32 %0, %1, %2":"=v"(r):"v"(a),"v"(b));return r;}
__device__ __forceinline__ float fsub_s(float a,float b){float r;asm("v_sub_f32_e32 %0, %1, %2":"=v"(r):"v"(a),"v"(b));return r;}
typedef float f32x2_t __attribute__((ext_vector_type(2))); typedef float f32x4_t __attribute__((ext_vector_type(4))); typedef __bf16 bf16x2_t __attribute__((ext_vector_type(2)));
__device__ __forceinline__ unsigned cvtpk_s(float lo,float hi){f32x2_t v={lo,hi};bf16x2_t b=__builtin_convertvector(v,bf16x2_t);return __builtin_bit_cast(unsigned,b);}
#define WAIT_BAR(N) asm volatile("s_waitcnt vmcnt(" #N ") lgkmcnt(0)\n\ts_barrier":::"memory")

__device__ __forceinline__ void qkt(f32x16&p0,f32x16&p1,const char*Kslot,const bf16x8*qr,const f32x16&negm,int r32,int hi){
  const char*kb=Kslot+hi*1024+r32*16;
  #pragma unroll
  for(int d0=0;d0<4;++d0){
    const bf16x8 b0=*reinterpret_cast<const bf16x8*>(kb+d0*2048);
    const bf16x8 b1=*reinterpret_cast<const bf16x8*>(kb+d0*2048+512);
    if(d0==0){p0=__builtin_amdgcn_mfma_f32_32x32x16_bf16(b0,qr[0],negm,0,0,0);p1=__builtin_amdgcn_mfma_f32_32x32x16_bf16(b1,qr[0],negm,0,0,0);}
    else{p0=__builtin_amdgcn_mfma_f32_32x32x16_bf16(b0,qr[d0],p0,0,0,0);p1=__builtin_amdgcn_mfma_f32_32x32x16_bf16(b1,qr[d0],p1,0,0,0);}}
}
typedef __attribute__((address_space(3))) const char* lds_cptr;
typedef short v4i16_t __attribute__((ext_vector_type(4)));
__device__ __forceinline__ void kload8(bf16x8*kf,lds_cptr kp){
  kf[0]=*(const __attribute__((address_space(3))) bf16x8*)(kp);      kf[1]=*(const __attribute__((address_space(3))) bf16x8*)(kp+512);
  kf[2]=*(const __attribute__((address_space(3))) bf16x8*)(kp+2048); kf[3]=*(const __attribute__((address_space(3))) bf16x8*)(kp+2560);
  kf[4]=*(const __attribute__((address_space(3))) bf16x8*)(kp+4096); kf[5]=*(const __attribute__((address_space(3))) bf16x8*)(kp+4608);
  kf[6]=*(const __attribute__((address_space(3))) bf16x8*)(kp+6144); kf[7]=*(const __attribute__((address_space(3))) bf16x8*)(kp+6656);
}
__device__ __forceinline__ void kload2(bf16x8*kf,lds_cptr kp,int j){ kf[2*j]=*(const __attribute__((address_space(3))) bf16x8*)(kp+j*2048); kf[2*j+1]=*(const __attribute__((address_space(3))) bf16x8*)(kp+j*2048+512); }
__device__ __forceinline__ s16x4 vtr(lds_cptr p){ return __builtin_bit_cast(s16x4,__builtin_amdgcn_ds_read_tr16_b64_v4i16((__attribute__((address_space(3))) v4i16_t*)p)); }
__device__ __forceinline__ float rowmax(const f32x16&p0,const f32x16&p1){
  float a=max3f(p0[0],p0[1],p1[0]),b=max3f(p0[2],p0[3],p1[1]);a=max3f(a,p1[2],p1[3]);
  #pragma unroll
  for(int r=4;r<16;r+=4){a=max3f(a,p0[r],p0[r+1]);b=max3f(b,p0[r+2],p0[r+3]);a=max3f(a,p1[r],p1[r+1]);b=max3f(b,p1[r+2],p1[r+3]);}
  const float m=max2f(a,b);
  auto rr=__builtin_amdgcn_permlane32_swap(__float_as_uint(m),__float_as_uint(m),false,false);
  return max2f(__uint_as_float(rr[0]),__uint_as_float(rr[1]));
}
__device__ __forceinline__ void pv(f32x16*o,int vb,bf16x8 pa0,bf16x8 pa1,bf16x8 pa2,bf16x8 pa3){
  #pragma unroll
  for(int d0=0;d0<2;++d0){s16x4 lo[4],hi[4];
    #pragma unroll
    for(int ks=0;ks<4;++ks){
      asm volatile("ds_read_b64_tr_b16 %0,%1 offset:%c2":"=&v"(lo[ks]):"v"(vb),"i"(d0*4096+ks*1024):"memory");
      asm volatile("ds_read_b64_tr_b16 %0,%1 offset:%c2":"=&v"(hi[ks]):"v"(vb),"i"(d0*4096+ks*1024+512):"memory");}
    asm volatile("s_waitcnt lgkmcnt(0)":::"memory");SBAR();
    #define PK(k) (bf16x8){lo[k][0],lo[k][1],lo[k][2],lo[k][3],hi[k][0],hi[k][1],hi[k][2],hi[k][3]}
    o[d0]=__builtin_amdgcn_mfma_f32_32x32x16_bf16(pa0,PK(0),o[d0],0,0,0);
    o[d0]=__builtin_amdgcn_mfma_f32_32x32x16_bf16(pa1,PK(1),o[d0],0,0,0);
    o[d0]=__builtin_amdgcn_mfma_f32_32x32x16_bf16(pa2,PK(2),o[d0],0,0,0);
    o[d0]=__builtin_amdgcn_mfma_f32_32x32x16_bf16(pa3,PK(3),o[d0],0,0,0);
    #undef PK
  }
}

#ifndef ATTN_STORE16
#define ATTN_STORE16(p,v) (*(u32x4*)(p)=(v))
#endif
template<int THRL> __device__ __forceinline__ void attn_unit(int b,int h,int qb,const bf16*Q,const bf16*__restrict__ K,const bf16*__restrict__ V,bf16*O,const float*__restrict__ CB,char*shm){
  const int tid=threadIdx.x,lane=tid&63,r32=lane&31,hi=lane>>5; const int wid=__builtin_amdgcn_readfirstlane(tid>>6);
  const long rowbase=(long)b*SEQ, kvbase=(long)b*KVROWS; const int q0=qb*QB;
  const bf16*Qw=Q+(rowbase+q0+wid*QBLK)*DM+h*D;
  const bf16*Kh=K+kvbase*DM+h*D,*Vh=V+kvbase*DM+h*D;
  const unsigned lds0=(unsigned)(uintptr_t)shm;
  float*wsf=(float*)(shm+LDS_WS)+wid*64;
  const bf16*ksrc=Kh+(long)lane*DM+wid*8;
  const bf16*vsrc=Vh+(long)(16*(wid&3)+(lane>>2))*DM+(wid>>2)*32+(lane&3)*8;
  const unsigned kdst=lds0+LDS_K+wid*1024, vdst=lds0+LDS_V+wid*1024;
  #define DMA_K(t,slot) glds16(ksrc+(long)(t)*KVBLK*DM,(unsigned)__builtin_amdgcn_readfirstlane(kdst+(slot)))
  #define DMA_V(t,slot) glds16(vsrc+(long)(t)*KVBLK*DM,(unsigned)__builtin_amdgcn_readfirstlane(vdst+(slot)))
  const int vb0=(int)(lds0+LDS_V)+((lane>>4)&1)*32+(lane&3)*8+(4*hi+((lane&15)>>2))*64;
  const char*Kbase=shm+LDS_K; bf16x8 kf[8];
  const lds_cptr shm3=(lds_cptr)shm; const lds_cptr kp0=shm3+LDS_K+hi*1024+r32*16; const lds_cptr vp0=shm3+LDS_V+((lane>>4)&1)*32+(lane&3)*8+(4*hi+((lane&15)>>2))*64;
  const int NT=(q0+QB)/KVBLK+1;
  typedef __attribute__((address_space(3))) float* lds_fptr; const lds_fptr cbt=(lds_fptr)(shm+LDS_CBT);
  { const float*cbg=CB+(long)(b*NHEAD+h)*KVROWS; const float ref=cbg[64+q0]; for(int i=tid;i<NT*KVBLK;i+=NW*64)cbt[i]=cbg[i]-ref; }
  DMA_K(0,0);DMA_V(0,0);DMA_K(1,SLOTB);
  bf16x8 qr[4];
  #pragma unroll
  for(int d0=0;d0<4;++d0)qr[d0]=*reinterpret_cast<const bf16x8*>(&Qw[(long)r32*DM+d0*16+hi*8]);
  float mhat=0.f,l_reg=0.f;f32x16 o[2];o[0]=f32x16{};o[1]=f32x16{};const f32x16 zero16=f32x16{}; f32x16 negm=f32x16{};
  const int qrel=wid*QBLK+r32;
  #define CMASK(P0,P1,t) do{int jb_=(t)-(NT-4); if(jb_>=0)cmask(P0,P1,jb_,qrel,hi);}while(0)
  typedef __attribute__((address_space(3))) const f32x4_t* lds_f4ptr;
  #define BIAS(P0,P1,t) do{ const lds_f4ptr bp_=(lds_f4ptr)(cbt+64*(t)+4*hi); \
    _Pragma("unroll") for(int g_=0;g_<4;++g_){ const f32x4_t b0_=bp_[2*g_], b1_=bp_[8+2*g_]; \
      _Pragma("unroll") for(int j_=0;j_<4;++j_){ P0[4*g_+j_]+=b0_[j_]; P1[4*g_+j_]+=b1_[j_]; } } }while(0)
  bool resc=false;
  #define START(P0,P1) do{ const float rm=rowmax(P0,P1); resc=false; \
    { const float dl=__builtin_fmaxf(rm,0.f); mhat=fadd_s(mhat,dl); _Pragma("unroll") for(int r=0;r<16;++r)negm[r]=-mhat; asm volatile("":"+v"(negm)); \
      _Pragma("unroll") for(int r=0;r<16;++r){P0[r]=fsub_s(P0[r],dl);P1[r]=fsub_s(P1[r],dl);} \
      } \
    _Pragma("unroll") for(int r=0;r<16;++r)P0[r]=__builtin_amdgcn_exp2f(P0[r]); }while(0)
  #define RESC() do{ if(resc){ asm volatile("s_waitcnt lgkmcnt(0)":::"memory"); \
      _Pragma("unroll") for(int d_=0;d_<2;++d_) _Pragma("unroll") for(int r=0;r<16;++r)o[d_][r]*=wsf[crow(r,hi)]; } }while(0)
  f32x16 pA0,pA1,pB0,pB1;
  int sl_prev=0,sl_cur=0,sl_next=SLOTB;
  #define ROT() do{sl_prev=sl_cur;sl_cur=sl_next;sl_next=(sl_next==(NSLOT-1)*SLOTB)?0:sl_next+SLOTB;}while(0)
  DMA_K(2,2*SLOTB);
  WAIT_BAR(3);
  mhat=cbt[64+q0+qrel]+14.0f; _Pragma("unroll") for(int r=0;r<16;++r)negm[r]=-mhat; asm volatile("":"+v"(negm));
  qkt(pA0,pA1,Kbase,qr,negm,r32,hi);asm volatile("s_nop 15\n\ts_nop 7":"+v"(pA0),"+v"(pA1));BIAS(pA0,pA1,0);CMASK(pA0,pA1,0);
  START(pA0,pA1);
  _Pragma("unroll") for(int r=0;r<16;++r)pA1[r]=__builtin_amdgcn_exp2f(pA1[r]);
  WAIT_BAR(0);
  DMA_K(3,0);DMA_V(1,SLOTB);
  ROT();
  kload8(kf,kp0+sl_cur);
  WAIT_BAR(2);
  s16x4 vlo[8],vhi[8]; u32x4 pw0,pw1,pw2,pw3;
  #define PKW(P,B) cvtpk_s(P[B],P[B+1])
  #define PAF(k) __builtin_bit_cast(bf16x8,pw##k)
  #define VFR(i) (bf16x8){vlo[i][0],vlo[i][1],vlo[i][2],vlo[i][3],vhi[i][0],vhi[i][1],vhi[i][2],vhi[i][3]}
  #define PIN(x) asm volatile("":"+v"(x))
  #define MX3(a,b,c) __builtin_fmaxf(__builtin_fmaxf((a),(b)),(c))
  #define GAPA(MF,A0,A1,A2,A3,W0,W1,PW) do{ MF; sacc+=A0; sacc+=A1; sacc+=A2; sacc+=A3; PIN(sacc); W0; W1; PIN(PW); SBAR(); }while(0)
  #define EX(v) __builtin_amdgcn_exp2f(v)
  #define GAPB(MF,X,B) do{ MF; X[B]=EX(X[B]); X[B+1]=EX(X[B+1]); X[B+2]=EX(X[B+2]); X[B+3]=EX(X[B+3]); PIN(X); SBAR(); }while(0)
  #define VRD(i) do{ vlo[i]=vtr(vp_+(((i)>>2)*4096+((i)&3)*1024)); vhi[i]=vtr(vp_+(((i)>>2)*4096+((i)&3)*1024+512)); }while(0)
  #define KRD(G,j) do{ if(G){ kload2(kf,kp0+sl_next,j); SBAR(); } }while(0)
  #define STEP(C0,C1,P0,P1,t,GK,GV,GL) do{ SBAR(); \
    const lds_cptr vp_=vp0+sl_prev; \
    VRD(0); SBAR(); float sacc=(P0[0]+P0[1]); \
    GAPA(C0=__builtin_amdgcn_mfma_f32_32x32x16_bf16(kf[0],qr[0],negm,0,0,0), P0[2],P0[3],P0[4],P0[5],     pw0[0]=PKW(P0,0), pw0[1]=PKW(P0,2), pw0); \
    VRD(4); SBAR(); GAPA(C1=__builtin_amdgcn_mfma_f32_32x32x16_bf16(kf[1],qr[0],negm,0,0,0), P0[6],P0[7],P0[8],P0[9],     pw0[2]=PKW(P0,4), pw0[3]=PKW(P0,6), pw0); \
    VRD(1); SBAR(); GAPA(C0=__builtin_amdgcn_mfma_f32_32x32x16_bf16(kf[2],qr[1],C0,0,0,0),   P0[10],P0[11],P0[12],P0[13], pw1[0]=PKW(P0,8), pw1[1]=PKW(P0,10), pw1); \
    VRD(5); SBAR(); GAPA(C1=__builtin_amdgcn_mfma_f32_32x32x16_bf16(kf[3],qr[1],C1,0,0,0),   P0[14],P0[15],P1[0],P1[1],   pw1[2]=PKW(P0,12),pw1[3]=PKW(P0,14), pw1); \
    VRD(2); SBAR(); GAPA(C0=__builtin_amdgcn_mfma_f32_32x32x16_bf16(kf[4],qr[2],C0,0,0,0),   P1[2],P1[3],P1[4],P1[5],     pw2[0]=PKW(P1,0), pw2[1]=PKW(P1,2), pw2); \
    VRD(6); SBAR(); GAPA(C1=__builtin_amdgcn_mfma_f32_32x32x16_bf16(kf[5],qr[2],C1,0,0,0),   P1[6],P1[7],P1[8],P1[9],     pw2[2]=PKW(P1,4), pw2[3]=PKW(P1,6), pw2); \
    VRD(3); SBAR(); GAPA(C0=__builtin_amdgcn_mfma_f32_32x32x16_bf16(kf[6],qr[3],C0,0,0,0),   P1[10],P1[11],P1[12],P1[13], pw3[0]=PKW(P1,8), pw3[1]=PKW(P1,10), pw3); \
    VRD(7); SBAR(); GAPA(C1=__builtin_amdgcn_mfma_f32_32x32x16_bf16(kf[7],qr[3],C1,0,0,0),   P1[14],P1[15],0.f,0.f,       pw3[2]=PKW(P1,12),pw3[3]=PKW(P1,14), pw3); \
    l_reg+=sacc; \
    if(GK){DMA_K((t)+3,sl_cur);} if(GV){DMA_V((t)+1,sl_next);} \
    BIAS(C0,C1,t); CMASK(C0,C1,t); \
    { float rm=__builtin_fmaxf(__builtin_fmaxf(C0[0],C0[15]),__builtin_fmaxf(C1[0],C1[15]));   \
      resc=false; \
      if(__builtin_expect(__any(rm>(float)THRL),0)){ const float dl=__builtin_fmaxf(rm,0.f); mhat+=dl; _Pragma("unroll") for(int r=0;r<16;++r)negm[r]=-mhat; asm volatile("":"+v"(negm)); \
        _Pragma("unroll") for(int r=0;r<16;++r){C0[r]-=dl;C1[r]-=dl;} \
        const float f=__builtin_amdgcn_exp2f(-dl); l_reg*=f; if(hi==0)wsf[r32]=f; resc=true; } } \
    SBAR(); \
    GAPB(o[0]=__builtin_amdgcn_mfma_f32_32x32x16_bf16(PAF(0),VFR(0),o[0],0,0,0), C0,0); \
    GAPB(o[1]=__builtin_amdgcn_mfma_f32_32x32x16_bf16(PAF(0),VFR(4),o[1],0,0,0), C0,4); \
    KRD(GL,0); GAPB(o[0]=__builtin_amdgcn_mfma_f32_32x32x16_bf16(PAF(1),VFR(1),o[0],0,0,0), C0,8); \
    KRD(GL,1); GAPB(o[1]=__builtin_amdgcn_mfma_f32_32x32x16_bf16(PAF(1),VFR(5),o[1],0,0,0), C0,12); \
    KRD(GL,2); GAPB(o[0]=__builtin_amdgcn_mfma_f32_32x32x16_bf16(PAF(2),VFR(2),o[0],0,0,0), C1,0); \
    KRD(GL,3); GAPB(o[1]=__builtin_amdgcn_mfma_f32_32x32x16_bf16(PAF(2),VFR(6),o[1],0,0,0), C1,4); \
    GAPB(o[0]=__builtin_amdgcn_mfma_f32_32x32x16_bf16(PAF(3),VFR(3),o[0],0,0,0), C1,8); \
    GAPB(o[1]=__builtin_amdgcn_mfma_f32_32x32x16_bf16(PAF(3),VFR(7),o[1],0,0,0), C1,12); \
    }while(0)
  int t=1;
  #undef CMASK
  #define CMASK(P0,P1,t) do{}while(0)
  for(;t+5<NT;t+=2){
    STEP(pB0,pB1,pA0,pA1,t,true,true,true);     WAIT_BAR(2); RESC(); ROT();
    STEP(pA0,pA1,pB0,pB1,t+1,true,true,true);   WAIT_BAR(2); RESC(); ROT();
  }
  #undef CMASK
  #define CMASK(P0,P1,t) do{int jb_=(t)-(NT-4); if(jb_>=0)cmask(P0,P1,jb_,qrel,hi);}while(0)
  #define ENDW(tt) do{ if((tt)+3<NT){WAIT_BAR(2);} else if((tt)+2<NT){WAIT_BAR(1);} else {WAIT_BAR(0);} }while(0)
  for(;t+2<NT;t+=2){
    STEP(pB0,pB1,pA0,pA1,t,(t+3<NT),(t+1<NT),(t+1<NT));       ENDW(t);   RESC(); ROT();
    STEP(pA0,pA1,pB0,pB1,t+1,(t+4<NT),(t+2<NT),(t+2<NT));     ENDW(t+1); RESC(); ROT();
  }
  STEP(pB0,pB1,pA0,pA1,NT-2,false,true,true); ENDW(NT-2); RESC(); ROT();
  STEP(pA0,pA1,pB0,pB1,NT-1,false,false,false); RESC();
  { float sacc=pA0[0]+pA0[1]; _Pragma("unroll") for(int r=2;r<16;++r)sacc+=pA0[r]; _Pragma("unroll") for(int r=0;r<16;++r)sacc+=pA1[r]; l_reg+=sacc;
    pw0=(u32x4){PKW(pA0,0),PKW(pA0,2),PKW(pA0,4),PKW(pA0,6)};pw1=(u32x4){PKW(pA0,8),PKW(pA0,10),PKW(pA0,12),PKW(pA0,14)};pw2=(u32x4){PKW(pA1,0),PKW(pA1,2),PKW(pA1,4),PKW(pA1,6)};pw3=(u32x4){PKW(pA1,8),PKW(pA1,10),PKW(pA1,12),PKW(pA1,14)};
    SBAR(); pv(o,vb0+sl_cur,PAF(0),PAF(1),PAF(2),PAF(3)); }
  #undef PKW
  #undef PAF
  #undef VFR
  #undef PIN
  #undef MX3
  #undef GAPA
  #undef GAPB
  #undef EX
  #undef VRD
  #undef KRD
  #undef STEP
  #undef ENDW
  {auto rr=__builtin_amdgcn_permlane32_swap(__float_as_uint(l_reg),__float_as_uint(l_reg),false,false);l_reg=__uint_as_float(rr[0])+__uint_as_float(rr[1]);}
  if(hi==0)wsf[32+r32]=l_reg;asm volatile("s_waitcnt lgkmcnt(0)":::"memory");
  float rli[16];
  #pragma unroll
  for(int r=0;r<16;++r)rli[r]=__builtin_amdgcn_rcpf(wsf[32+crow(r,hi)]);
  bf16*Ow=O+(rowbase+q0+wid*QBLK)*DM+h*D;
  { bf16*stg=(bf16*)(shm+LDS_OST)+wid*2048;
    #pragma unroll
    for(int r=0;r<16;++r){const int orow=crow(r,hi);
      #pragma unroll
      for(int d0=0;d0<2;++d0)stg[orow*64+d0*32+r32]=__float2bfloat16(o[d0][r]*rli[r]);}
    asm volatile("s_waitcnt lgkmcnt(0)":::"memory");
    #pragma unroll
    for(int i=0;i<4;++i){const int row=i*8+(lane>>3),ch=lane&7; const u32x4 v=*(const u32x4*)(stg+row*64+ch*8); ATTN_STORE16(Ow+(long)row*DM+ch*8,v);} }
  asm volatile("s_waitcnt lgkmcnt(0)\n\ts_barrier":::"memory");
  #undef DMA_K
  #undef DMA_V
  #undef CMASK
  #undef BIAS
  #undef START
  #undef RESC
  #undef ROT
}
constexpr int ATTN_LDS_BYTES=LDS_BYTES;
#undef SBAR
#undef WAIT_BAR
}

constexpr int NWAVES = 8;
#ifndef MK_N_LAUNCHES
#define MK_N_LAUNCHES 1
#endif
constexpr int N_PHASES = 9;
constexpr int DM = 1024, NB = 8, SEQ = 2048, NMETA = 16, NR = NB * SEQ, NRX = NR + 256;
constexpr int CWID = 512, CK = 31, NH = 8, HD = 64;
constexpr int INCOLS = 4616, N1 = 4608, FCOL = 2560, GCOL = 2568;
constexpr int NE = 64, DE = 256, MOE_CAP = NR, MAXT = 192;
constexpr int AROWS = 2080, KROWS = 2112;
constexpr float RMS_EPS = 1e-6f, LN_EPS = 1e-5f;
constexpr float LOG2E = 1.4426950408889634f;
constexpr float C2 = 0.125f * LOG2E;
constexpr float NEGBIG = -1e30f;

constexpr size_t MiB = 1u << 20;
constexpr size_t WS_CTL = 0, CTL_ZERO_BYTES = 1 * MiB;
constexpr size_t WS_BIAS1 = 1 * MiB, WS_WR = 1 * MiB + 32 * 1024, WS_RS = 1 * MiB + 512 * 1024;
constexpr size_t WS_W1T = 2 * MiB, WS_WCT = 11 * MiB, WS_WAT = 12 * MiB, WS_WOT = 13 * MiB, WS_WGU = 15 * MiB, WS_WD = 79 * MiB;
constexpr size_t WS_XN = 111 * MiB;
constexpr size_t WS_ABUF = 144 * MiB, WS_CACT = 161 * MiB;
constexpr size_t WS_QO = 177 * MiB, WS_KX = 193 * MiB, WS_VX = 210 * MiB;
constexpr size_t WS_CB = 227 * MiB, WS_LOGF = 228 * MiB, WS_TOK = 229 * MiB, WS_WL = 233 * MiB, WS_O = 237 * MiB, WS_END = 269 * MiB;
constexpr int CW_TMO = 0, CW_CODE = 1, CW_BAR = 4096, CW_CNT = 8192;

constexpr int RING_BYTES = 131072, LDSCTL_OFF = RING_BYTES, MISC_OFF = LDSCTL_OFF + 320, TAB_OFF = RING_BYTES + 1024;
constexpr int BIAS_OFF = RING_BYTES + 4096;
constexpr int LIST_OFF = RING_BYTES + 4096;
constexpr int LDS_BYTES = 155648;

typedef GAS unsigned gu32;
#define RLX_AGENT __ATOMIC_RELAXED, __HIP_MEMORY_SCOPE_AGENT
#define LDS_WAIT() asm volatile("s_waitcnt lgkmcnt(0)" ::: "memory")
#define VM_WAIT() asm volatile("s_waitcnt vmcnt(0)" ::: "memory")
#define XB_TMO      128
#define XB_XCNT(j)  (256  + 64 * (j))
#define XB_XSUB(j)  (1280 + 64 * (j))
#define XB_XGEN(j)  (2304 + 64 * (j))
#define XB_TOP      3328
#define XB_TOPGEN   3392
#define XCD_BAR_WORDS 3456
#define XB_SPIN_CAP (1u << 18)

__device__ __forceinline__ unsigned xb_ld(unsigned* p)              { return __hip_atomic_load(p, __ATOMIC_RELAXED, __HIP_MEMORY_SCOPE_AGENT); }
__device__ __forceinline__ unsigned xb_add(unsigned* p, unsigned v) { return __hip_atomic_fetch_add(p, v, __ATOMIC_RELAXED, __HIP_MEMORY_SCOPE_AGENT); }
__device__ __forceinline__ unsigned xb_xcc_id() { return (unsigned)__builtin_amdgcn_s_getreg((3 << 11) | 20) & 0xFu; }
#define XB_SPIN(cond, bar) do { unsigned _sp = 0; while (cond) { __builtin_amdgcn_s_sleep(1); \
    if ((++_sp & 255u) == 0u) { if (xb_ld(&(bar)[XB_TMO])) break; if (_sp > XB_SPIN_CAP) { atomicAdd(&(bar)[XB_TMO], 1u); break; } } } } while (0)

struct XcdBarrier {
    unsigned* bar; unsigned x;
    volatile LAS unsigned* st;
};

__device__ __forceinline__ XcdBarrier xcd_barrier_post(unsigned* bar, volatile LAS unsigned* st) {
    XcdBarrier b; b.bar = bar; b.x = xb_xcc_id(); b.st = st;
    if (threadIdx.x == 0) (void)xb_add(&bar[XB_XCNT(b.x)], 1u);
    return b;
}
__device__ __forceinline__ void xcd_barrier_complete(unsigned* bar, unsigned x, unsigned& nloc, unsigned& nx) {
    const unsigned G = gridDim.x * gridDim.y * gridDim.z;
    unsigned sum, cnt, mine, sp = 0u;
    for (;;) {
        sum = 0u; cnt = 0u; mine = 0u;
#pragma unroll
        for (unsigned j = 0; j < 16; ++j) { const unsigned c = xb_ld(&bar[XB_XCNT(j)]); sum += c; cnt += (c > 0u) ? 1u : 0u; mine = (j == x) ? c : mine; }
        if (sum == G) break;
        __builtin_amdgcn_s_sleep(1);
        if ((++sp & 255u) == 0u) { if (xb_ld(&bar[XB_TMO])) break; if (sp > XB_SPIN_CAP) { atomicAdd(&bar[XB_TMO], 1u); break; } }
    }
    nloc = mine > 0u ? mine : 1u; nx = cnt > 0u ? cnt : 1u;
}

__device__ __forceinline__ void xcd_barrier(const XcdBarrier& b) {
    asm volatile("s_waitcnt vmcnt(0)" ::: "memory");
    __syncthreads();
    if (threadIdx.x == 0) {
        unsigned* bar = b.bar;
        __builtin_amdgcn_s_waitcnt(0);
        unsigned nloc = b.st[0], nx = b.st[1];
        if (nloc == 0u) { xcd_barrier_complete(bar, b.x, nloc, nx); b.st[0] = nloc; b.st[1] = nx; }
        const unsigned old = xb_add(&bar[XB_XSUB(b.x)], 1u);
        const unsigned gen = old / nloc;
        if (old + 1u == (gen + 1u) * nloc) {
            __builtin_amdgcn_fence(__ATOMIC_RELEASE, "agent");
            asm volatile("s_waitcnt vmcnt(0)" ::: "memory");
            const unsigned og = xb_add(&bar[XB_TOP], 1u);
            const unsigned tg = og / nx;
            if (og + 1u == (tg + 1u) * nx) xb_add(&bar[XB_TOPGEN], 1u);
            else XB_SPIN(xb_ld(&bar[XB_TOPGEN]) == tg, bar);
            __builtin_amdgcn_fence(__ATOMIC_ACQUIRE, "agent");
            xb_add(&bar[XB_XGEN(b.x)], 1u);
            asm volatile("s_waitcnt vmcnt(0)" ::: "memory");
        } else {
            XB_SPIN(xb_ld(&bar[XB_XGEN(b.x)]) == gen, bar);
            __builtin_amdgcn_fence(__ATOMIC_ACQUIRE, "agent");
            asm volatile("s_waitcnt vmcnt(0)" ::: "memory");
        }
    }
    __syncthreads();
}

struct Frame {
    LAS unsigned char* lds;
    volatile LAS unsigned* MISC;
    unsigned* ctl;
    int tid, lane, wave, vcu, G;
    const float *x, *meta, *norm1_g, *w_in, *b_in, *dw_w, *dw_b, *ln_g, *ln_b, *w_conv_out, *b_conv_out, *q_norm_g, *k_norm_g, *b_forget,
                *w_attn_out, *w_out, *norm2_g, *w_group, *b_group, *w_router, *b_router, *w_gate, *w_up, *w_down;
    float* out;
    float *BIAS1, *RS, *CB, *LOGF, *WL; bf16_t *WRH, *WRL;
    int* TOK;
    bf16_t *W1T, *WCT, *WAT, *WOT, *WGU, *WD, *XN, *MERGED, *ABUF, *CACT, *HN, *QO, *KX, *VX, *HB, *SG, *YB, *OB;
};

__device__ __forceinline__ float wave_sum(float v) {
#pragma unroll
    for (int o = 1; o < 64; o <<= 1) v += __shfl_xor(v, o);
    return v;
}

__device__ __forceinline__ int col1(int p) {
    const int pn = p >> 8, q = p & 255, bj = q >> 7, y = q & 127;
    if (pn < 4) return 128 * pn + y + 512 * bj;
    if (pn < 8) { const int wc = y >> 5, xx = y & 31, head = 4 * (pn & 1) + wc, dim = 32 * bj + xx; return (pn < 6 ? 1024 : 1536) + 64 * head + dim; }
    if (pn < 10) return 2048 + 256 * (pn - 8) + q;
    return GCOL + 256 * (pn - 10) + q;
}

__device__ __forceinline__ float sig_scale(int p);
__device__ __forceinline__ void tr_item(const float* W, int ldw, int k0, int n0, bf16_t* WT, int ldk, int row0, LAS float* scr, int lane, float sc = 1.0f) {
    { f32x4 v[8];
#pragma unroll
      for (int i = 0; i < 8; ++i) v[i] = *(const f32x4*)(W + (size_t)(k0 + 8 * i + (lane >> 3)) * ldw + n0 + 4 * (lane & 7));
#pragma unroll
      for (int i = 0; i < 8; ++i) { LAS float* d = scr + (8 * i + (lane >> 3)) * 33 + 4 * (lane & 7); d[0] = v[i][0]; d[1] = v[i][1]; d[2] = v[i][2]; d[3] = v[i][3]; } }
    LDS_WAIT(); asm volatile("" ::: "memory");
    const int c = lane & 7;
#pragma unroll
    for (int j = 0; j < 4; ++j) { const int n = (lane >> 3) + 8 * j; const LAS float* s = scr + (8 * c) * 33 + n;
        u32x4 o; o.x = cvt_pk_bf16(s[0 * 33] * sc, s[1 * 33] * sc); o.y = cvt_pk_bf16(s[2 * 33] * sc, s[3 * 33] * sc); o.z = cvt_pk_bf16(s[4 * 33] * sc, s[5 * 33] * sc); o.w = cvt_pk_bf16(s[6 * 33] * sc, s[7 * 33] * sc);
        *(u32x4*)(WT + (size_t)(row0 + n) * ldk + k0 + 8 * c) = o; }
    LDS_WAIT(); asm volatile("" ::: "memory");
}

__device__ __forceinline__ float log_sigmoid_(float z) { return z >= 0.f ? -log1pf(expf(-z)) : z - log1pf(expf(z)); }

__device__ __forceinline__ void p0_prologue(Frame& F) {
    LAS float* scr = (LAS float*)(F.lds + F.wave * 16384);
    const int gw = F.vcu * NWAVES + F.wave, NGW = F.G * NWAVES;
    constexpr int I_IN = 16 * 144, I_C = 8 * 32, I_O = 16 * 32;
    constexpr int NITEMS = I_IN + 2 * I_C + I_O;
    for (int it = gw; it < NITEMS; it += NGW) {
        int r = it;
        if (r < I_IN) { const int kb = r / 144, pb = r % 144; tr_item(F.w_in, INCOLS, 64 * kb, col1(32 * pb), F.W1T, 1024, 32 * pb, scr, F.lane, sig_scale(32 * pb)); continue; } r -= I_IN;
        if (r < I_C) { tr_item(F.w_conv_out, 1024, 64 * (r / 32), 32 * (r % 32), F.WCT, 512, 32 * (r % 32), scr, F.lane); continue; } r -= I_C;
        if (r < I_C) { tr_item(F.w_attn_out, 1024, 64 * (r / 32), 32 * (r % 32), F.WAT, 512, 32 * (r % 32), scr, F.lane); continue; } r -= I_C;
        { tr_item(F.w_out, 1024, 64 * (r / 32), 32 * (r % 32), F.WOT, 1024, 32 * (r % 32), scr, F.lane); }
    }
    const int gt = F.vcu * (NWAVES * 64) + F.tid, NGT = F.G * NWAVES * 64;
    for (int p = gt; p < N1; p += NGT) F.BIAS1[p] = F.b_in[col1(p)] * sig_scale(p);
    for (int i = gt; i < 1024 * 80; i += NGT) { const int c = i >> 10, k = i & 1023; float w = 0.f;
        if (c < 8) w = F.w_group[k * 8 + c]; else if (c < 72) w = F.w_router[k * 64 + (c - 8)];
        w *= F.norm2_g[k];
        const unsigned hi = cvt_pk_bf16(w, 0.f) & 0xffffu; const float rem = w - __uint_as_float(hi << 16);
        F.WRH[i] = (bf16_t)hi; F.WRL[i] = (bf16_t)(cvt_pk_bf16(rem, 0.f) & 0xffffu); }
    const u32x4 z4 = (u32x4){0u, 0u, 0u, 0u};
    for (int i = gt; i < NB * 16 * 64; i += NGT) { const int b = i / (16 * 64), r = (i / 64) % 16, c = i % 64; *(u32x4*)(F.ABUF + ((size_t)(b * AROWS + r)) * 512 + 8 * c) = z4; }
    for (int i = gt; i < NB * 48 * 64; i += NGT) { const int b = i / (48 * 64), r = (i / 64) % 48, c = i % 64;
        *(u32x4*)(F.KX + ((size_t)(b * KROWS + r)) * 512 + 8 * c) = z4; *(u32x4*)(F.VX + ((size_t)(b * KROWS + r)) * 512 + 8 * c) = z4; }
    __syncthreads();
    { LAS f32x4* wl = (LAS f32x4*)F.lds;
      for (int r = F.tid; r < 1024; r += NWAVES * 64) { const float* wp = F.w_in + (size_t)r * INCOLS + FCOL; wl[2 * r] = *(const f32x4*)wp; wl[2 * r + 1] = *(const f32x4*)(wp + 4); } }
    __syncthreads();
    if (gw < NR + NMETA) {
        f32x4 wf[4][4][2];
#pragma unroll
        for (int j = 0; j < 4; ++j)
#pragma unroll
            for (int jj = 0; jj < 4; ++jj) { const LAS f32x4* wp = (const LAS f32x4*)F.lds + 2 * (4 * F.lane + 256 * j + jj); wf[j][jj][0] = wp[0]; wf[j][jj][1] = wp[1]; }
        f32x4 g1[4];
#pragma unroll
        for (int j = 0; j < 4; ++j) g1[j] = *(const f32x4*)(F.norm1_g + 4 * F.lane + 256 * j);
        for (int m0 = gw; m0 < NR + NMETA; m0 += 2 * NGW) {
            f32x4 v[2][4]; float s[2], d[2][8]; bool ok[2];
#pragma unroll
            for (int u = 0; u < 2; ++u) { const int m = m0 + u * NGW; ok[u] = m < NR + NMETA; const int mm = ok[u] ? m : m0;
                const float* xrow = mm < NR ? F.x + (size_t)mm * DM : F.meta + (size_t)(mm - NR) * DM;
#pragma unroll
                for (int j = 0; j < 4; ++j) v[u][j] = *(const f32x4*)(xrow + 4 * F.lane + 256 * j); }
#pragma unroll
            for (int u = 0; u < 2; ++u) { s[u] = 0.f;
#pragma unroll
                for (int h = 0; h < 8; ++h) d[u][h] = 0.f;
#pragma unroll
                for (int j = 0; j < 4; ++j) { s[u] += (v[u][j].x * v[u][j].x + v[u][j].y * v[u][j].y) + (v[u][j].z * v[u][j].z + v[u][j].w * v[u][j].w);
                    v[u][j] = v[u][j] * g1[j];
#pragma unroll
                    for (int jj = 0; jj < 4; ++jj) { const float xv = v[u][j][jj];
#pragma unroll
                        for (int h = 0; h < 4; ++h) { d[u][h] += xv * wf[j][jj][0][h]; d[u][4 + h] += xv * wf[j][jj][1][h]; } } } }
            float rs[2], g[2];
            const bool u32_ = (F.lane & 32) != 0, u16_ = (F.lane & 16) != 0, u8_ = (F.lane & 8) != 0;
#pragma unroll
            for (int u = 0; u < 2; ++u) { rs[u] = 1.0f / sqrtf(wave_sum(s[u]) * (1.f / DM) + RMS_EPS);
                float e[4], f[2];
#pragma unroll
                for (int i = 0; i < 4; ++i) { const float snd = u32_ ? d[u][i] : d[u][4 + i], kp = u32_ ? d[u][4 + i] : d[u][i]; e[i] = kp + __shfl_xor(snd, 32); }
#pragma unroll
                for (int i = 0; i < 2; ++i) { const float snd = u16_ ? e[i] : e[2 + i], kp = u16_ ? e[2 + i] : e[i]; f[i] = kp + __shfl_xor(snd, 16); }
                float gg = (u8_ ? f[1] : f[0]) + __shfl_xor(u8_ ? f[0] : f[1], 8);
                gg += __shfl_xor(gg, 4); gg += __shfl_xor(gg, 2); gg += __shfl_xor(gg, 1); g[u] = gg; }
#pragma unroll
            for (int u = 0; u < 2; ++u) if (ok[u]) { const int m = m0 + u * NGW;
                bf16_t* orow = F.XN + (size_t)m * DM;
#pragma unroll
                for (int j = 0; j < 4; ++j) { const f32x4 y = v[u][j] * rs[u]; u32x2 o; o.x = cvt_pk_bf16(y.x, y.y); o.y = cvt_pk_bf16(y.z, y.w); *(u32x2*)(orow + 4 * F.lane + 256 * j) = o; }
                if ((F.lane & 7) == 0) { const int h = F.lane >> 3;
                    const float z = g[u] * rs[u] + F.b_in[FCOL + h] + F.b_forget[h];
                    F.LOGF[(size_t)m * 8 + h] = log_sigmoid_(z); } }
        }
    }
}

__device__ __forceinline__ void scan_bh(Frame& F, int bh) {
    const int b = bh >> 3, h = bh & 7, lane = F.lane;
    float loc[33]; float tot = 0.f;
#pragma unroll
    for (int i = 0; i < 33; ++i) { const int p = 33 * lane + i; float v = 0.f;
        if (p < NMETA) v = F.LOGF[(size_t)(NR + p) * 8 + h]; else if (p < SEQ + NMETA) v = F.LOGF[((size_t)b * SEQ + (p - NMETA)) * 8 + h];
        tot += v; loc[i] = tot; }
    float inc = tot;
#pragma unroll
    for (int o = 1; o < 64; o <<= 1) { const float n = __shfl_up(inc, o); if (lane >= o) inc += n; }
    const float excl = inc - tot;
    float* cb = F.CB + (size_t)bh * KROWS;
#pragma unroll
    for (int i = 0; i < 33; ++i) { const int p = 33 * lane + i; if (p < SEQ + NMETA) cb[48 + p] = -(excl + loc[i]) * LOG2E; }
    if (lane < 48) cb[lane] = NEGBIG;
}

#ifndef SO_GS
#define SO_GS 4
#endif
struct StaticOrder {
    int nM, nN, nwg, G, c;
    __device__ __forceinline__ void init(int nM_, int nN_, int G_, int c_, int extra = 0) { nM = nM_; nN = nN_; nwg = nM * nN + extra; G = G_; c = c_; }
    __device__ __forceinline__ bool tile(int i, int& pm, int& pn) const {
        const long L = (long)i * G + c; if (L >= nwg) return false;
        int wgid = (int)L; { const int q = nwg / 8, r = nwg % 8, xcd = wgid % 8, off = wgid / 8; wgid = (xcd < r ? xcd * (q + 1) : r * (q + 1) + (xcd - r) * q) + off; }
        if (wgid >= nM * nN) { const int x = wgid - nM * nN; pm = nM; pn = x < 4 ? x : x + 2; return true; }
        const int nig = SO_GS * nN, gid = wgid / nig, fm = gid * SO_GS, gsz = (nM - fm) < SO_GS ? (nM - fm) : SO_GS;
        pm = fm + ((wgid % nig) % gsz); pn = (wgid % nig) / gsz; return true;
    }
};
struct SchedPlain {
    StaticOrder so; const char* A; const char* B; int K;
    __device__ __forceinline__ bool next(int i, pg8::Unit& u) const { u.e = 0; return so.tile(i, u.pm, u.pn); }
    __device__ __forceinline__ const char* a_base(const pg8::Unit& u) const { return A + (size_t)u.pm * 256 * K * 2; }
    __device__ __forceinline__ const char* b_base(const pg8::Unit& u) const { return B + (size_t)u.pn * 256 * K * 2; }
    __device__ __forceinline__ void a_offs(const pg8::Unit&, const int (&)[2], const int (&)[2], unsigned (&)[2][2]) const {}
    __device__ __forceinline__ void lists(const pg8::Unit&, LAS unsigned char*, int, int) const {}
};
struct SchedDual {
    StaticOrder so; const char *A0, *B0, *A1, *B1; int K;
    __device__ __forceinline__ bool next(int i, pg8::Unit& u) const { u.e = i & 1; return so.tile(i >> 1, u.pm, u.pn); }
    __device__ __forceinline__ const char* a_base(const pg8::Unit& u) const { return (u.e ? A1 : A0) + (size_t)u.pm * 256 * K * 2; }
    __device__ __forceinline__ const char* b_base(const pg8::Unit& u) const { return (u.e ? B1 : B0) + (size_t)u.pn * 256 * K * 2; }
    __device__ __forceinline__ void a_offs(const pg8::Unit&, const int (&)[2], const int (&)[2], unsigned (&)[2][2]) const {}
    __device__ __forceinline__ void lists(const pg8::Unit&, LAS unsigned char*, int, int) const {}
};
struct SchedMoe {
    int first, last, stride, c, sh; const LAS int* tab; const LAS int* cnt; const char* A; const char* B; const int* TOK; int K, brows; bool gather;
    const void* L0; const void* L1;
    __device__ __forceinline__ bool next(int i, pg8::Unit& u) const { const int idx = first + i * stride + c; if (idx >= last) return false; u.pm = idx >> sh; u.pn = idx & ((1 << sh) - 1); u.e = tab[u.pm] | ((i & 1) << 30); return true; }
    __device__ __forceinline__ void lists(const pg8::Unit& u, LAS unsigned char* lds, int wid, int lane) const {
        const void* src = (wid < 4) ? L0 : L1;
        if (src) { const char* base = (const char*)src + ((size_t)(u.e & 255) * MOE_CAP + ((u.e >> 8) & 255) * 256 + (wid & 3) * 64) * 4;
            __builtin_amdgcn_global_load_lds((const unsigned*)(base + (unsigned)lane * 4u), (LAS unsigned*)(lds + LIST_OFF + ((u.e >> 30) & 1) * 2048 + (wid >> 2) * 1024 + (wid & 3) * 256), 4, 0, 0); }
    }
    __device__ __forceinline__ int rows(const pg8::Unit& u) const { return cnt[u.e & 255] - 256 * ((u.e >> 8) & 255); }
    __device__ __forceinline__ const char* a_base(const pg8::Unit& u) const { return gather ? A : A + (size_t)u.pm * 256 * K * 2; }
    __device__ __forceinline__ const char* b_base(const pg8::Unit& u) const { return B + ((size_t)(u.e & 255) * brows + (size_t)u.pn * 256) * K * 2; }
    __device__ __forceinline__ void a_offs(const pg8::Unit& u, const int (&R)[2], const int (&C)[2], unsigned (&ao)[2][2]) const {
        if (gather) {
            const int e = u.e & 255, rt = (u.e >> 8) & 255, n = cnt[e];
#pragma unroll
            for (int h = 0; h < 2; ++h)
#pragma unroll
                for (int i = 0; i < 2; ++i) { const int pos = rt * 256 + 128 * h + R[i]; const int tok = TOK[(size_t)e * MOE_CAP + (pos < n ? pos : 0)] >> 1; ao[h][i] = (unsigned)(tok * K + C[i]) * 2u; }
            asm volatile("s_waitcnt vmcnt(0)" : "+v"(ao[0][0]), "+v"(ao[0][1]), "+v"(ao[1][0]), "+v"(ao[1][1]) :: "memory");
        }
    }
};

__device__ __forceinline__ float sigmoid_pre(float t) { return __builtin_amdgcn_rcpf(1.0f + __builtin_amdgcn_exp2f(t)); }
__device__ __forceinline__ float sig_scale(int p) { return (p >= 2560 || (p < 1024 && (p & 255) >= 128)) ? -LOG2E : 1.0f; }
#ifndef ZC1
#define ZC1 false
#endif
#ifndef ZC4
#define ZC4 false
#endif
#ifndef ZC6
#define ZC6 false
#endif
#ifndef ZC7
#define ZC7 true
#endif
__device__ __forceinline__ u32x4 pack8(const f32x4& a, const f32x4& b) { u32x4 w; w.x = cvt_pk_bf16(a[0], a[1]); w.y = cvt_pk_bf16(a[2], a[3]); w.z = cvt_pk_bf16(b[0], b[1]); w.w = cvt_pk_bf16(b[2], b[3]); return w; }
__device__ __forceinline__ void unpack8(const u32x4& w, f32x4& a, f32x4& b) { a = (f32x4){bf_lo(w.x), bf_hi(w.x), bf_lo(w.y), bf_hi(w.y)}; b = (f32x4){bf_lo(w.z), bf_hi(w.z), bf_lo(w.w), bf_hi(w.w)}; }

struct Epi1 {
    static constexpr bool PERM = true; static constexpr bool ZERO_C = ZC1;
    __device__ __forceinline__ void init(f32x4 (&acc)[2][2][4][2], const pg8::Unit& u, int wc, int fq) const {
        const LAS float* bp = lb + u.pn * 256 + 32 * wc + 8 * fq;
        const f32x4 b00 = *(const LAS f32x4*)(bp), b01 = *(const LAS f32x4*)(bp + 4), b10 = *(const LAS f32x4*)(bp + 128), b11 = *(const LAS f32x4*)(bp + 132);
#pragma unroll
        for (int a = 0; a < 2; ++a)
#pragma unroll
            for (int m = 0; m < 4; ++m) { acc[a][0][m][0] = b00; acc[a][0][m][1] = b01; acc[a][1][m][0] = b10; acc[a][1][m][1] = b11; }
    }
    const LAS float* lb; bf16_t *ABUF, *Q, *KX, *VX, *SG;
    __device__ __forceinline__ bool operator()(f32x4 (&acc)[2][2][4][2], const pg8::Unit& u, int wr, int wc, int fr, int fq) {
        asm volatile("" : "+v"(fr), "+v"(fq));
        const int pn = u.pn; const bool meta = (u.pm == 64); const int cpos = 32 * wc + 8 * fq;
        if (meta && (pn == 4 || pn == 5 || pn >= 10)) return false;
        const int row_w = u.pm * 256 + 64 * wr + fr;
        if (pn < 4) {
            const int col = 128 * pn + cpos;
#pragma unroll
            for (int ai = 0; ai < 2; ++ai)
#pragma unroll
                for (int m = 0; m < 4; ++m) {
                    const f32x4 x00 = acc[ai][0][m][0], x01 = acc[ai][0][m][1], x10 = acc[ai][1][m][0], x11 = acc[ai][1][m][1];
                    f32x4 o0, o1;
#pragma unroll
                    for (int j = 0; j < 4; ++j) { o0[j] = x00[j] * sigmoid_pre(x10[j]); o1[j] = x01[j] * sigmoid_pre(x11[j]); }
                    const u32x4 w = pack8(o0, o1);
                    const int Rg = row_w + 128 * ai + 16 * m;
                    if (!meta) { const int b = Rg >> 11, t = Rg & 2047; *(u32x4*)(ABUF + ((size_t)(b * AROWS + 32 + t)) * 512 + col) = w; }
                    else if (ai == 0 && m == 0 && wr == 0) { for (int bb = 0; bb < NB; ++bb) *(u32x4*)(ABUF + ((size_t)(bb * AROWS + 16 + fr)) * 512 + col) = w; }
                }
        } else if (pn < 8) {
            const bool isq = pn < 6; const LAS float* g = lb + N1 + (isq ? 0 : 64);
            const f32x4 g00 = *(const LAS f32x4*)(g + 8 * fq), g01 = *(const LAS f32x4*)(g + 8 * fq + 4), g10 = *(const LAS f32x4*)(g + 32 + 8 * fq), g11 = *(const LAS f32x4*)(g + 36 + 8 * fq);
            const int col = 64 * (4 * (pn & 1) + wc) + 8 * fq;
#pragma unroll
            for (int ai = 0; ai < 2; ++ai)
#pragma unroll
                for (int m = 0; m < 4; ++m) {
                    const f32x4 x00 = acc[ai][0][m][0], x01 = acc[ai][0][m][1], x10 = acc[ai][1][m][0], x11 = acc[ai][1][m][1];
                    const f32x4 sq = x00 * x00 + x01 * x01 + x10 * x10 + x11 * x11;
                    float ss = (sq[0] + sq[1]) + (sq[2] + sq[3]);
                    ss += __shfl_xor(ss, 16); ss += __shfl_xor(ss, 32);
                    const float rs = 1.0f / sqrtf(ss * (1.f / 64.f) + RMS_EPS);
                    const u32x4 w0 = pack8(x00 * rs * g00, x01 * rs * g01), w1 = pack8(x10 * rs * g10, x11 * rs * g11);
                    const int Rg = row_w + 128 * ai + 16 * m; const int b = Rg >> 11, t = Rg & 2047;
                    if (isq) { bf16_t* o = Q + (size_t)Rg * 512 + col; *(u32x4*)o = w0; *(u32x4*)(o + 32) = w1; }
                    else if (!meta) { bf16_t* o = KX + ((size_t)(b * KROWS + 64 + t)) * 512 + col; *(u32x4*)o = w0; *(u32x4*)(o + 32) = w1; }
                    else if (ai == 0 && m == 0 && wr == 0) { for (int bb = 0; bb < NB; ++bb) { bf16_t* o = KX + ((size_t)(bb * KROWS + 48 + fr)) * 512 + col; *(u32x4*)o = w0; *(u32x4*)(o + 32) = w1; } }
                }
        } else if (pn < 10) {
            const int col = 256 * (pn - 8) + cpos;
#pragma unroll
            for (int ai = 0; ai < 2; ++ai)
#pragma unroll
                for (int m = 0; m < 4; ++m) {
                    const u32x4 w0 = pack8(acc[ai][0][m][0], acc[ai][0][m][1]), w1 = pack8(acc[ai][1][m][0], acc[ai][1][m][1]);
                    const int Rg = row_w + 128 * ai + 16 * m; const int b = Rg >> 11, t = Rg & 2047;
                    if (!meta) { bf16_t* o = VX + ((size_t)(b * KROWS + 64 + t)) * 512 + col; *(u32x4*)o = w0; *(u32x4*)(o + 128) = w1; }
                    else if (ai == 0 && m == 0 && wr == 0) { for (int bb = 0; bb < NB; ++bb) { bf16_t* o = VX + ((size_t)(bb * KROWS + 48 + fr)) * 512 + col; *(u32x4*)o = w0; *(u32x4*)(o + 128) = w1; } }
                }
        } else {
            const int col = 256 * (pn - 10) + cpos;
#pragma unroll
            for (int ai = 0; ai < 2; ++ai)
#pragma unroll
                for (int m = 0; m < 4; ++m) {
                    const f32x4 x00 = acc[ai][0][m][0], x01 = acc[ai][0][m][1], x10 = acc[ai][1][m][0], x11 = acc[ai][1][m][1];
                    f32x4 o00, o01, o10, o11;
#pragma unroll
                    for (int j = 0; j < 4; ++j) { o00[j] = sigmoid_pre(x00[j]); o01[j] = sigmoid_pre(x01[j]); o10[j] = sigmoid_pre(x10[j]); o11[j] = sigmoid_pre(x11[j]); }
                    bf16_t* o = SG + (size_t)(row_w + 128 * ai + 16 * m) * 2048 + col;
                    *(u32x4*)o = pack8(o00, o01); *(u32x4*)(o + 128) = pack8(o10, o11);
                }
        }
        return false;
    }
};

struct Epi3 {
    static constexpr bool PERM = true; static constexpr bool ZERO_C = false;
    __device__ __forceinline__ void init(f32x4 (&acc)[2][2][4][2], const pg8::Unit&, int, int) const {
#pragma unroll
        for (int a = 0; a < 2; ++a)
#pragma unroll
            for (int b = 0; b < 2; ++b)
#pragma unroll
                for (int m = 0; m < 4; ++m)
#pragma unroll
                    for (int n = 0; n < 2; ++n) acc[a][b][m][n] = (f32x4){0.f, 0.f, 0.f, 0.f};
    }
    const float* bc; const bf16_t* SG; bf16_t* MERGED;
    __device__ __forceinline__ bool operator()(f32x4 (&acc)[2][2][4][2], const pg8::Unit& u, int wr, int wc, int fr, int fq) {
        asm volatile("" : "+v"(fr), "+v"(fq));
        const int col0 = u.pn * 256 + 32 * wc + 8 * fq;
        const bf16_t* sgrow = SG + ((size_t)u.pm * 256 + 64 * wr + fr) * 2048 + col0;
        if (u.e == 0) {
            const f32x4 b00 = *(const f32x4*)(bc + col0), b01 = *(const f32x4*)(bc + col0 + 4), b10 = *(const f32x4*)(bc + col0 + 128), b11 = *(const f32x4*)(bc + col0 + 132);
#pragma unroll
            for (int ai = 0; ai < 2; ++ai)
#pragma unroll
                for (int m = 0; m < 4; ++m) {
                    const bf16_t* sp = sgrow + (size_t)(128 * ai + 16 * m) * 2048;
                    const u32x4 wc0 = *(const u32x4*)(sp), wc1 = *(const u32x4*)(sp + 128), wa0 = *(const u32x4*)(sp + 1024), wa1 = *(const u32x4*)(sp + 1152);
                    f32x4 c00, c01, c10, c11, a00, a01, a10, a11;
                    unpack8(wc0, c00, c01); unpack8(wc1, c10, c11); unpack8(wa0, a00, a01); unpack8(wa1, a10, a11);
#pragma unroll
                    for (int j = 0; j < 4; ++j) {
                        acc[ai][0][m][0][j] = (acc[ai][0][m][0][j] + b00[j]) * c00[j] * __builtin_amdgcn_rcpf(fmaxf(a00[j], 1e-20f));
                        acc[ai][0][m][1][j] = (acc[ai][0][m][1][j] + b01[j]) * c01[j] * __builtin_amdgcn_rcpf(fmaxf(a01[j], 1e-20f));
                        acc[ai][1][m][0][j] = (acc[ai][1][m][0][j] + b10[j]) * c10[j] * __builtin_amdgcn_rcpf(fmaxf(a10[j], 1e-20f));
                        acc[ai][1][m][1][j] = (acc[ai][1][m][1][j] + b11[j]) * c11[j] * __builtin_amdgcn_rcpf(fmaxf(a11[j], 1e-20f)); }
                }
            return true;
        }
        bf16_t* mrow = MERGED + ((size_t)u.pm * 256 + 64 * wr + fr) * 1024 + col0;
#pragma unroll
        for (int ai = 0; ai < 2; ++ai)
#pragma unroll
            for (int m = 0; m < 4; ++m) {
                const bf16_t* sp = sgrow + (size_t)(128 * ai + 16 * m) * 2048;
                const u32x4 wa0 = *(const u32x4*)(sp + 1024), wa1 = *(const u32x4*)(sp + 1152);
                f32x4 a00, a01, a10, a11; unpack8(wa0, a00, a01); unpack8(wa1, a10, a11);
                bf16_t* op = mrow + (size_t)(128 * ai + 16 * m) * 1024;
                *(u32x4*)op = pack8(acc[ai][0][m][0] * a00, acc[ai][0][m][1] * a01); *(u32x4*)(op + 128) = pack8(acc[ai][1][m][0] * a10, acc[ai][1][m][1] * a11);
            }
        return false;
    }
};

#ifndef EPI4_D
#define EPI4_D 3
#endif
struct Epi4 {
    static constexpr bool PERM = false; static constexpr bool ZERO_C = ZC4;
    __device__ __forceinline__ void init(f32x4 (&acc)[2][2][4][2], const pg8::Unit&, int, int) const {
#pragma unroll
        for (int a = 0; a < 2; ++a)
#pragma unroll
            for (int b = 0; b < 2; ++b)
#pragma unroll
                for (int m = 0; m < 4; ++m)
#pragma unroll
                    for (int n = 0; n < 2; ++n) acc[a][b][m][n] = (f32x4){0.f, 0.f, 0.f, 0.f};
    }
    const float* x; float* out;
    __device__ __forceinline__ bool operator()(f32x4 (&acc)[2][2][4][2], const pg8::Unit& u, int wr, int wc, int fr, int fq) {
        asm volatile("" : "+v"(fr), "+v"(fq));
        const size_t off0 = ((size_t)u.pm * 256 + 64 * wr + fr) * 1024 + u.pn * 256 + 32 * wc + 4 * fq;
        f32x4 r[8][2][2];
#define EPI4_LD(s) do { _Pragma("unroll") for (int bj = 0; bj < 2; ++bj) _Pragma("unroll") for (int n = 0; n < 2; ++n) \
            r[s][bj][n] = *(const f32x4*)(x + off0 + (size_t)(128 * ((s) >> 2) + 16 * ((s) & 3)) * 1024 + 128 * bj + 16 * n); } while (0)
#pragma unroll
        for (int s0 = 0; s0 < EPI4_D; ++s0) EPI4_LD(s0);
#pragma unroll
        for (int s0 = 0; s0 < 8; ++s0) {
            if (s0 + EPI4_D < 8) EPI4_LD(s0 + EPI4_D);
#pragma unroll
            for (int bj = 0; bj < 2; ++bj)
#pragma unroll
                for (int n = 0; n < 2; ++n) *(f32x4*)(out + off0 + (size_t)(128 * (s0 >> 2) + 16 * (s0 & 3)) * 1024 + 128 * bj + 16 * n) = r[s0][bj][n] + acc[s0 >> 2][bj][s0 & 3][n];
        }
#undef EPI4_LD
        return false;
    }
};

struct Epi6 {
    static constexpr bool PERM = true; static constexpr bool ZERO_C = ZC6;
    __device__ __forceinline__ void init(f32x4 (&acc)[2][2][4][2], const pg8::Unit&, int, int) const {
#pragma unroll
        for (int a = 0; a < 2; ++a)
#pragma unroll
            for (int b = 0; b < 2; ++b)
#pragma unroll
                for (int m = 0; m < 4; ++m)
#pragma unroll
                    for (int n = 0; n < 2; ++n) acc[a][b][m][n] = (f32x4){0.f, 0.f, 0.f, 0.f};
    }
    const LAS unsigned char* lst; bf16_t* HB;
    __device__ __forceinline__ bool operator()(f32x4 (&acc)[2][2][4][2], const pg8::Unit& u, int wr, int wc, int fr, int fq) {
        asm volatile("" : "+v"(fr), "+v"(fq));
        const LAS float* rsl = (const LAS float*)(lst + ((u.e >> 30) & 1) * 2048);
        float rsv[2][4];
#pragma unroll
        for (int ai = 0; ai < 2; ++ai)
#pragma unroll
            for (int m = 0; m < 4; ++m) rsv[ai][m] = rsl[128 * ai + 64 * wr + 16 * m + fr];
#pragma unroll
        for (int ai = 0; ai < 2; ++ai)
#pragma unroll
            for (int m = 0; m < 4; ++m) {
                const int rl = 128 * ai + 64 * wr + 16 * m + fr;
                const float rs = rsv[ai][m];
                f32x4 o0, o1;
#pragma unroll
                for (int j = 0; j < 4; ++j) { const float g0 = acc[ai][0][m][0][j] * rs, g1 = acc[ai][0][m][1][j] * rs;
                    o0[j] = g0 * sigmoidf_(g0) * (acc[ai][1][m][0][j] * rs); o1[j] = g1 * sigmoidf_(g1) * (acc[ai][1][m][1][j] * rs); }
                *(u32x4*)(HB + ((size_t)u.pm * 256 + rl) * 256 + 128 * u.pn + 32 * wc + 8 * fq) = pack8(o0, o1);
            }
        return false;
    }
};

struct Epi7 {
    static constexpr bool PERM = true; static constexpr bool ZERO_C = ZC7;
    __device__ __forceinline__ void init(f32x4 (&acc)[2][2][4][2], const pg8::Unit&, int, int) const {
#pragma unroll
        for (int a = 0; a < 2; ++a)
#pragma unroll
            for (int b = 0; b < 2; ++b)
#pragma unroll
                for (int m = 0; m < 4; ++m)
#pragma unroll
                    for (int n = 0; n < 2; ++n) acc[a][b][m][n] = (f32x4){0.f, 0.f, 0.f, 0.f};
    }
    const LAS int* cnt; const LAS unsigned char* lst; bf16_t* YB;
    __device__ __forceinline__ bool operator()(f32x4 (&acc)[2][2][4][2], const pg8::Unit& u, int wr, int wc, int fr, int fq) {
        asm volatile("" : "+v"(fr), "+v"(fq));
        const int e = u.e & 255, rt = (u.e >> 8) & 255, n = cnt[e];
        const LAS int* tl = (const LAS int*)(lst + ((u.e >> 30) & 1) * 2048); const LAS float* wl = (const LAS float*)(tl + 256);
        const int col = u.pn * 256 + 32 * wc + 8 * fq;
#pragma unroll
        for (int ai = 0; ai < 2; ++ai) {
            int ent[4]; float wv[4];
#pragma unroll
            for (int m = 0; m < 4; ++m) { const int pl = 128 * ai + 64 * wr + 16 * m + fr; ent[m] = tl[pl]; wv[m] = wl[pl]; if (rt * 256 + pl >= n) ent[m] = -1; }
#pragma unroll
            for (int m = 0; m < 4; ++m) if (ent[m] >= 0) {
                const float w = wv[m]; bf16_t* op = YB + (size_t)ent[m] * 1024 + col;
                *(u32x4*)op = pack8(acc[ai][0][m][0] * w, acc[ai][0][m][1] * w); *(u32x4*)(op + 128) = pack8(acc[ai][1][m][0] * w, acc[ai][1][m][1] * w); }
            asm volatile("" ::: "memory");
        }
        return false;
    }
};

typedef float f32x2 __attribute__((ext_vector_type(2)));
constexpr int CONV_SLOT1 = 32 * 520 * 4;
static_assert(CONV_SLOT1 + 62 * 1024 <= RING_BYTES, "conv LDS");
__device__ __forceinline__ void conv_stage(Frame& F, int b, int chunk, int slot) {
    const char* base = (const char*)(F.ABUF + ((size_t)(b * AROWS + 32 + chunk * 32 - 30)) * 512) + F.lane * 16;
#pragma unroll
    for (int r = 0; r < 8; ++r) { const int row = F.wave * 8 + r;
        if (row < 62) __builtin_amdgcn_global_load_lds((const unsigned*)(base + (size_t)row * 1024), (LAS unsigned*)(F.lds + slot + row * 1024), 16, 0, 0); }
}
__device__ __forceinline__ void conv_compute(Frame& F, int b, int chunk, int slot, const float (&w)[CK], float bias, float g, float bb) {
    const int c = F.tid, t0 = chunk * 32;
    const LAS bf16_t* vs = (const LAS bf16_t*)(F.lds + slot) + c;
    float v[64];
#pragma unroll
    for (int i = 0; i < 62; ++i) v[i] = bf2f(vs[i * 512]);
    v[62] = 0.f; v[63] = 0.f;
    f32x2 s2[16];
#pragma unroll
    for (int p = 0; p < 16; ++p) { f32x2 a = (f32x2){bias, bias};
#pragma unroll
        for (int j = 0; j < CK; ++j) { const f32x2 ww = (f32x2){w[j], w[j]};
            const f32x2 vv = (j & 1) ? (f32x2){v[2 * p + j], v[2 * p + j + 1]} : (f32x2){v[2 * p + j], v[2 * p + j + 1]};
            a = __builtin_elementwise_fma(ww, vv, a); }
        s2[p] = a; }
    float ov[32];
#pragma unroll
    for (int p = 0; p < 16; ++p) { ov[2 * p] = s2[p][0]; ov[2 * p + 1] = s2[p][1]; }
    LAS float* red = (LAS float*)F.lds; LAS float* st = (LAS float*)(F.lds + TAB_OFF);
    __syncthreads();
#pragma unroll
    for (int i = 0; i < 32; ++i) red[i * 520 + c] = ov[i];
    __syncthreads();
    { const int row = F.tid >> 4, seg = F.tid & 15; float s = 0.f;
#pragma unroll
      for (int qq = 0; qq < 32; ++qq) s += red[row * 520 + seg + 16 * qq];
      s += __shfl_xor(s, 1); s += __shfl_xor(s, 2); s += __shfl_xor(s, 4); s += __shfl_xor(s, 8);
      const float mean = s * (1.f / 512.f); float q2 = 0.f;
#pragma unroll
      for (int qq = 0; qq < 32; ++qq) { const float dlt = red[row * 520 + seg + 16 * qq] - mean; q2 += dlt * dlt; }
      q2 += __shfl_xor(q2, 1); q2 += __shfl_xor(q2, 2); q2 += __shfl_xor(q2, 4); q2 += __shfl_xor(q2, 8);
      if (seg == 0) { st[2 * row] = mean; st[2 * row + 1] = 1.0f / sqrtf(q2 * (1.f / 512.f) + LN_EPS); } }
    __syncthreads();
    bf16_t* op = F.CACT + ((size_t)(b * SEQ + t0)) * 512 + c;
#pragma unroll
    for (int i = 0; i < 32; ++i) { const float y = (ov[i] - st[2 * i]) * st[2 * i + 1] * g + bb; const float z = y * sigmoidf_(y);
        op[(size_t)i * 512] = (bf16_t)(cvt_pk_bf16(z, 0.f) & 0xffffu); }
}
__device__ __forceinline__ void conv_phase(Frame& F) {
    const int c = F.tid, G = F.G;
    float w[CK];
#pragma unroll
    for (int j = 0; j < CK; ++j) w[j] = F.dw_w[j * CWID + c];
    const float bias = F.dw_b[c], g = F.ln_g[c], bb = F.ln_b[c];
    const bool adj = (G == 256); const int ustep = adj ? (1 << 28) : 2 * G;
    for (int u = adj ? 2 * F.vcu : (int)blockIdx.x; u < NB * 64; u += ustep) {
        const int u2 = adj ? u + 1 : u + G; const bool two = u2 < NB * 64;
        conv_stage(F, u >> 6, u & 63, 0);
        if (two) { conv_stage(F, u2 >> 6, u2 & 63, CONV_SLOT1); asm volatile("s_waitcnt vmcnt(6)" ::: "memory");        } else asm volatile("s_waitcnt vmcnt(0)" ::: "memory");
        __syncthreads();
        conv_compute(F, u >> 6, u & 63, 0, w, bias, g, bb);
        if (two) { asm volatile("s_waitcnt vmcnt(24)" ::: "memory");
            __syncthreads();
            conv_compute(F, u2 >> 6, u2 & 63, CONV_SLOT1, w, bias, g, bb); }
        __syncthreads();
    }
}

constexpr int CVT_GU = 64 * 16 * 16, CVT_D = 64 * 4 * 32, CVT_EARLY = 6400;
struct CvtItem { const float* W; int ldw, k0, n0; bf16_t* WT; int ldk, row0; const float* gk; };
__device__ __forceinline__ CvtItem cvt_decode(Frame& F, int r) {
    CvtItem it;
    if (r < CVT_GU) { const int e = r >> 8, r2 = r & 255, kb = r2 >> 4, pb = r2 & 15, p0 = 32 * pb, pn = p0 >> 8, bj = (p0 & 255) >> 7, y = p0 & 127;
        it.W = (bj ? F.w_up : F.w_gate) + (size_t)e * 1024 * 256; it.ldw = 256; it.k0 = 64 * kb; it.n0 = 128 * pn + y; it.WT = F.WGU + (size_t)e * 512 * 1024; it.ldk = 1024; it.row0 = p0; it.gk = F.norm2_g; }
    else { r -= CVT_GU; const int e = r >> 7, r2 = r & 127, kb = r2 >> 5, nb = r2 & 31;
        it.W = F.w_down + (size_t)e * 256 * 1024; it.ldw = 1024; it.k0 = 64 * kb; it.n0 = 32 * nb; it.WT = F.WD + (size_t)e * 1024 * 256; it.ldk = 256; it.row0 = 32 * nb; it.gk = nullptr; }
    return it;
}
__device__ __forceinline__ void cvt_load(const CvtItem& it, f32x4 (&v)[8], float (&gk)[8], int lane) {
#pragma unroll
    for (int i = 0; i < 8; ++i) v[i] = *(const f32x4*)(it.W + (size_t)(it.k0 + 8 * i + (lane >> 3)) * it.ldw + it.n0 + 4 * (lane & 7));
#pragma unroll
    for (int i = 0; i < 8; ++i) gk[i] = it.gk ? it.gk[it.k0 + 8 * i + (lane >> 3)] : 1.0f;
}
__device__ __forceinline__ void cvt_store(const CvtItem& it, const f32x4 (&v)[8], const float (&gk)[8], LAS float* scr, int lane) {
#pragma unroll
    for (int i = 0; i < 8; ++i) { LAS float* d = scr + (8 * i + (lane >> 3)) * 33 + 4 * (lane & 7); d[0] = v[i][0] * gk[i]; d[1] = v[i][1] * gk[i]; d[2] = v[i][2] * gk[i]; d[3] = v[i][3] * gk[i]; }
    LDS_WAIT(); asm volatile("" ::: "memory");
    const int c = lane & 7;
#pragma unroll
    for (int j = 0; j < 4; ++j) { const int n = (lane >> 3) + 8 * j; const LAS float* s = scr + (8 * c) * 33 + n;
        u32x4 o; o.x = cvt_pk_bf16(s[0 * 33], s[1 * 33]); o.y = cvt_pk_bf16(s[2 * 33], s[3 * 33]); o.z = cvt_pk_bf16(s[4 * 33], s[5 * 33]); o.w = cvt_pk_bf16(s[6 * 33], s[7 * 33]);
        *(u32x4*)(it.WT + (size_t)(it.row0 + n) * it.ldk + it.k0 + 8 * c) = o; }
    LDS_WAIT(); asm volatile("" ::: "memory");
}
__device__ __forceinline__ void convert_experts(Frame& F, int first, int last, int w, int nw) {
    LAS float* scr = (LAS float*)(F.lds + F.wave * 16384);
    int r = first + w;
    if (r >= last) return;
    CvtItem cur = cvt_decode(F, r); f32x4 va[8], vb[8]; float ga[8], gb[8];
    cvt_load(cur, va, ga, F.lane);
    for (;;) {
        const int rn = r + nw; const bool more = rn < last;
        CvtItem nxt = cur; if (more) { nxt = cvt_decode(F, rn); cvt_load(nxt, vb, gb, F.lane); }
        cvt_store(cur, va, ga, scr, F.lane);
        if (!more) break;
        const int rn2 = rn + nw; const bool more2 = rn2 < last;
        CvtItem nx2 = nxt; if (more2) { nx2 = cvt_decode(F, rn2); cvt_load(nx2, va, ga, F.lane); }
        cvt_store(nxt, vb, gb, scr, F.lane);
        if (!more2) break;
        cur = nx2; r = rn2;
    }
}

constexpr int RT_NRT = 2, RT_WAVES = 2;
__device__ __forceinline__ void p5_router(Frame& F) {
    const int lane = F.lane, row = lane & 15, q = lane >> 4;
    LAS float* Lw = (LAS float*)(F.lds + F.wave * 16384);
    unsigned* cnt = F.ctl + CW_CNT;
    constexpr int NTASK = NR / (16 * RT_NRT);
    if (F.wave < RT_WAVES) for (int task = F.wave * F.G + F.vcu; task < NTASK; task += RT_WAVES * F.G) {
        const int row0 = task * 16 * RT_NRT;
        const float* __restrict__ hp = F.out + (size_t)(row0 + row) * DM + 8 * q;
        bf16_t* __restrict__ hn = F.HN + (size_t)(row0 + row) * DM + 8 * q;
        const bf16_t* __restrict__ bh = F.WRH + (size_t)row * 1024 + 8 * q; const bf16_t* __restrict__ bl = F.WRL + (size_t)row * 1024 + 8 * q;
        f32x4 acc[RT_NRT][5];
#pragma unroll
        for (int rt = 0; rt < RT_NRT; ++rt)
#pragma unroll
            for (int tl = 0; tl < 5; ++tl) acc[rt][tl] = (f32x4){0.f, 0.f, 0.f, 0.f};
        float ss[RT_NRT];
#pragma unroll
        for (int rt = 0; rt < RT_NRT; ++rt) ss[rt] = 0.f;
        constexpr int HD_ = 2;
        f32x4 hq0[HD_][RT_NRT], hq1[HD_][RT_NRT]; bf16x8 Bc[10];
#pragma unroll
        for (int d = 0; d < HD_; ++d)
#pragma unroll
            for (int rt = 0; rt < RT_NRT; ++rt) { hq0[d][rt] = *(const f32x4*)(hp + (size_t)rt * 16 * DM + 32 * d); hq1[d][rt] = *(const f32x4*)(hp + (size_t)rt * 16 * DM + 32 * d + 4); }
#pragma unroll
        for (int tl = 0; tl < 5; ++tl) { Bc[2 * tl] = *(const bf16x8*)(bh + (size_t)tl * 16 * 1024); Bc[2 * tl + 1] = *(const bf16x8*)(bl + (size_t)tl * 16 * 1024); }
        constexpr int NS_ = 32;
        for (int s2 = 0; s2 < NS_; s2 += HD_) {
#pragma unroll
            for (int d = 0; d < HD_; ++d) {
                const int s = s2 + d, sn = s + 1 < NS_ ? s + 1 : s;
                bf16x8 Bn[10];
#pragma unroll
                for (int tl = 0; tl < 5; ++tl) { Bn[2 * tl] = *(const bf16x8*)(bh + (size_t)tl * 16 * 1024 + 32 * sn); Bn[2 * tl + 1] = *(const bf16x8*)(bl + (size_t)tl * 16 * 1024 + 32 * sn); }
                f32x4 h0[RT_NRT], h1[RT_NRT];
#pragma unroll
                for (int rt = 0; rt < RT_NRT; ++rt) { h0[rt] = hq0[d][rt]; h1[rt] = hq1[d][rt]; }
                if (s2 + HD_ < NS_) {
#pragma unroll
                    for (int rt = 0; rt < RT_NRT; ++rt) { hq0[d][rt] = *(const f32x4*)(hp + (size_t)rt * 16 * DM + 32 * (s + HD_)); hq1[d][rt] = *(const f32x4*)(hp + (size_t)rt * 16 * DM + 32 * (s + HD_) + 4); } }
#pragma unroll
                for (int rt = 0; rt < RT_NRT; ++rt) {
                    const f32x4 sq = h0[rt] * h0[rt] + h1[rt] * h1[rt]; ss[rt] += (sq[0] + sq[1]) + (sq[2] + sq[3]);
                    const u32x4 ahi = pack8(h0[rt], h1[rt]); f32x4 r0, r1; unpack8(ahi, r0, r1);
                    *(u32x4*)(hn + (size_t)rt * 16 * DM + 32 * s) = ahi;
                    const u32x4 alo = pack8(h0[rt] - r0, h1[rt] - r1);
                    const bf16x8 Ahi = __builtin_bit_cast(bf16x8, ahi), Alo = __builtin_bit_cast(bf16x8, alo);
#pragma unroll
                    for (int tl = 0; tl < 5; ++tl) {
                        acc[rt][tl] = __builtin_amdgcn_mfma_f32_16x16x32_bf16(Ahi, Bc[2 * tl], acc[rt][tl], 0, 0, 0);
                        acc[rt][tl] = __builtin_amdgcn_mfma_f32_16x16x32_bf16(Ahi, Bc[2 * tl + 1], acc[rt][tl], 0, 0, 0);
                        acc[rt][tl] = __builtin_amdgcn_mfma_f32_16x16x32_bf16(Alo, Bc[2 * tl], acc[rt][tl], 0, 0, 0); }
                }
#pragma unroll
                for (int i = 0; i < 10; ++i) Bc[i] = Bn[i];
            }
        }
        float rsv[RT_NRT];
#pragma unroll
        for (int rt = 0; rt < RT_NRT; ++rt) { float s_ = ss[rt]; s_ += __shfl_xor(s_, 16); s_ += __shfl_xor(s_, 32); rsv[rt] = 1.0f / sqrtf(s_ * (1.f / DM) + RMS_EPS);
#pragma unroll
            for (int tl = 0; tl < 5; ++tl)
#pragma unroll
                for (int r = 0; r < 4; ++r) Lw[(rt * 16 + 4 * q + r) * 80 + 16 * tl + row] = acc[rt][tl][r]; }
        LDS_WAIT(); asm volatile("" ::: "memory");
        if (lane < 16 * RT_NRT) {
            const float rs = (lane >> 4) == 0 ? rsv[0] : rsv[RT_NRT - 1];
            float lg[72];
#pragma unroll
            for (int c = 0; c < 72; ++c) lg[c] = Lw[lane * 80 + c] * rs + (c < 8 ? F.b_group[c] : F.b_router[c - 8]);
            int gi = 0; float gm = lg[0];
#pragma unroll
            for (int c = 1; c < 8; ++c) if (lg[c] > gm) { gm = lg[c]; gi = c; }
            float gs = 0.f;
#pragma unroll
            for (int c = 0; c < 8; ++c) gs += expf(lg[c] - gm);
            const float gwt = 1.0f / gs;
            float el[8];
#pragma unroll
            for (int i = 0; i < 8; ++i) el[i] = lg[8 + i];
#pragma unroll
            for (int g = 1; g < 8; ++g) if (gi == g) {
#pragma unroll
                for (int i = 0; i < 8; ++i) el[i] = lg[8 + 8 * g + i]; }
            int i1 = 0; float l1 = el[0];
#pragma unroll
            for (int i = 1; i < 8; ++i) if (el[i] > l1) { l1 = el[i]; i1 = i; }
            int i2 = -1; float l2 = -3e38f;
#pragma unroll
            for (int i = 0; i < 8; ++i) if (i != i1 && el[i] > l2) { l2 = el[i]; i2 = i; }
            const float ex = expf(l2 - l1), w1 = gwt / (1.0f + ex), w2 = gwt * ex / (1.0f + ex);
            const int e1 = gi * 8 + i1, e2 = gi * 8 + i2, tok = row0 + lane;
            {
            const unsigned p1 = atomicAdd(cnt + 64 * e1, 1u), p2 = atomicAdd(cnt + 64 * e2, 1u);
            F.TOK[(size_t)e1 * MOE_CAP + p1] = 2 * tok; F.WL[(size_t)e1 * MOE_CAP + p1] = w1; F.RS[(size_t)e1 * MOE_CAP + p1] = rs;
            F.TOK[(size_t)e2 * MOE_CAP + p2] = 2 * tok + 1; F.WL[(size_t)e2 * MOE_CAP + p2] = w2; F.RS[(size_t)e2 * MOE_CAP + p2] = rs; }
        }
        LDS_WAIT(); asm volatile("" ::: "memory");
    }
}

#ifndef WD_LATE_E_
#define WD_LATE_E_ 40
#endif
constexpr int WD_LATE_E = WD_LATE_E_, CVT_LATE0 = CVT_GU + 128 * WD_LATE_E;
__device__ __forceinline__ int moe_table(Frame& F) {
    LAS int* cntl = (LAS int*)(F.lds + TAB_OFF); LAS int* tab = cntl + 64; LAS int* ntl = tab + MAXT;
    __syncthreads();
    if (F.tid < 64) {
        const int n = (int)__hip_atomic_load(F.ctl + CW_CNT + 64 * F.tid, RLX_AGENT); cntl[F.tid] = n;
        const int nte = (n + 255) >> 8; int inc = nte;
#pragma unroll
        for (int o = 1; o < 64; o <<= 1) { const int v = __shfl_up(inc, o); if (F.tid >= o) inc += v; }
        const int base = inc - nte;
        for (int r = 0; r < nte; ++r) if (base + r < MAXT) tab[base + r] = F.tid | (r << 8);
        if (F.tid == 63) ntl[0] = inc < MAXT ? inc : MAXT;
        if (F.tid == WD_LATE_E) ntl[1] = base;
    }
    __syncthreads();
    return ntl[0];
}

__device__ __forceinline__ void p8_combine(Frame& F) {
    const int gw = F.vcu * NWAVES + F.wave, NGW = F.G * NWAVES;
    for (int t0 = gw; t0 < NR; t0 += 2 * NGW) {
        f32x4 h[2][4]; u32x2 a[2][4], b[2][4];
#pragma unroll
        for (int u = 0; u < 2; ++u) { const int t = (t0 + u * NGW < NR) ? t0 + u * NGW : t0;
            const float* op = F.out + (size_t)t * DM + 4 * F.lane; const bf16_t* y0 = F.YB + (size_t)(2 * t) * DM + 4 * F.lane;
#pragma unroll
            for (int j = 0; j < 4; ++j) { h[u][j] = *(const f32x4*)(op + 256 * j); a[u][j] = *(const u32x2*)(y0 + 256 * j); b[u][j] = *(const u32x2*)(y0 + DM + 256 * j); } }
#pragma unroll
        for (int u = 0; u < 2; ++u) if (t0 + u * NGW < NR) { float* op = F.out + (size_t)(t0 + u * NGW) * DM + 4 * F.lane;
#pragma unroll
            for (int j = 0; j < 4; ++j) { f32x4 o = h[u][j];
                o[0] += bf_lo(a[u][j].x) + bf_lo(b[u][j].x); o[1] += bf_hi(a[u][j].x) + bf_hi(b[u][j].x); o[2] += bf_lo(a[u][j].y) + bf_lo(b[u][j].y); o[3] += bf_hi(a[u][j].y) + bf_hi(b[u][j].y);
                *(f32x4*)(op + 256 * j) = o; } }
    }
}

struct Args { const float* in[24]; float* out; unsigned char* ws; int ph_lo, ph_hi; };
static_assert(sizeof(Args) == 24 * 8 + 8 + 8 + 8, "Args has no padding");

__global__ void __launch_bounds__(NWAVES * 64, 2) fwd_kernel(Args args) {
    extern __shared__ __attribute__((aligned(16))) unsigned char lds[];
    Frame F;
    F.lds = (LAS unsigned char*)lds;
    F.MISC = (volatile LAS unsigned*)(F.lds + MISC_OFF);
    F.tid = threadIdx.x; F.lane = F.tid & 63; F.wave = __builtin_amdgcn_readfirstlane(F.tid >> 6);
    F.G = gridDim.x; { const int bx = blockIdx.x; F.vcu = (F.G % 8 == 0) ? (bx % 8) * (F.G / 8) + bx / 8 : bx; }
    const __attribute__((address_space(4))) Args* ap = (const __attribute__((address_space(4))) Args*)__builtin_amdgcn_kernarg_segment_ptr();
#define FRAME_LOAD() do { asm volatile("" : "+s"(ap)); \
    unsigned char* ws = ap->ws; \
    F.ctl = (unsigned*)(ws + WS_CTL); \
    F.x = ap->in[0]; F.meta = ap->in[1]; F.norm1_g = ap->in[2]; F.w_in = ap->in[3]; F.b_in = ap->in[4]; F.dw_w = ap->in[5]; F.dw_b = ap->in[6]; \
    F.ln_g = ap->in[7]; F.ln_b = ap->in[8]; F.w_conv_out = ap->in[9]; F.b_conv_out = ap->in[10]; F.q_norm_g = ap->in[11]; F.k_norm_g = ap->in[12]; \
    F.b_forget = ap->in[13]; F.w_attn_out = ap->in[14]; F.w_out = ap->in[15]; F.norm2_g = ap->in[16]; F.w_group = ap->in[17]; F.b_group = ap->in[18]; \
    F.w_router = ap->in[19]; F.b_router = ap->in[20]; F.w_gate = ap->in[21]; F.w_up = ap->in[22]; F.w_down = ap->in[23]; \
    F.out = ap->out; \
    F.BIAS1 = (float*)(ws + WS_BIAS1); F.WRH = (bf16_t*)(ws + WS_WR); F.WRL = (bf16_t*)(ws + WS_WR + 160 * 1024); F.RS = (float*)(ws + WS_W1T);    F.CB = (float*)(ws + WS_CB); F.LOGF = (float*)(ws + WS_LOGF); \
    F.WL = (float*)(ws + WS_WL); F.TOK = (int*)(ws + WS_TOK); \
    F.W1T = (bf16_t*)(ws + WS_W1T); F.WCT = (bf16_t*)(ws + WS_WCT); F.WAT = (bf16_t*)(ws + WS_WAT); F.WOT = (bf16_t*)(ws + WS_WOT); F.WGU = (bf16_t*)(ws + WS_WGU); F.WD = (bf16_t*)(ws + WS_WD); \
    F.XN = (bf16_t*)(ws + WS_XN); F.MERGED = (bf16_t*)(ws + WS_XN); F.ABUF = (bf16_t*)(ws + WS_ABUF); F.CACT = (bf16_t*)(ws + WS_CACT); F.HN = (bf16_t*)(ws + WS_O); \
    F.QO = (bf16_t*)(ws + WS_QO); F.KX = (bf16_t*)(ws + WS_KX); F.VX = (bf16_t*)(ws + WS_VX); F.HB = (bf16_t*)(ws + WS_QO); F.SG = (bf16_t*)ap->out; F.YB = (bf16_t*)(ws + WS_XN); F.OB = (bf16_t*)(ws + WS_O); \
    } while (0)
    FRAME_LOAD();
    for (int u = F.tid; u < (LDS_BYTES - LDSCTL_OFF) / 4; u += NWAVES * 64) ((LAS unsigned*)(F.lds + LDSCTL_OFF))[u] = 0u;
    __syncthreads();
    XcdBarrier bar; bar.bar = F.ctl + CW_BAR; bar.x = 0; bar.st = nullptr;
    if (MK_N_LAUNCHES == 1) bar = xcd_barrier_post(F.ctl + CW_BAR, F.MISC + 8);
#define GRID_BAR() do { if (MK_N_LAUNCHES == 1) xcd_barrier(bar); } while (0)
    const int lo = ap->ph_lo, hi = ap->ph_hi;
#ifndef P1_ALIGN
#define P1_ALIGN true
#endif
#ifndef PHASE_MASK
#define PHASE_MASK 0x1ff
#endif
#define IN(k) (((PHASE_MASK >> (k)) & 1) && lo <= (k) && (k) < hi)
#define BOTH(k) (IN(k) && IN((k) + 1))
    if (IN(0)) { p0_prologue(F); if (BOTH(0)) GRID_BAR();
    }

    if (IN(1)) { FRAME_LOAD();
        { LAS float* lb = (LAS float*)(F.lds + BIAS_OFF);
          for (int i = F.tid; i < N1; i += NWAVES * 64) lb[i] = F.BIAS1[i];
          if (F.tid < 64) { lb[N1 + F.tid] = F.q_norm_g[F.tid] * C2; lb[N1 + 64 + F.tid] = F.k_norm_g[F.tid]; }
          __syncthreads(); }
        if (F.wave == 0) for (int bh = F.G - 1 - (int)blockIdx.x; bh < 64; bh += F.G) scan_bh(F, bh);
        SchedPlain S; S.so.init(NR / 256, N1 / 256, F.G, (int)blockIdx.x, 8); S.A = (const char*)F.XN; S.B = (const char*)F.W1T; S.K = 1024;
        Epi1 E{(const LAS float*)(F.lds + BIAS_OFF), F.ABUF, F.QO, F.KX, F.VX, F.SG};
        pg8::gemm_phase<Epi1, SchedPlain, P1_ALIGN>(F.lds, 1024, S, E);
#ifndef CVT_EARLY_N
#define CVT_EARLY_N 8700
#endif
        { const int nfull = (NR / 256) * (N1 / 256) + 8 - 4 * F.G;
          if (F.G == 256 && (int)blockIdx.x >= nfull) convert_experts(F, 0, CVT_EARLY_N, ((int)blockIdx.x - nfull) * NWAVES + F.wave, (F.G - nfull) * NWAVES); }
        if (BOTH(1)) GRID_BAR();
    }

    if (IN(2)) { FRAME_LOAD();
        for (int v = F.vcu; v < 256; v += F.G) { const int bh = v >> 2, s = v & 3;
            attn_body::attn_unit<8>(bh >> 3, bh & 7, s, (const attn_body::bf16*)F.QO, (const attn_body::bf16*)F.KX, (const attn_body::bf16*)F.VX, (attn_body::bf16*)F.OB, F.CB, (char*)lds);
            attn_body::attn_unit<8>(bh >> 3, bh & 7, 7 - s, (const attn_body::bf16*)F.QO, (const attn_body::bf16*)F.KX, (const attn_body::bf16*)F.VX, (attn_body::bf16*)F.OB, F.CB, (char*)lds); }
        __syncthreads();
        conv_phase(F);
        __syncthreads();
        if (BOTH(2)) GRID_BAR();
    }

    if (IN(3)) { FRAME_LOAD();
        SchedDual S; S.so.init(NR / 256, 4, F.G, (int)blockIdx.x); S.A0 = (const char*)F.CACT; S.B0 = (const char*)F.WCT; S.A1 = (const char*)F.OB; S.B1 = (const char*)F.WAT; S.K = 512;
        Epi3 E{F.b_conv_out, F.SG, F.MERGED};
        pg8::gemm_phase<Epi3, SchedDual, true>(F.lds, 512, S, E);
        if (BOTH(3)) GRID_BAR();
    }

    if (IN(4)) { FRAME_LOAD();
        SchedPlain S; S.so.init(NR / 256, 4, F.G, (int)blockIdx.x); S.A = (const char*)F.MERGED; S.B = (const char*)F.WOT; S.K = 1024;
        Epi4 E{F.x, F.out};
        pg8::gemm_phase<Epi4, SchedPlain, true>(F.lds, 1024, S, E);
        if (BOTH(4)) GRID_BAR();
    }

    if (IN(5)) { FRAME_LOAD();
        if (F.wave >= RT_WAVES) convert_experts(F, F.G == 256 ? CVT_EARLY_N : 0, CVT_LATE0, F.vcu * (NWAVES - RT_WAVES) + (F.wave - RT_WAVES), F.G * (NWAVES - RT_WAVES)); else { __builtin_amdgcn_s_setprio(3); p5_router(F); __builtin_amdgcn_s_setprio(0); }
        if (BOTH(5)) GRID_BAR(); }

#ifndef DOWN_B
#define DOWN_B 3
#endif
    if (IN(6)) { FRAME_LOAD();
        const int nt = moe_table(F);
        const LAS int* cntl = (const LAS int*)(F.lds + TAB_OFF);
        const int U6 = 2 * nt, G = F.G, c = F.vcu;
        const bool overlap = U6 > G && U6 <= 2 * G && (G & 7) == 0;
        int K7 = 256; asm volatile("" : "+s"(K7));
        Epi6 E6{(const LAS unsigned char*)(F.lds + LIST_OFF), F.HB}; Epi7 E7{cntl, (const LAS unsigned char*)(F.lds + LIST_OFF), F.YB};
        { SchedMoe S{0, overlap ? G : U6, G, c, 1, cntl + 64, cntl, (const char*)F.HN, (const char*)F.WGU, F.TOK, 1024, 512, true, F.RS, nullptr};
          pg8::gemm_phase<Epi6, SchedMoe, true, true>(F.lds, 1024, S, E6);
        }
        GRID_BAR();
        if (!overlap) { convert_experts(F, CVT_LATE0, CVT_GU + CVT_D, c * NWAVES + F.wave, G * NWAVES); __syncthreads(); GRID_BAR(); }
        const int tS = cntl[64 + MAXT + 1];
        const int cpx = G / 8, xq = c / cpx, jq = c % cpx;
        int lastB = DOWN_B * (2 * G - U6) < 2 * G ? DOWN_B * (2 * G - U6) : 2 * G; if (lastB > 4 * tS) lastB = 4 * tS;
        if (overlap) {
            const int nP = U6 - G, shareP = (nP + 7) / 8; int before = 0, mine = 0;
            for (int x2 = 0; x2 < 8; ++x2) { int n2 = nP - x2 * shareP; n2 = n2 < 0 ? 0 : (n2 > shareP ? shareP : n2); if (x2 < xq) before += n2; if (x2 == xq) mine = n2; }
            if (jq < mine) { SchedMoe S{G, U6, 1 << 28, xq * shareP + jq, 1, cntl + 64, cntl, (const char*)F.HN, (const char*)F.WGU, F.TOK, 1024, 512, true, F.RS, nullptr};
                pg8::gemm_phase<Epi6, SchedMoe, true, true>(F.lds, 1024, S, E6); }
            else { convert_experts(F, CVT_LATE0, CVT_GU + CVT_D, (c - before - mine) * NWAVES + F.wave, (2 * G - U6) * NWAVES); __syncthreads();
                SchedMoe S{0, lastB, 2 * G - U6, c - before - mine, 2, cntl + 64, cntl, (const char*)F.HB, (const char*)F.WD, F.TOK, K7, 1024, false, F.TOK, F.WL};
                pg8::gemm_phase<Epi7, SchedMoe, true>(F.lds, K7, S, E7); }
            GRID_BAR();
        }
        { const int c0 = overlap ? lastB : 0, nC = 4 * nt - c0, shareC = (nC + 7) / 8;
          const bool spread = overlap && nC <= G && shareC <= cpx;
          SchedMoe S{c0, 4 * nt, spread ? (1 << 28) : G, spread ? (jq < shareC ? xq * shareC + jq : (1 << 28)) : c, 2, cntl + 64, cntl, (const char*)F.HB, (const char*)F.WD, F.TOK, K7, 1024, false, F.TOK, F.WL};
          pg8::gemm_phase<Epi7, SchedMoe, true>(F.lds, K7, S, E7);
        }
        GRID_BAR();
    }
    if (IN(8)) { FRAME_LOAD();
        p8_combine(F); }
#undef IN
#undef BOTH
}


extern "C" void kernel_launch(void* const* d_in, const int* in_sizes, int n_in, void* d_out, int out_size, void* d_ws, size_t ws_size, hipStream_t stream) {
    static int grid = 0;
    if (grid == 0) {
        if (n_in != 24 || in_sizes[0] != NR * DM || out_size != NR * DM || ws_size < WS_END) {
            fprintf(stderr, "kernel_launch: unexpected shapes (n_in %d, in0 %d, out %d, ws %zu); nothing launched\n", n_in, n_in > 0 ? in_sizes[0] : -1, out_size, ws_size); grid = -1; return; }
        int dev = 0, cus = 0, per_cu = 0;
        if (hipGetDevice(&dev) != hipSuccess || hipDeviceGetAttribute(&cus, hipDeviceAttributeMultiprocessorCount, dev) != hipSuccess) { grid = -1; return; }
        if (hipFuncSetAttribute((const void*)fwd_kernel, hipFuncAttributeMaxDynamicSharedMemorySize, LDS_BYTES) != hipSuccess) { fprintf(stderr, "kernel_launch: hipFuncSetAttribute failed\n"); grid = -1; return; }
        if (hipOccupancyMaxActiveBlocksPerMultiprocessor(&per_cu, (const void*)fwd_kernel, NWAVES * 64, LDS_BYTES) != hipSuccess || per_cu < 1) { fprintf(stderr, "kernel_launch: occupancy query reports %d blocks per CU\n", per_cu); (void)hipGetLastError(); grid = -1; return; }
        grid = cus;
    }
    if (grid < 0) return;
    if (hipMemsetAsync((char*)d_ws + WS_CTL, 0, CTL_ZERO_BYTES, stream) != hipSuccess) return;
    Args a{};
    for (int i = 0; i < 24; ++i) a.in[i] = (const float*)d_in[i];
    a.out = (float*)d_out; a.ws = (unsigned char*)d_ws;
    if (MK_N_LAUNCHES == 1) { a.ph_lo = 0; a.ph_hi = N_PHASES; hipLaunchKernelGGL(fwd_kernel, dim3(grid), dim3(NWAVES * 64), LDS_BYTES, stream, a); }
    else for (int p = 0; p < N_PHASES; ++p) { a.ph_lo = p; a.ph_hi = p + 1; hipLaunchKernelGGL(fwd_kernel, dim3(grid), dim3(NWAVES * 64), LDS_BYTES, stream, a); }
}
```
